# Optimizing an MI355X kernel written in HIP

```python
import math
import jax, jax.numpy as jnp
from jax import lax
import numpy as np

D_MODEL = 1024
BATCH = 16
SEQ = 2048
DEPTH = 2

D_MIX = D_MODEL
LRU_WIDTH = D_MIX // 4
LRU_BLOCKS = 4
LRU_BLOCK = LRU_WIDTH // LRU_BLOCKS
CONV_WIDTH = 4
LRU_C = 8.0
HG_HEADS = 4
HG_DK = 64
HG_DV = 64
HG_KDIM = HG_HEADS * HG_DK
HG_WIDTH = HG_HEADS * HG_DV
HG_CHUNK = 64
MLA_HEADS = 8
MLA_NOPE = 64
MLA_ROPE = 32
MLA_V = 64
MLA_QK = MLA_NOPE + MLA_ROPE
MLA_Q_RANK = 256
MLA_KV_RANK = 128
MLA_WIDTH = MLA_HEADS * MLA_V
ATTN_BLOCK = 128
ROPE_THETA = 10000.0
D_FF = 2752
N_EXPERTS = 8
TOP_K = 2
D_EXPERT = 3584
N_DENSE = (DEPTH + 1) // 2
N_MOE = DEPTH // 2
EPS = 1e-6
IN_SIZES = (LRU_WIDTH, LRU_WIDTH, HG_KDIM, HG_KDIM, HG_KDIM, HG_WIDTH, HG_WIDTH, MLA_Q_RANK, MLA_KV_RANK, MLA_ROPE)
D_IN = LRU_WIDTH * 2 + HG_KDIM * 3 + HG_WIDTH * 2 + MLA_Q_RANK + MLA_KV_RANK + MLA_ROPE

kernel_name = 'hybrid_rglru_hgrn2_mla_moe_encoder'


def rms_norm(x, g):
    xf = x.astype(jnp.float32)
    y = xf * lax.rsqrt(jnp.mean(xf * xf, axis=-1, keepdims=True) + EPS)
    return (y * g.astype(jnp.float32)).astype(x.dtype)


def split_columns(proj):
    outs, start = [], 0
    for size in IN_SIZES:
        outs.append(proj[..., start:start + size])
        start += size
    return outs


def centred_dwconv(x, w, b):
    S = x.shape[1]
    pad_l = CONV_WIDTH // 2
    xp = jnp.pad(x, ((0, 0), (pad_l, CONV_WIDTH - 1 - pad_l), (0, 0)))
    y = b
    for k in range(CONV_WIDTH):
        y = y + xp[:, k:k + S] * w[k]
    return y


def linear_scan(a, b, reverse):
    def combine(l, r):
        return r[0] * l[0], r[0] * l[1] + r[1]
    return lax.associative_scan(combine, (a, b), axis=1, reverse=reverse)[1]


def rg_lru(x, w_a, b_a, w_x, b_x, lam, reverse):
    B, S, W = x.shape
    f32 = jnp.float32
    xb = x.reshape(B, S, LRU_BLOCKS, LRU_BLOCK)
    r = jax.nn.sigmoid(jnp.einsum('bsnd,nde->bsne', xb, w_a.astype(f32)).reshape(B, S, W) + b_a.astype(f32))
    i = jax.nn.sigmoid(jnp.einsum('bsnd,nde->bsne', xb, w_x.astype(f32)).reshape(B, S, W) + b_x.astype(f32))
    log_a = -LRU_C * r * jax.nn.softplus(-lam.astype(f32))
    a = jnp.exp(log_a)
    mult = jnp.sqrt(-jnp.expm1(2.0 * log_a))
    return linear_scan(a, mult * (i * x), reverse)


def rglru_mixer(xa, gate, conv_w, conv_b, w_a, b_a, w_x, b_x, lam):
    xc = centred_dwconv(xa, conv_w, conv_b).astype(jnp.float32)
    h = (rg_lru(xc, w_a[0], b_a[0], w_x[0], b_x[0], lam[0], False)
         + rg_lru(xc, w_a[1], b_a[1], w_x[1], b_x[1], lam[1], True))
    return (h * jax.nn.gelu(gate.astype(jnp.float32))).astype(xa.dtype)


def gla_chunked(q, k, v, logf):
    B, H, S, dk = q.shape
    dv = v.shape[-1]
    n = S // HG_CHUNK

    def to_chunks(t):
        return jnp.moveaxis(t.reshape(B, H, n, HG_CHUNK, t.shape[-1]), 2, 0)

    lower = jnp.tril(jnp.ones((HG_CHUNK, HG_CHUNK), dtype=bool))[:, :, None]

    def step(state, inp):
        qc, kc, vc, gc = inp
        bcum = jnp.cumsum(gc, axis=2)
        b_last = bcum[:, :, -1:, :]
        o_inter = jnp.einsum('bhtd,bhde->bhte', qc * jnp.exp(bcum), state)
        diff = bcum[:, :, :, None, :] - bcum[:, :, None, :, :]
        decay = jnp.exp(jnp.where(lower, diff, -jnp.inf))
        scores = jnp.einsum('bhtd,bhsd,bhtsd->bhts', qc, kc, decay)
        o = o_inter + jnp.einsum('bhts,bhse->bhte', scores, vc)
        new_state = (state * jnp.exp(b_last[:, :, 0, :, None])
                     + jnp.einsum('bhsd,bhse->bhde', kc * jnp.exp(b_last - bcum), vc))
        return new_state, o

    init = jnp.zeros((B, H, dk, dv), jnp.float32)
    _, o = lax.scan(step, init, (to_chunks(q), to_chunks(k), to_chunks(v), to_chunks(logf)))
    return jnp.moveaxis(o, 0, 2).reshape(B, H, S, dv)


def hgrn2_mixer(q_in, ff_in, fb_in, i_in, g_in, lb, norm_g):
    B, S, _ = q_in.shape
    f32 = jnp.float32

    def heads(t):
        return t.astype(f32).reshape(B, S, HG_HEADS, -1).transpose(0, 2, 1, 3)

    def gates(z, lb_dir):
        f = lb_dir.astype(f32) + (1.0 - lb_dir.astype(f32)) * jax.nn.sigmoid(z.astype(f32))
        return heads(jnp.log(f)), heads(1.0 - f)

    q = heads(jax.nn.silu(q_in.astype(f32)) * HG_DK ** -0.5)
    v = heads(i_in)
    logf_f, k_f = gates(ff_in, lb[0])
    logf_b, k_b = gates(fb_in, lb[1])
    rev = lambda t: jnp.flip(t, axis=2)
    o_fwd = gla_chunked(q, k_f, v, logf_f)
    o_bwd = rev(gla_chunked(rev(q), rev(k_b), rev(v), rev(logf_b)))
    o = (o_fwd + o_bwd).transpose(0, 2, 1, 3)
    o = rms_norm(o, norm_g).reshape(B, S, HG_WIDTH)
    return (o * jax.nn.silu(g_in.astype(f32))).astype(q_in.dtype)


def apply_rope_tail(t, cos, sin):
    t_nope, t_rope = t[..., :MLA_NOPE], t[..., MLA_NOPE:]
    half = MLA_ROPE // 2
    x1, x2 = t_rope[..., :half].astype(jnp.float32), t_rope[..., half:].astype(jnp.float32)
    rot = jnp.concatenate([x1 * cos - x2 * sin, x2 * cos + x1 * sin], axis=-1).astype(t.dtype)
    return jnp.concatenate([t_nope, rot], axis=-1)


def dense_attention_blocked(q, k, v):
    B, S, H, dq = q.shape
    n = S // ATTN_BLOCK
    scale = dq ** -0.5
    qb = jnp.moveaxis(q.reshape(B, n, ATTN_BLOCK, H, dq), 1, 0)

    def one_block(q_blk):
        s = jnp.einsum('bqhd,bkhd->bhqk', q_blk, k).astype(jnp.float32) * scale
        p = jax.nn.softmax(s, axis=-1).astype(v.dtype)
        return jnp.einsum('bhqk,bkhd->bqhd', p, v)

    o = lax.map(one_block, qb)
    return jnp.moveaxis(o, 0, 1).reshape(B, S, H, v.shape[-1])


def mla_mixer(c_q, c_kv, k_rope, positions, q_norm_g, w_uq, kv_norm_g, w_ukv, qk_g_q, qk_g_k):
    B, S, _ = c_q.shape
    q = (rms_norm(c_q, q_norm_g) @ w_uq).reshape(B, S, MLA_HEADS, MLA_QK)
    kv = (rms_norm(c_kv, kv_norm_g) @ w_ukv).reshape(B, S, MLA_HEADS, MLA_NOPE + MLA_V)
    k_nope, v = kv[..., :MLA_NOPE], kv[..., MLA_NOPE:]
    k = jnp.concatenate([k_nope, jnp.broadcast_to(k_rope[:, :, None, :], (B, S, MLA_HEADS, MLA_ROPE))], axis=-1)
    q = rms_norm(q, qk_g_q)
    k = rms_norm(k, qk_g_k)
    inv_freq = ROPE_THETA ** (-jnp.arange(0, MLA_ROPE // 2, dtype=jnp.float32) * (2.0 / MLA_ROPE))
    ang = positions.astype(jnp.float32)[..., None] * inv_freq
    cos, sin = jnp.cos(ang)[:, :, None, :], jnp.sin(ang)[:, :, None, :]
    q = apply_rope_tail(q, cos, sin)
    k = apply_rope_tail(k, cos, sin)
    o = dense_attention_blocked(q, k, v)
    return o.reshape(B, S, MLA_WIDTH)


def swiglu_dense(h, w_gate_up, w_down):
    gu = h @ w_gate_up
    g, u = gu[..., :D_FF], gu[..., D_FF:]
    return (jax.nn.silu(g) * u) @ w_down


def moe_swiglu(h, router, w1, w3, w2):
    B, S, D = h.shape
    ht = h.reshape(B * S, D)
    logits = (ht @ router).astype(jnp.float32)
    top_v, top_i = lax.top_k(logits, TOP_K)
    top_w = jax.nn.softmax(top_v, axis=-1)
    combine = jnp.sum(jax.nn.one_hot(top_i, N_EXPERTS, dtype=jnp.float32) * top_w[..., None], axis=1).astype(h.dtype)
    y = jnp.zeros_like(ht)
    for e in range(N_EXPERTS):
        act = jax.nn.silu(ht @ w1[e]) * (ht @ w3[e])
        y = y + (act * combine[:, e:e + 1]) @ w2[e]
    return y.reshape(B, S, D)


def setup_inputs(seed: int = 0) -> dict:
    key = jax.random.key(seed)
    ks = jax.random.split(key, 32)
    f32 = jnp.float32
    nrm = lambda k, shape, scale: jax.random.normal(k, shape, f32) * scale
    gain = lambda k, shape: 1.0 + 0.02 * jax.random.normal(k, shape, f32)
    u = jax.random.uniform(ks[10], (DEPTH, 2, LRU_WIDTH), f32, minval=0.9, maxval=0.999)
    a0 = u ** (1.0 / LRU_C)
    lam = jnp.log(a0) - jnp.log1p(-a0)
    positions = jnp.arange(SEQ, dtype=jnp.int32)[None, :] + jax.random.randint(ks[1], (BATCH, 1), 0, 4096, dtype=jnp.int32)
    return {
        'x': jax.random.normal(ks[0], (BATCH, SEQ, D_MODEL), f32),
        'positions': positions,
        'norm_mix': gain(ks[2], (DEPTH, D_MODEL)),
        'w_in': nrm(ks[3], (DEPTH, D_MODEL, D_IN), D_MODEL ** -0.5),
        'conv_w': nrm(ks[4], (DEPTH, CONV_WIDTH, LRU_WIDTH), CONV_WIDTH ** -0.5),
        'conv_b': nrm(ks[5], (DEPTH, LRU_WIDTH), 0.01),
        'lru_wa': nrm(ks[6], (DEPTH, 2, LRU_BLOCKS, LRU_BLOCK, LRU_BLOCK), LRU_BLOCK ** -0.5),
        'lru_ba': nrm(ks[7], (DEPTH, 2, LRU_WIDTH), 0.01),
        'lru_wx': nrm(ks[8], (DEPTH, 2, LRU_BLOCKS, LRU_BLOCK, LRU_BLOCK), LRU_BLOCK ** -0.5),
        'lru_bx': nrm(ks[9], (DEPTH, 2, LRU_WIDTH), 0.01),
        'lru_lam': lam,
        'out_g_a': gain(ks[11], (DEPTH, LRU_WIDTH)),
        'hg_lb_logits': nrm(ks[12], (DEPTH, 2, HG_KDIM), 0.1),
        'hg_norm_g': gain(ks[13], (DEPTH, HG_DV)),
        'mla_q_norm': gain(ks[14], (DEPTH, MLA_Q_RANK)),
        'mla_w_uq': nrm(ks[15], (DEPTH, MLA_Q_RANK, MLA_HEADS * MLA_QK), MLA_Q_RANK ** -0.5),
        'mla_kv_norm': gain(ks[16], (DEPTH, MLA_KV_RANK)),
        'mla_w_ukv': nrm(ks[17], (DEPTH, MLA_KV_RANK, MLA_HEADS * (MLA_NOPE + MLA_V)), MLA_KV_RANK ** -0.5),
        'qk_norm_q': gain(ks[18], (DEPTH, MLA_QK)),
        'qk_norm_k': gain(ks[19], (DEPTH, MLA_QK)),
        'out_g_c': gain(ks[20], (DEPTH, MLA_WIDTH)),
        'w_out': nrm(ks[21], (DEPTH, D_MIX, D_MODEL), D_MIX ** -0.5),
        'norm_ffn': gain(ks[22], (DEPTH, D_MODEL)),
        'ffn_w_gate_up': nrm(ks[23], (N_DENSE, D_MODEL, 2 * D_FF), D_MODEL ** -0.5),
        'ffn_w_down': nrm(ks[24], (N_DENSE, D_FF, D_MODEL), D_FF ** -0.5),
        'moe_router': nrm(ks[25], (N_MOE, D_MODEL, N_EXPERTS), D_MODEL ** -0.5),
        'moe_w1': nrm(ks[26], (N_MOE, N_EXPERTS, D_MODEL, D_EXPERT), D_MODEL ** -0.5),
        'moe_w3': nrm(ks[27], (N_MOE, N_EXPERTS, D_MODEL, D_EXPERT), D_MODEL ** -0.5),
        'moe_w2': nrm(ks[28], (N_MOE, N_EXPERTS, D_EXPERT, D_MODEL), D_EXPERT ** -0.5),
    }


def reference(x, positions, norm_mix, w_in, conv_w, conv_b, lru_wa, lru_ba, lru_wx, lru_bx, lru_lam,
              out_g_a, hg_lb_logits, hg_norm_g, mla_q_norm, mla_w_uq, mla_kv_norm, mla_w_ukv,
              qk_norm_q, qk_norm_k, out_g_c, w_out, norm_ffn, ffn_w_gate_up, ffn_w_down,
              moe_router, moe_w1, moe_w3, moe_w2):
    p = jax.nn.softmax(hg_lb_logits.astype(jnp.float32), axis=0)
    lower_bounds = jnp.cumsum(p, axis=0) - p[0:1]
    for l in range(DEPTH):
        h = rms_norm(x, norm_mix[l])
        (xa, ga, hq, hff, hfb, hi, hg, cq, ckv, kr) = split_columns(h @ w_in[l])
        y_a = rglru_mixer(xa, ga, conv_w[l], conv_b[l], lru_wa[l], lru_ba[l], lru_wx[l], lru_bx[l], lru_lam[l])
        y_b = hgrn2_mixer(hq, hff, hfb, hi, hg, lower_bounds[l], hg_norm_g[l])
        y_c = mla_mixer(cq, ckv, kr, positions, mla_q_norm[l], mla_w_uq[l], mla_kv_norm[l], mla_w_ukv[l],
                        qk_norm_q[l], qk_norm_k[l])
        mixed = jnp.concatenate([rms_norm(y_a, out_g_a[l]), y_b, rms_norm(y_c, out_g_c[l])], axis=-1)
        x = x + mixed @ w_out[l]
        h = rms_norm(x, norm_ffn[l])
        if l % 2 == 0:
            x = x + swiglu_dense(h, ffn_w_gate_up[l // 2], ffn_w_down[l // 2])
        else:
            x = x + moe_swiglu(h, moe_router[l // 2], moe_w1[l // 2], moe_w3[l // 2], moe_w2[l // 2])
    return x
```

```cpp
#include <hip/hip_runtime.h>
#include <cstdio>
#include <cstdint>

typedef unsigned short bf16_t;
typedef float f32x4 __attribute__((ext_vector_type(4)));
typedef unsigned u32x4 __attribute__((ext_vector_type(4)));
typedef unsigned u32x2 __attribute__((ext_vector_type(2)));
#define LAS __attribute__((address_space(3)))

constexpr int NB = 16, SEQ = 2048, T = NB * SEQ, D = 1024;
constexpr int DIN = 2208, DINP = 2304;
constexpr int C_XA = 0, C_GA = 256, C_HQ = 512, C_HFF = 768, C_HFB = 1024, C_HI = 1280, C_HG = 1536, C_CQ = 1792, C_CKV = 2048, C_KR = 2176;
constexpr int DFF = 2752, DFFP = 2816, NGU = 5632;
constexpr int DEX = 3584, NE = 8;
constexpr float EPS = 1e-6f;

constexpr size_t MiB = 1u << 20;
constexpr size_t WS_CTL = 0;
constexpr size_t WS_WIN = 1 * MiB;
constexpr size_t WS_WOUT = 10 * MiB;
constexpr size_t WS_WGU = 14 * MiB;
constexpr size_t WS_WDN = 25 * MiB;
constexpr size_t WS_WUQ = 31 * MiB;
constexpr size_t WS_WUKV = 32 * MiB;
constexpr size_t WS_LIST = 33 * MiB;
constexpr size_t WS_HB = 38 * MiB;
constexpr size_t WS_PROJ = 102 * MiB;
constexpr size_t WS_Q = 246 * MiB, WS_K = 294 * MiB;
constexpr size_t WS_V = 342 * MiB;
constexpr size_t WS_XS = 440 * MiB;
constexpr size_t OUT_DIRS = 0, OUT_YC = 64 * MiB;
constexpr size_t WS_SS = 504 * MiB;
constexpr size_t WS_ACT = 102 * MiB;
constexpr size_t WS_W13 = 374 * MiB;
constexpr size_t WS_W2 = 214 * MiB;
constexpr size_t WS_ACTM = 246 * MiB;
constexpr size_t WS_PART = 102 * MiB;
constexpr size_t WS_END = 508 * MiB;
constexpr int CW_CNT = 8192;

__device__ __forceinline__ unsigned pk4_fp8(float a, float b, float c, float d) {
    a = __builtin_amdgcn_fmed3f(a, -448.f, 448.f); b = __builtin_amdgcn_fmed3f(b, -448.f, 448.f); c = __builtin_amdgcn_fmed3f(c, -448.f, 448.f); d = __builtin_amdgcn_fmed3f(d, -448.f, 448.f);
    int pk = __builtin_amdgcn_cvt_pk_fp8_f32(a, b, 0, false); pk = __builtin_amdgcn_cvt_pk_fp8_f32(c, d, pk, true); return (unsigned)pk; }
__device__ __forceinline__ float bf2f(bf16_t b) { return __uint_as_float(((unsigned)b) << 16); }
__device__ __forceinline__ unsigned f2bf(float f) { unsigned u = __float_as_uint(f); return (u + 0x7fffu + ((u >> 16) & 1u)) >> 16; }
__device__ __forceinline__ unsigned pk2(float lo, float hi) { return f2bf(lo) | (f2bf(hi) << 16); }
__device__ __forceinline__ int lane_id_v() { int r; asm volatile("v_mbcnt_lo_u32_b32 %0, -1, 0\n\tv_mbcnt_hi_u32_b32 %0, -1, %0" : "=v"(r)); return r; }
__device__ __forceinline__ int launder_s(int v) { asm volatile("" : "+s"(v)); return v; }
__device__ __forceinline__ int tid_of(int wv) { return launder_s(wv) * 64 + lane_id_v(); }
template <int M> __device__ __forceinline__ float xor_shfl(float v) { static_assert(M > 0 && M < 32, "swizzle range"); return __int_as_float(__builtin_amdgcn_ds_swizzle(__float_as_int(v), (M << 10) | 0x1F)); }
__device__ __forceinline__ float half_sum(float v) { auto rr = __builtin_amdgcn_permlane32_swap(__float_as_uint(v), __float_as_uint(v), false, false); return __uint_as_float(rr[0]) + __uint_as_float(rr[1]); }
__device__ __forceinline__ float half_max(float v) { auto rr = __builtin_amdgcn_permlane32_swap(__float_as_uint(v), __float_as_uint(v), false, false); return fmaxf(__uint_as_float(rr[0]), __uint_as_float(rr[1])); }
__device__ __forceinline__ float lane_bcast(float v, int src_lane) { return __int_as_float(__builtin_amdgcn_ds_bpermute(src_lane << 2, __float_as_int(v))); }
__device__ __forceinline__ void lds_barrier() { asm volatile("s_waitcnt lgkmcnt(0)" ::: "memory"); __builtin_amdgcn_s_barrier(); asm volatile("" ::: "memory"); }
__device__ __forceinline__ float wave_sum(float v) {
    v += xor_shfl<1>(v); v += xor_shfl<2>(v); v += xor_shfl<4>(v); v += xor_shfl<8>(v); v += xor_shfl<16>(v);
    return half_sum(v);
}
__device__ __forceinline__ float sigmoidf_(float x) { return __builtin_amdgcn_rcpf(1.0f + __builtin_amdgcn_exp2f(-1.4426950408889634f * x)); }
__device__ __forceinline__ float siluf_(float x) { return x * __builtin_amdgcn_rcpf(1.0f + __builtin_amdgcn_exp2f(-1.4426950408889634f * x)); }
__device__ __forceinline__ float gelu_tanh(float x) { const float u = 0.7978845608028654f * (x + 0.044715f * x * x * x); const float t = 1.0f - 2.0f * __builtin_amdgcn_rcpf(1.0f + __builtin_amdgcn_exp2f(2.885390081777927f * u)); return 0.5f * x * (1.0f + t); }

__constant__ float c_invfreq[16] = {1.0f, 0.5623413251903491f, 0.31622776601683794f, 0.1778279410038923f, 0.1f, 0.05623413251903491f, 0.031622776601683794f, 0.01778279410038923f,
                                    0.01f, 0.005623413251903491f, 0.0031622776601683794f, 0.001778279410038923f, 0.001f, 0.0005623413251903491f, 0.00031622776601683794f, 0.0001778279410038923f};
__device__ __forceinline__ void rope_cs(int pos, int i, float& c, float& s) {
    const float ang = (float)pos * c_invfreq[i];
    const double rev = (double)ang * 0.15915494309189535; const float fr = (float)(rev - floor(rev));
    s = __builtin_amdgcn_sinf(fr); c = __builtin_amdgcn_cosf(fr);
}

constexpr float F8_WSCALE = 64.f;
constexpr float F8_ASCALE = 8.f;
struct TrJob { const float* src; bf16_t* dst; const float* kscale; int K, N, lds, ldd, mode, radd, f8; };
__device__ __forceinline__ void tr_item(const TrJob& J, int item, float*  , int lane) {
    const int nblk = J.N / 32, kb = item / nblk, nb = item % nblk, k0 = 64 * kb, n0 = 32 * nb, c = lane & 7, r = lane >> 3;
    const float* sp = J.src + (size_t)(k0 + 8 * r) * J.lds + n0 + 4 * c;
    f32x4 v[8];
#pragma unroll
    for (int i = 0; i < 8; ++i) v[i] = *(const f32x4*)(sp + (size_t)i * J.lds);
    if (J.kscale) {
#pragma unroll
        for (int i = 0; i < 8; ++i) v[i] *= J.kscale[k0 + 8 * r + i]; }
#pragma unroll
    for (int j = 0; j < 4; ++j) { const int sn = n0 + 4 * c + j; const int dn = J.mode ? ((sn >> 7) * 256 + J.radd + (sn & 127)) : sn;
        if (J.f8) { u32x2 o; o.x = pk4_fp8(v[0][j] * F8_WSCALE, v[1][j] * F8_WSCALE, v[2][j] * F8_WSCALE, v[3][j] * F8_WSCALE); o.y = pk4_fp8(v[4][j] * F8_WSCALE, v[5][j] * F8_WSCALE, v[6][j] * F8_WSCALE, v[7][j] * F8_WSCALE);
            *(u32x2*)((unsigned char*)J.dst + (size_t)dn * J.ldd + k0 + 8 * r) = o; }
        else { u32x4 o; o.x = pk2(v[0][j], v[1][j]); o.y = pk2(v[2][j], v[3][j]); o.z = pk2(v[4][j], v[5][j]); o.w = pk2(v[6][j], v[7][j]);
            *(u32x4*)(J.dst + (size_t)dn * J.ldd + k0 + 8 * r) = o; } }
}
typedef short bf16x8 __attribute__((ext_vector_type(8)));
typedef float f32x16 __attribute__((ext_vector_type(16)));
#define GAS __attribute__((address_space(1)))
typedef GAS unsigned gu32;
#define RLX_AGENT __ATOMIC_RELAXED, __HIP_MEMORY_SCOPE_AGENT

constexpr int NWAVES = 8;
__device__ __forceinline__ int launder(int v) { asm volatile("" : "+v"(v)); return v; }
constexpr int RING_OFF = 0, RING_BYTES = 131072;
constexpr int LDSCTL_OFF = RING_BYTES, MISC_OFF = LDSCTL_OFF + 320;
constexpr int ROWTAB_OFF = RING_BYTES + 1024;
constexpr int LDS_BYTES = 147456;
constexpr int CW_QUEUE = 16384;
constexpr int CW_BAR = 65536;

#define XB_TMO      128
#define XB_XCNT(j)  (256  + 64 * (j))
#define XB_XSUB(j)  (1280 + 64 * (j))
#define XB_XGEN(j)  (2304 + 64 * (j))
#define XB_TOP      3328
#define XB_TOPGEN   3392
#define XCD_BAR_WORDS 3456
#define XB_SPIN_CAP (1u << 18)
__device__ __forceinline__ unsigned xb_ld(unsigned* p)              { return __hip_atomic_load(p, __ATOMIC_RELAXED, __HIP_MEMORY_SCOPE_AGENT); }
__device__ __forceinline__ unsigned xb_add(unsigned* p, unsigned v) { return __hip_atomic_fetch_add(p, v, __ATOMIC_RELAXED, __HIP_MEMORY_SCOPE_AGENT); }
__device__ __forceinline__ unsigned xb_xcc_id() { return (unsigned)__builtin_amdgcn_s_getreg((3 << 11) | 20) & 0xFu; }
#define XB_SPIN(cond, bar) do { unsigned _sp = 0; while (cond) { __builtin_amdgcn_s_sleep(1); \
    if ((++_sp & 255u) == 0u) { if (xb_ld(&(bar)[XB_TMO])) break; if (_sp > XB_SPIN_CAP) { atomicAdd(&(bar)[XB_TMO], 1u); break; } } } } while (0)
struct XcdBarrier { unsigned* bar; unsigned x; volatile LAS unsigned* st; int wv; };
__device__ __forceinline__ XcdBarrier xcd_barrier_post(unsigned* bar, volatile LAS unsigned* st, int wv) {
    XcdBarrier b; b.bar = bar; b.x = xb_xcc_id(); b.st = st; b.wv = wv;
    if (tid_of(wv) == 0) (void)xb_add(&bar[XB_XCNT(b.x)], 1u);
    return b;
}
__device__ __forceinline__ void xcd_barrier_complete(unsigned* bar, unsigned x, unsigned& nloc, unsigned& nx) {
    const unsigned G = gridDim.x * gridDim.y * gridDim.z;
    unsigned sum, cnt, mine, sp = 0u;
    for (;;) {
        sum = 0u; cnt = 0u; mine = 0u;
#pragma unroll
        for (unsigned j = 0; j < 16; ++j) { const unsigned c = xb_ld(&bar[XB_XCNT(j)]); sum += c; cnt += (c > 0u) ? 1u : 0u; mine = (j == x) ? c : mine; }
        if (sum == G) break;
        __builtin_amdgcn_s_sleep(1);
        if ((++sp & 255u) == 0u) { if (xb_ld(&bar[XB_TMO])) break; if (sp > XB_SPIN_CAP) { atomicAdd(&bar[XB_TMO], 1u); break; } }
    }
    nloc = mine > 0u ? mine : 1u; nx = cnt > 0u ? cnt : 1u;
}
__device__ __forceinline__ void xcd_barrier(const XcdBarrier& b) {
    asm volatile("s_waitcnt vmcnt(0)" ::: "memory");
    __syncthreads();
    if (tid_of(b.wv) == 0) {
        unsigned* bar = b.bar;
        __builtin_amdgcn_s_waitcnt(0);
        unsigned nloc = b.st[0], nx = b.st[1];
        if (nloc == 0u) { xcd_barrier_complete(bar, b.x, nloc, nx); b.st[0] = nloc; b.st[1] = nx; }
        const unsigned old = xb_add(&bar[XB_XSUB(b.x)], 1u);
        const unsigned gen = old / nloc;
        if (old + 1u == (gen + 1u) * nloc) {
            __builtin_amdgcn_fence(__ATOMIC_RELEASE, "agent");
            asm volatile("s_waitcnt vmcnt(0)" ::: "memory");
            const unsigned og = xb_add(&bar[XB_TOP], 1u);
            const unsigned tg = og / nx;
            if (og + 1u == (tg + 1u) * nx) xb_add(&bar[XB_TOPGEN], 1u);
            else XB_SPIN(xb_ld(&bar[XB_TOPGEN]) == tg, bar);
            __builtin_amdgcn_fence(__ATOMIC_ACQUIRE, "agent");
            xb_add(&bar[XB_XGEN(b.x)], 1u);
            asm volatile("s_waitcnt vmcnt(0)" ::: "memory");
        } else {
            XB_SPIN(xb_ld(&bar[XB_XGEN(b.x)]) == gen, bar);
            __builtin_amdgcn_fence(__ATOMIC_ACQUIRE, "agent");
            asm volatile("s_waitcnt vmcnt(0)" ::: "memory");
        }
    }
    __syncthreads();
}

namespace pg8 {
typedef int i32x4v __attribute__((ext_vector_type(4)));
typedef int i32x8v __attribute__((ext_vector_type(8)));
constexpr int BM = 256, BK = 64, HALF = 128, HTB = HALF * BK * 2, STAGE_BYTES = 8 * HTB, NXCD = 8, WGM = 8;
__host__ __device__ __forceinline__ int lds_byte(int r, int c) { const int st = (r >> 4) * 2 + (c >> 5), rr = r & 15, cc = c & 31, ob = rr * 64 + cc * 2; return st * 1024 + (ob ^ (((ob >> 9) & 1) << 5)); }
__host__ __device__ __forceinline__ void stage_rc(int b, int& R, int& C) { const int st = b / 1024, sb = b % 1024, swz = sb ^ (((sb >> 9) & 1) << 5); R = (st >> 1) * 16 + swz / 64; C = (st & 1) * 32 + (swz % 64) / 2; }
__host__ __device__ __forceinline__ int perm32(int rho) { const int n = rho >> 4, i = rho & 15; return 8 * (i >> 2) + 4 * n + (i & 3); }
struct Unit { int pm, pn; };
constexpr int RST_OFF = 4096, RST_UNITS = 11;
struct StaticOrder {
    int nM, nN, nwg, G, c, wgm;
    __device__ __forceinline__ void init(int nM_, int nN_, int G_, int c_, int wgm_ = WGM) { nM = nM_; nN = nN_; nwg = nM * nN; G = G_; c = c_; wgm = wgm_; }
    __device__ __forceinline__ bool next(int i, Unit& u) const {
        const long L = (long)i * G + c; if (L >= nwg) return false;
        int wgid = (int)L; { const int q = nwg / NXCD, r = nwg % NXCD, xcd = wgid % NXCD, off = wgid / NXCD; wgid = (xcd < r ? xcd * (q + 1) : r * (q + 1) + (xcd - r) * q) + off; }
        const int nig = wgm * nN, gid = wgid / nig, fm = gid * wgm, gsz = (nM - fm) < wgm ? (nM - fm) : wgm;
        u.pm = fm + ((wgid % nig) % gsz); u.pn = (wgid % nig) / gsz; return true;
    }
};
__device__ __forceinline__ f32x4 mma_f8(bf16x8 b0, bf16x8 b1, bf16x8 a0, bf16x8 a1, f32x4 c) {
    const i32x8v B = __builtin_shufflevector(__builtin_bit_cast(i32x4v, b0), __builtin_bit_cast(i32x4v, b1), 0, 1, 2, 3, 4, 5, 6, 7);
    const i32x8v A = __builtin_shufflevector(__builtin_bit_cast(i32x4v, a0), __builtin_bit_cast(i32x4v, a1), 0, 1, 2, 3, 4, 5, 6, 7);
    return __builtin_amdgcn_mfma_scale_f32_16x16x128_f8f6f4(B, A, c, 0, 0, 0, 0, 0, 0);
}
__device__ __forceinline__ const char* sgpr_ptr(const char* p) { asm volatile("" : "+s"(p)); return p; }
__device__ __forceinline__ unsigned cvt_pk_bf16(float lo, float hi) { unsigned r; asm volatile("v_cvt_pk_bf16_f32 %0, %1, %2" : "=v"(r) : "v"(lo), "v"(hi)); return r; }


struct ProbDense {
    static constexpr bool GATHER = false; static constexpr int ESZ = 2;
    const bf16_t* A; const bf16_t* Bt; int lda, K;
    __device__ __forceinline__ int ldb_() const { return K; }
    __device__ __forceinline__ size_t a_base(const Unit& u) const { return (size_t)(u.pm * BM) * lda * ESZ; }
    __device__ __forceinline__ const char* b_base(const Unit& u) const { return (const char*)Bt + (size_t)u.pn * BM * K * 2; }
};
struct MoeMap {
    const LAS int* tp;
    __device__ __forceinline__ void locate(int pm, int& e, int& lt, int& cnt) const {
        const i32x4v a = *(const LAS i32x4v*)tp, b = *(const LAS i32x4v*)(tp + 4);
        e = (pm >= a.y) + (pm >= a.z) + (pm >= a.w) + (pm >= b.x) + (pm >= b.y) + (pm >= b.z) + (pm >= b.w);
        e = __builtin_amdgcn_readfirstlane(e); lt = __builtin_amdgcn_readfirstlane(pm - tp[e]); cnt = __builtin_amdgcn_readfirstlane(tp[9 + e]);
    }
};
struct ProbMoeUp {
    static constexpr bool GATHER = true; static constexpr int ESZ = 1;
    const bf16_t* A; const bf16_t* Bt; int lda, K; MoeMap mm; const int* list; const float* wl;
    __device__ __forceinline__ int ldb_() const { return K; }
    __device__ __forceinline__ size_t row_idx(const Unit& u, int row) const { int e, lt, cnt; mm.locate(u.pm, e, lt, cnt); const int r = lt * BM + row; return (size_t)e * T + (r < cnt ? r : cnt - 1); }
    __device__ __forceinline__ size_t a_base(const Unit&) const { return 0; }
    __device__ __forceinline__ const char* b_base(const Unit& u) const { int e, lt, cnt; mm.locate(u.pm, e, lt, cnt); return (const char*)Bt + ((size_t)e * (2 * DEX) + (size_t)u.pn * BM) * K * ESZ; }
};
struct ProbMoeDown {
    static constexpr bool GATHER = false; static constexpr int ESZ = 1;
    const bf16_t* A; const bf16_t* Bt; int lda, K; MoeMap mm;
    __device__ __forceinline__ int ldb_() const { return K; }
    __device__ __forceinline__ size_t a_base(const Unit& u) const { return (size_t)(u.pm * BM) * lda * ESZ; }
    __device__ __forceinline__ const char* b_base(const Unit& u) const { int e, lt, cnt; mm.locate(u.pm, e, lt, cnt); return (const char*)Bt + ((size_t)e * D + (size_t)u.pn * BM) * K * ESZ; }
};

struct ProbMoeDownSlice {
    static constexpr bool GATHER = false; static constexpr int ESZ = 1;
    const bf16_t* A; const bf16_t* Bt; int lda, K, kfull, tile0; MoeMap mm;
    __device__ __forceinline__ int ldb_() const { return kfull; }
    __device__ __forceinline__ size_t a_base(const Unit& u) const { return ((size_t)((tile0 + u.pm) * BM) * lda + (size_t)(u.pn >> 2) * K) * ESZ; }
    __device__ __forceinline__ const char* b_base(const Unit& u) const { int e, lt, cnt; mm.locate(tile0 + u.pm, e, lt, cnt); return (const char*)Bt + (((size_t)e * D + (size_t)(u.pn & 3) * BM) * kfull + (size_t)(u.pn >> 2) * K) * ESZ; }
};
struct EpiPartialBf16 {
    static constexpr bool TOKTAB = false; static constexpr bool TAB = false; static constexpr int NVM = 32; static constexpr bool PERM = false;
    bf16_t* P; float scale;
    __device__ __forceinline__ void operator()(const f32x4 (&acc)[2][2][4][2], const Unit& u, int wr, int wc, int fr, int fq, LAS unsigned char* rt, int slot) const {
        bf16_t* tile = P + (size_t)(u.pm * 28 + u.pn) * (BM * BM) + (size_t)(wr * 64 + fr) * BM + wc * 32 + 4 * fq;
#pragma unroll
        for (int ai = 0; ai < 2; ++ai)
#pragma unroll
            for (int m = 0; m < 4; ++m)
#pragma unroll
                for (int bj = 0; bj < 2; ++bj)
#pragma unroll
                    for (int n = 0; n < 2; ++n) { const f32x4 v = acc[ai][bj][m][n] * scale; u32x2 w; w.x = cvt_pk_bf16(v.x, v.y); w.y = cvt_pk_bf16(v.z, v.w);
                        *(u32x2*)(tile + (size_t)(ai * HALF + m * 16) * BM + bj * HALF + n * 16) = w; }
    }
};
__device__ __forceinline__ float row_rs(const float* ss, int row) {
    const f32x4* p = (const f32x4*)(ss + (size_t)row * 16); const f32x4 a = p[0], b = p[1], c = p[2], d = p[3];
    return rsqrtf((((a.x + a.y) + (a.z + a.w)) + ((b.x + b.y) + (b.z + b.w)) + ((c.x + c.y) + (c.z + c.w)) + ((d.x + d.y) + (d.z + d.w))) * (1.0f / D) + EPS);
}
struct EpiStoreBf16 {
    static constexpr bool TOKTAB = false; static constexpr bool TAB = true; static constexpr int NVM = 16; static constexpr bool PERM = true;
    bf16_t* O; int ldc; const float* ss;
    __device__ __forceinline__ void operator()(const f32x4 (&acc)[2][2][4][2], const Unit& u, int wr, int wc, int fr, int fq, LAS unsigned char* rt, int slot) const {
        const int row0 = u.pm * BM + wr * 64 + fr, col0 = u.pn * BM + wc * 32 + 8 * fq;
        float rsv[2][4];
#pragma unroll
        for (int ai = 0; ai < 2; ++ai)
#pragma unroll
            for (int m = 0; m < 4; ++m) rsv[ai][m] = ss ? ((const LAS float*)(rt + RST_OFF))[slot * 256 + wr * 64 + fr + ai * HALF + m * 16] : 1.0f;
#pragma unroll
        for (int ai = 0; ai < 2; ++ai)
#pragma unroll
            for (int m = 0; m < 4; ++m) { bf16_t* rowp = O + (size_t)(row0 + ai * HALF + m * 16) * ldc + col0; const float rs = rsv[ai][m];
#pragma unroll
                for (int bj = 0; bj < 2; ++bj) { const f32x4 v0 = acc[ai][bj][m][0] * rs, v1 = acc[ai][bj][m][1] * rs;
                    u32x4 w; w.x = cvt_pk_bf16(v0[0], v0[1]); w.y = cvt_pk_bf16(v0[2], v0[3]); w.z = cvt_pk_bf16(v1[0], v1[1]); w.w = cvt_pk_bf16(v1[2], v1[3]);
                    *(u32x4*)(rowp + bj * HALF) = w; } }
    }
};
__device__ __forceinline__ void bf16x8_to_f32(const u32x4& w, f32x4& lo, f32x4& hi) {
    lo = (f32x4){__uint_as_float(w.x << 16), __uint_as_float(w.x & 0xffff0000u), __uint_as_float(w.y << 16), __uint_as_float(w.y & 0xffff0000u)};
    hi = (f32x4){__uint_as_float(w.z << 16), __uint_as_float(w.z & 0xffff0000u), __uint_as_float(w.w << 16), __uint_as_float(w.w & 0xffff0000u)};
}
template <bool IN_F32>
struct EpiResid {
    static constexpr bool TOKTAB = false; static constexpr bool TAB = false; static constexpr int NVM = 16; static constexpr bool PERM = true;
    const void* resid; bf16_t* out; int ldc; float* ss;
    static constexpr int RB = IN_F32 ? 2 : 4;
    __device__ __forceinline__ void operator()(const f32x4 (&acc)[2][2][4][2], const Unit& u, int wr, int wc, int fr, int fq, LAS unsigned char* rt, int slot) const {
        const int row0 = u.pm * BM + wr * 64 + fr, col0 = u.pn * BM + wc * 32 + 8 * fq;
#pragma unroll
        for (int ai = 0; ai < 2; ++ai)
#pragma unroll
            for (int mb = 0; mb < 4; mb += RB) {
                f32x4 rf[RB][2][2]; u32x4 rb[RB][2];
#pragma unroll
                for (int m2 = 0; m2 < RB; ++m2) { const size_t off = (size_t)(row0 + ai * HALF + (mb + m2) * 16) * ldc + col0;
#pragma unroll
                    for (int bj = 0; bj < 2; ++bj) {
                        if constexpr (IN_F32) { rf[m2][bj][0] = *(const f32x4*)((const float*)resid + off + bj * HALF); rf[m2][bj][1] = *(const f32x4*)((const float*)resid + off + bj * HALF + 4); }
                        else rb[m2][bj] = *(const u32x4*)((const bf16_t*)resid + off + bj * HALF); } }
#pragma unroll
                for (int m2 = 0; m2 < RB; ++m2) { const int m = mb + m2, row = row0 + ai * HALF + m * 16; const size_t off = (size_t)row * ldc + col0; float s = 0.f;
#pragma unroll
                    for (int bj = 0; bj < 2; ++bj) { f32x4 v0, v1;
                        if constexpr (IN_F32) { v0 = rf[m2][bj][0]; v1 = rf[m2][bj][1]; } else bf16x8_to_f32(rb[m2][bj], v0, v1);
                        v0 += acc[ai][bj][m][0]; v1 += acc[ai][bj][m][1];
                        u32x4 w; w.x = cvt_pk_bf16(v0.x, v0.y); w.y = cvt_pk_bf16(v0.z, v0.w); w.z = cvt_pk_bf16(v1.x, v1.y); w.w = cvt_pk_bf16(v1.z, v1.w);
                        *(u32x4*)(out + off + bj * HALF) = w;
                        if (ss) s += ((v0.x * v0.x + v0.y * v0.y) + (v0.z * v0.z + v0.w * v0.w)) + ((v1.x * v1.x + v1.y * v1.y) + (v1.z * v1.z + v1.w * v1.w)); }
                    if (ss) { s += xor_shfl<16>(s); s = half_sum(s); if (fq == 0) ((LAS float*)rt)[wc * 256 + (row - u.pm * BM)] = s; } }
                asm volatile("" ::: "memory"); }
        if (ss) {
            __syncthreads();
            const int t = wr * 256 + wc * 64 + fq * 16 + fr;
            if (t < 256) { const LAS float* q = (const LAS float*)rt + t; ss[((size_t)u.pm * BM + t) * 4 + u.pn] = (q[0] + q[256]) + (q[512] + q[768]); }
        }
    }
};
__device__ __forceinline__ float silu_fast(float x) { return x * __builtin_amdgcn_rcpf(1.0f + __builtin_amdgcn_exp2f(-1.4426950408889634f * x)); }
typedef float f32x2v __attribute__((ext_vector_type(2)));
__device__ __forceinline__ f32x4 swiglu4(const f32x4& g, const f32x4& u, float c1, float k) {
    const f32x2v c1v = {c1, c1}, kv = {k, k};
    const f32x2v ga = {g.x, g.y}, gb = {g.z, g.w}, ua = {u.x, u.y}, ub = {u.z, u.w};
    const f32x2v aa = ga * c1v, ab = gb * c1v;
    f32x2v ta = {__builtin_amdgcn_exp2f(aa.x), __builtin_amdgcn_exp2f(aa.y)}, tb = {__builtin_amdgcn_exp2f(ab.x), __builtin_amdgcn_exp2f(ab.y)};
    const f32x2v da = __builtin_elementwise_fma(ta, kv, kv), db = __builtin_elementwise_fma(tb, kv, kv);
    const f32x2v ra = {__builtin_amdgcn_rcpf(da.x), __builtin_amdgcn_rcpf(da.y)}, rb = {__builtin_amdgcn_rcpf(db.x), __builtin_amdgcn_rcpf(db.y)};
    const f32x2v oa = (ga * ua) * ra, ob = (gb * ub) * rb;
    return (f32x4){oa.x, oa.y, ob.x, ob.y};
}
struct EpiSwiglu {
    static constexpr bool TOKTAB = false; static constexpr bool TAB = true; static constexpr int NVM = 8; static constexpr bool PERM = true;
    bf16_t* O; int ldc; const float* ss;
    __device__ __forceinline__ void operator()(const f32x4 (&acc)[2][2][4][2], const Unit& u, int wr, int wc, int fr, int fq, LAS unsigned char* rt, int slot) const {
        const int row0 = u.pm * BM + wr * 64 + fr, col0 = u.pn * HALF + wc * 32 + 8 * fq;
        float rsv[2][4];
#pragma unroll
        for (int ai = 0; ai < 2; ++ai)
#pragma unroll
            for (int m = 0; m < 4; ++m) rsv[ai][m] = ss ? ((const LAS float*)(rt + RST_OFF))[slot * 256 + wr * 64 + fr + ai * HALF + m * 16] : 1.0f;
#pragma unroll
        for (int ai = 0; ai < 2; ++ai)
#pragma unroll
            for (int m = 0; m < 4; ++m) { bf16_t* rowp = O + (size_t)(row0 + ai * HALF + m * 16) * ldc + col0; const float rs = rsv[ai][m];
                const float c1 = -1.4426950408889634f * rs, k = __builtin_amdgcn_rcpf(rs * rs);
                const f32x4 o0 = swiglu4(acc[ai][0][m][0], acc[ai][1][m][0], c1, k), o1 = swiglu4(acc[ai][0][m][1], acc[ai][1][m][1], c1, k);
                u32x4 w; w.x = cvt_pk_bf16(o0[0], o0[1]); w.y = cvt_pk_bf16(o0[2], o0[3]); w.z = cvt_pk_bf16(o1[0], o1[1]); w.w = cvt_pk_bf16(o1[2], o1[3]);
                *(u32x4*)rowp = w; }
    }
};
struct EpiSwigluMoe {
    static constexpr bool TOKTAB = false; static constexpr bool TAB = false; static constexpr int NVM = 8; static constexpr bool PERM = true;
    unsigned char* O; int ldc; MoeMap mm;
    __device__ __forceinline__ void operator()(const f32x4 (&acc)[2][2][4][2], const Unit& u, int wr, int wc, int fr, int fq, LAS unsigned char* rt, int slot) const {
        int e, lt, cnt; mm.locate(u.pm, e, lt, cnt);
        const int trow0 = wr * 64 + fr, col0 = u.pn * HALF + wc * 32 + 8 * fq;
        float w8[2][4];
#pragma unroll
        for (int ai = 0; ai < 2; ++ai)
#pragma unroll
            for (int m = 0; m < 4; ++m) { const int tr = trow0 + ai * HALF + m * 16; const float w = ((const LAS float*)(rt + 2048 + slot))[tr]; w8[ai][m] = (lt * BM + tr < cnt) ? w : 0.f; }
#pragma unroll
        for (int ai = 0; ai < 2; ++ai)
#pragma unroll
            for (int m = 0; m < 4; ++m) { const int tr = trow0 + ai * HALF + m * 16;
                unsigned char* rowp = O + (size_t)(u.pm * BM + tr) * ldc + col0;
                const float wgt = w8[ai][m], c1 = -1.4426950408889634f / F8_WSCALE, k = wgt > 0.f ? __builtin_amdgcn_rcpf(wgt * (F8_ASCALE / (F8_WSCALE * F8_WSCALE))) : 1.0e30f;
                const f32x4 o0 = swiglu4(acc[ai][0][m][0], acc[ai][1][m][0], c1, k), o1 = swiglu4(acc[ai][0][m][1], acc[ai][1][m][1], c1, k);
                u32x2 w; w.x = pk4_fp8(o0[0], o0[1], o0[2], o0[3]); w.y = pk4_fp8(o1[0], o1[1], o1[2], o1[3]);
                *(u32x2*)rowp = w; }
    }
};
template <bool OUT_F32>
struct EpiScatterMoe {
    static constexpr bool TAB = false; static constexpr bool TOKTAB = true; static constexpr int NVM = 0; static constexpr bool PERM = true;
    const bf16_t* xs; void* out; int ldc; MoeMap mm; const int* list; float scale;
    __device__ __forceinline__ int tok_of(const Unit& u, int row) const { int e, lt, cnt; mm.locate(u.pm, e, lt, cnt); const int lr = lt * BM + row; return lr < cnt ? list[(size_t)e * T + lr] : -1; }
    __device__ __forceinline__ void operator()(const f32x4 (&acc)[2][2][4][2], const Unit& u, int wr, int wc, int fr, int fq, LAS unsigned char* rt, int slot) const {
        const int trow0 = wr * 64 + fr, col0 = u.pn * BM + wc * 32 + 8 * fq;
        int tok[2][4];
#pragma unroll
        for (int ai = 0; ai < 2; ++ai)
#pragma unroll
            for (int m = 0; m < 4; ++m) tok[ai][m] = ((const LAS int*)(rt + RST_OFF))[slot * 256 + trow0 + ai * HALF + m * 16];
#pragma unroll
        for (int ai = 0; ai < 2; ++ai) {
            u32x4 rb[4][2];
#pragma unroll
            for (int m = 0; m < 4; ++m) { const bf16_t* rowp = xs + (size_t)(tok[ai][m] >= 0 ? tok[ai][m] : 0) * ldc + col0;
#pragma unroll
                for (int bj = 0; bj < 2; ++bj) rb[m][bj] = *(const u32x4*)(rowp + bj * HALF); }
#pragma unroll
            for (int m = 0; m < 4; ++m) { if (tok[ai][m] >= 0) { const size_t off = (size_t)tok[ai][m] * ldc + col0;
#pragma unroll
                for (int bj = 0; bj < 2; ++bj) { f32x4 v0, v1; bf16x8_to_f32(rb[m][bj], v0, v1); v0 += acc[ai][bj][m][0] * scale; v1 += acc[ai][bj][m][1] * scale;
                    if constexpr (OUT_F32) { *(f32x4*)((float*)out + off + bj * HALF) = v0; *(f32x4*)((float*)out + off + bj * HALF + 4) = v1; }
                    else { u32x4 w; w.x = cvt_pk_bf16(v0.x, v0.y); w.y = cvt_pk_bf16(v0.z, v0.w); w.z = cvt_pk_bf16(v1.x, v1.y); w.w = cvt_pk_bf16(v1.z, v1.w); *(u32x4*)((bf16_t*)out + off + bj * HALF) = w; } } } }
            asm volatile("" ::: "memory"); }
    }
};

template <class Prob, class Epi>
__device__ __forceinline__ void gemm_phase(LAS unsigned char* lds, LAS unsigned char* rowtab, const Prob& pb, const StaticOrder& S, const Epi& E, int wv) {
    const int tid = launder(tid_of(wv)), wid = __builtin_amdgcn_readfirstlane(tid >> 6), lane = tid & 63, wr = wid >> 2, wc = wid & 3, fr = lane & 15, fq = lane >> 4;
    const int K = pb.K, nt = K * Prob::ESZ / (2 * BK);
    int R0, C0; stage_rc(tid * 16, R0, C0);
    const unsigned c2 = (unsigned)C0 * 2u;
    const unsigned voffB = (unsigned)((Epi::PERM ? ((R0 & ~31) + perm32(R0 & 31)) : R0) * pb.ldb_()) * (unsigned)Prob::ESZ + c2;
    const unsigned voffA = Prob::GATHER ? 0u : (unsigned)(R0 * pb.lda) * (unsigned)Prob::ESZ + c2;
    const size_t step64B = (size_t)64 * pb.ldb_() * Prob::ESZ, step64A = (size_t)64 * pb.lda * Prob::ESZ, hstepA = (size_t)HALF * pb.lda * Prob::ESZ;
    const size_t hstepB = (size_t)HALF * pb.ldb_() * Prob::ESZ;
    const unsigned ldsw = (unsigned)wid * 1024u;
    const int aoff = lds_byte(wr * 64 + fr, fq * 8), boff = lds_byte(wc * 32 + fr, fq * 8);
    const char* Ab = (const char*)pb.A;
    LAS unsigned char* tabl = rowtab + R0 * 4;
    int slotC = 0, slotN = 1024;
    const unsigned rowbytes = (unsigned)(pb.lda * Prob::ESZ);
#define PG8_TABLES(un, slot) do { if constexpr (Prob::GATHER) { if (wid < 4) { const size_t _ix = pb.row_idx(un, tid); \
        __builtin_amdgcn_global_load_lds((const unsigned*)(pb.list + _ix), (LAS unsigned*)(rowtab + (slot) + wid * 256), 4, 0, 0); \
        __builtin_amdgcn_global_load_lds((const unsigned*)(pb.wl + _ix), (LAS unsigned*)(rowtab + 2048 + (slot) + wid * 256), 4, 0, 0); } } } while (0)
#define PG8_SA(b, h) (((b) * 2 + (h)) * HTB)
#define PG8_SB(b, h) ((4 + (b) * 2 + (h)) * HTB)
#define PG8_STAGE2(bufoff, g0, v0, g1, v1) do { const char* _p0 = sgpr_ptr((const char*)(g0)); const char* _p1 = sgpr_ptr((const char*)(g1)); const unsigned _v0 = (unsigned)launder((int)(v0)), _v1 = (unsigned)launder((int)(v1)); \
        __builtin_amdgcn_global_load_lds((const unsigned*)(_p0 + _v0), (LAS unsigned*)(lds + (bufoff) + ldsw), 16, 0, 0); \
        __builtin_amdgcn_global_load_lds((const unsigned*)(_p1 + _v1), (LAS unsigned*)(lds + (bufoff) + ldsw + 8192), 16, 0, 0); } while (0)
#define PG8_STAGE_B(bufoff, gbase) PG8_STAGE2(bufoff, gbase, voffB, (gbase) + step64B, voffB)
#define PG8_STAGE_A(bufoff, gbase) do { if constexpr (Prob::GATHER) PG8_STAGE2(bufoff, gbase, q0, gbase, q1); else PG8_STAGE2(bufoff, (gbase) + aofs, voffA, (gbase) + aofs + step64A, voffA); } while (0)
#define PG8_AOFF(nx, h, q0, q1) do { if constexpr (Prob::GATHER) { const LAS unsigned* _t = (const LAS unsigned*)(tabl + ((nx) ? slotN : slotC) + (h) * 512); q0 = _t[0] * rowbytes + c2; q1 = _t[64] * rowbytes + c2; } \
        else { aofs = ((nx) ? aN : aC) + (h) * hstepA; } } while (0)
#define PG8_LDA(dst, b, h) do { _Pragma("unroll") for (int m = 0; m < 4; ++m) _Pragma("unroll") for (int k = 0; k < 2; ++k) dst[m][k] = *(const LAS bf16x8*)(lds + PG8_SA(b, h) + aoff + m * 2048 + k * 1024); } while (0)
#define PG8_LDB(dst, b, h) do { _Pragma("unroll") for (int n = 0; n < 2; ++n) _Pragma("unroll") for (int k = 0; k < 2; ++k) dst[n][k] = *(const LAS bf16x8*)(lds + PG8_SB(b, h) + boff + n * 2048 + k * 1024); } while (0)
#define PG8_MMA(ai, bj, At, Bt) do { __builtin_amdgcn_s_setprio(1); _Pragma("unroll") for (int m = 0; m < 4; ++m) _Pragma("unroll") for (int n = 0; n < 2; ++n) { \
        if constexpr (Prob::ESZ == 1) acc[ai][bj][m][n] = mma_f8(Bt[n][0], Bt[n][1], At[m][0], At[m][1], acc[ai][bj][m][n]); \
        else { _Pragma("unroll") for (int k = 0; k < 2; ++k) acc[ai][bj][m][n] = __builtin_amdgcn_mfma_f32_16x16x32_bf16(Bt[n][k], At[m][k], acc[ai][bj][m][n], 0, 0, 0); } } __builtin_amdgcn_s_setprio(0); } while (0)
#define PG8_WAIT_V(n) asm volatile("s_waitcnt vmcnt(" #n ")" ::: "memory")
#define PG8_WAIT_V8F(first) do { if (first) asm volatile("s_waitcnt vmcnt(%0)" :: "n"(8 + Epi::NVM) : "memory"); else asm volatile("s_waitcnt vmcnt(8)" ::: "memory"); } while (0)
#define PG8_WAIT_L(n) asm volatile("s_waitcnt lgkmcnt(" #n ")" ::: "memory")
#define PG8_BAR __builtin_amdgcn_s_barrier()
#define PG8_SCHED __builtin_amdgcn_sched_barrier(0)
    Unit cur, nxt; int ui = 0;
    if (!S.next(0, cur)) return;
    f32x4 acc[2][2][4][2];
#pragma unroll
    for (int a = 0; a < 2; ++a)
#pragma unroll
        for (int b = 0; b < 2; ++b)
#pragma unroll
            for (int m = 0; m < 4; ++m)
#pragma unroll
                for (int n = 0; n < 2; ++n) acc[a][b][m][n] = (f32x4){0.f, 0.f, 0.f, 0.f};
    bf16x8 At[4][2], B0[2][2], B1[2][2];
    size_t aC = 0, aN = 0, aofs = 0;
    unsigned q0 = 0, q1 = 0;
    if constexpr (Prob::GATHER) { PG8_TABLES(cur, 0); PG8_WAIT_V(0); PG8_BAR; }
    else aC = pb.a_base(cur);
    const char* cB = pb.b_base(cur);
    PG8_STAGE_B(PG8_SB(0, 0), cB); PG8_STAGE_B(PG8_SB(0, 1), cB + hstepB);
    PG8_AOFF(false, 0, q0, q1); PG8_STAGE_A(PG8_SA(0, 0), Ab); PG8_AOFF(false, 1, q0, q1); PG8_STAGE_A(PG8_SA(0, 1), Ab);
    if (wr == 1) PG8_BAR;
    PG8_WAIT_V(2); PG8_BAR;
    PG8_STAGE_B(PG8_SB(1, 0), cB + 128); PG8_AOFF(false, 0, q0, q1); PG8_STAGE_A(PG8_SA(1, 0), Ab + 128); PG8_STAGE_B(PG8_SB(1, 1), cB + hstepB + 128);
    if constexpr (Epi::TOKTAB) {
        LAS int* tkT = (LAS int*)(rowtab + RST_OFF);
        for (int i0 = 0; i0 < RST_UNITS + 1; i0 += 2) { Unit um; const int iu = i0 + __builtin_amdgcn_readfirstlane(tid >> 8);
            if (iu < RST_UNITS && S.next(iu, um)) tkT[iu * 256 + (tid & 255)] = E.tok_of(um, tid & 255); }
        __syncthreads();
    }
    if constexpr (Epi::TAB) {
        if (E.ss != nullptr) {
            LAS float* rsT = (LAS float*)(rowtab + RST_OFF);
            for (int i0 = 0; i0 < RST_UNITS + 1; i0 += 2) { Unit um; const int iu = i0 + __builtin_amdgcn_readfirstlane(tid >> 8);
                if (iu < RST_UNITS && S.next(iu, um)) { const f32x4 q4 = *(const f32x4*)(E.ss + ((size_t)um.pm * BM + (tid & 255)) * 4);
                    rsT[iu * 256 + (tid & 255)] = rsqrtf(((q4.x + q4.y) + (q4.z + q4.w)) * (1.0f / D) + EPS); } }
            __syncthreads();
        }
    }
    PG8_WAIT_V(6); PG8_BAR;
    for (;;) {
        const bool has_next = S.next(ui + 1, nxt);
        const char* nB = has_next ? pb.b_base(nxt) : cB;
        if constexpr (Prob::GATHER) { if (has_next) PG8_TABLES(nxt, slotN); }
        else aN = has_next ? pb.a_base(nxt) : aC;
        for (int t = 0; t < nt; t += 2) {
            const bool last = (t == nt - 2);
            const char* a1 = Ab + (size_t)(t + 1) * 128;
            const char* a2 = last ? Ab : Ab + (size_t)(t + 2) * 128; const char* b2 = last ? nB : cB + (size_t)(t + 2) * 128;
            const char* a3 = a2 + 128; const char* b3 = b2 + 128;
            PG8_AOFF(false, 1, q0, q1); PG8_LDB(B0, 0, 0); PG8_LDB(B1, 0, 1); PG8_SCHED; PG8_LDA(At, 0, 0); PG8_STAGE_A(PG8_SA(1, 1), a1);
            PG8_WAIT_V8F(t == 0); PG8_WAIT_L(0); PG8_BAR; PG8_MMA(0, 0, At, B0); PG8_MMA(0, 1, At, B1); PG8_BAR; PG8_SCHED;
            PG8_AOFF(last, 0, q0, q1); PG8_LDA(At, 0, 1); PG8_STAGE_B(PG8_SB(0, 0), b2); PG8_STAGE_B(PG8_SB(0, 1), b2 + hstepB); PG8_STAGE_A(PG8_SA(0, 0), a2);
            PG8_WAIT_V8F(t == 0); PG8_WAIT_L(0); PG8_BAR; PG8_MMA(1, 0, At, B0); PG8_MMA(1, 1, At, B1); PG8_BAR; PG8_SCHED;
            PG8_AOFF(last, 1, q0, q1); PG8_LDB(B0, 1, 0); PG8_LDB(B1, 1, 1); PG8_SCHED; PG8_LDA(At, 1, 0); PG8_STAGE_A(PG8_SA(0, 1), a2);
            PG8_WAIT_V(8); PG8_WAIT_L(0); PG8_BAR; PG8_MMA(0, 0, At, B0); PG8_MMA(0, 1, At, B1); PG8_BAR; PG8_SCHED;
            PG8_AOFF(last, 0, q0, q1); PG8_LDA(At, 1, 1); PG8_STAGE_B(PG8_SB(1, 0), b3); PG8_STAGE_B(PG8_SB(1, 1), b3 + hstepB); PG8_STAGE_A(PG8_SA(1, 0), a3);
            PG8_WAIT_V(8); PG8_WAIT_L(0); PG8_BAR; PG8_MMA(1, 0, At, B0); PG8_MMA(1, 1, At, B1); PG8_BAR; PG8_SCHED;
        }
        if (wr == 0) PG8_BAR;
        { const int le = lane_id_v(); E(acc, cur, wr, wc, le & 15, le >> 4, rowtab, (Epi::TAB || Epi::TOKTAB) ? ui : slotC); }
        if (!has_next) break;
#pragma unroll
        for (int a = 0; a < 2; ++a)
#pragma unroll
            for (int b = 0; b < 2; ++b)
#pragma unroll
                for (int m = 0; m < 4; ++m)
#pragma unroll
                    for (int n = 0; n < 2; ++n) acc[a][b][m][n] = (f32x4){0.f, 0.f, 0.f, 0.f};
        cur = nxt; cB = nB; ++ui;
        if constexpr (Prob::GATHER) { slotC ^= 1024; slotN ^= 1024; }
        else {
            aC = aN;
        }
        if (wr == 1) PG8_BAR;
    }
    PG8_WAIT_V(0);
    PG8_BAR;
#undef PG8_SA
#undef PG8_SB
#undef PG8_STAGE2
#undef PG8_TABLES
#undef PG8_STAGE_A
#undef PG8_STAGE_B
#undef PG8_AOFF
#undef PG8_LDA
#undef PG8_LDB
#undef PG8_MMA
#undef PG8_WAIT_V
#undef PG8_WAIT_V8F
#undef PG8_WAIT_L
#undef PG8_BAR
#undef PG8_SCHED
}
}

struct MkArgs { const void* in[29]; float* out; unsigned char* ws; int ph_lo, ph_hi, li, pad; };
struct Frame {
    LAS unsigned char* lds; volatile LAS unsigned* MISC; unsigned* ctl;
    int tid, lane, wave, vcu, G, wv;
};
__device__ __forceinline__ void relaunder(Frame& F) { F.tid = launder(tid_of(F.wv)); F.lane = F.tid & 63; F.wave = __builtin_amdgcn_readfirstlane(F.tid >> 6); }
enum { P_PREP = 0, PL_WIN = 0, PL_MLA = 1, PL_MIXERS = 2, PL_PREPMIX = 3, PL_WOUT = 4, PL_NORM2 = 5, PL_UP0 = 6, PL_DOWN0 = 7, PL_UP1 = 8, PL_DOWN1 = 9, PL_NORMN = 10, PL_COUNT = 11, P_TOTAL = 1 + 2 * PL_COUNT };
__host__ __device__ constexpr int PH(int l, int k) { return 1 + l * PL_COUNT + k; }

__device__ __forceinline__ bool small_job(int item, const MkArgs& a, TrJob& J, int& local) {
    unsigned char* ws = a.ws;
    const float* w_in = (const float*)a.in[3]; const float* w_out = (const float*)a.in[21]; const float* uq = (const float*)a.in[15]; const float* ukv = (const float*)a.in[17];
    const float* qn = (const float*)a.in[14]; const float* kvn = (const float*)a.in[16]; const float* gu = (const float*)a.in[23]; const float* dn = (const float*)a.in[24];
    int r = item;
    for (int l = 0; l < 2; ++l) {
        if (r < 1104) { J = TrJob{w_in + (size_t)l * D * DIN, (bf16_t*)(ws + WS_WIN) + (size_t)l * DINP * D, (const float*)a.in[2] + l * D, D, DIN, DIN, D, 0, 0}; local = r; return true; } r -= 1104;
        if (r < 512) { J = TrJob{w_out + (size_t)l * D * D, (bf16_t*)(ws + WS_WOUT) + (size_t)l * D * D, nullptr, D, D, D, D, 0, 0}; local = r; return true; } r -= 512;
        if (r < 96) { J = TrJob{uq + (size_t)l * 256 * 768, (bf16_t*)(ws + WS_WUQ) + (size_t)l * 768 * 256, qn + l * 256, 256, 768, 768, 256, 0, 0}; local = r; return true; } r -= 96;
        if (r < 64) { J = TrJob{ukv + (size_t)l * 128 * 1024, (bf16_t*)(ws + WS_WUKV) + (size_t)l * 1024 * 128, kvn + l * 128, 128, 1024, 1024, 128, 0, 0}; local = r; return true; } r -= 64;
    }
    if (r < 1376) { J = TrJob{gu, (bf16_t*)(ws + WS_WGU), (const float*)a.in[22], D, DFF, 2 * DFF, D, 1, 0}; local = r; return true; } r -= 1376;
    if (r < 1376) { J = TrJob{gu + DFF, (bf16_t*)(ws + WS_WGU), (const float*)a.in[22], D, DFF, 2 * DFF, D, 1, 128}; local = r; return true; } r -= 1376;
    if (r < 1376) { J = TrJob{dn, (bf16_t*)(ws + WS_WDN), nullptr, DFF, D, D, DFFP, 0, 0}; local = r; return true; }
    return false;
}
constexpr int N_SMALL_ITEMS = 2 * (1104 + 512 + 96 + 64) + 3 * 1376;
constexpr int N_SMALL_FIRST = 1104;
__device__ __forceinline__ void moe_job_of(int e, int ty, const MkArgs& a, TrJob& J) {
    const float* w1 = (const float*)a.in[26]; const float* w3 = (const float*)a.in[27]; const float* w2 = (const float*)a.in[28];
    if (ty == 0) J = TrJob{w1 + (size_t)e * D * DEX, (bf16_t*)(a.ws + WS_W13 + (size_t)e * 2 * DEX * D), nullptr, D, DEX, DEX, D, 1, 0, 1};
    else if (ty == 1) J = TrJob{w3 + (size_t)e * D * DEX, (bf16_t*)(a.ws + WS_W13 + (size_t)e * 2 * DEX * D), nullptr, D, DEX, DEX, D, 1, 128, 1};
    else J = TrJob{w2 + (size_t)e * DEX * D, (bf16_t*)(a.ws + WS_W2 + (size_t)e * D * DEX), nullptr, DEX, D, D, DEX, 0, 0, 1};
}
constexpr int N_MOE_EARLY = 8 * 1792, N_MOE_LATE = 14 * 1792, N_MOE_W3_L0 = 2 * 1792;
__device__ __forceinline__ void moe_job_early(int item, const MkArgs& a, TrJob& J, int& local) { const int e = item / 1792; local = item - e * 1792; moe_job_of(e, 0, a, J); }
__device__ __forceinline__ void moe_job_late(int item, const MkArgs& a, TrJob& J, int& local) { const int job = item / 1792; local = item - job * 1792;
    if (job < 2) moe_job_of(job, 2, a, J); else moe_job_of(2 + ((job - 2) >> 1), 1 + ((job - 2) & 1), a, J); }
__device__ __forceinline__ void moe_job_w3l0(int item, const MkArgs& a, TrJob& J, int& local) { const int e = item / 1792; local = item - e * 1792; moe_job_of(e, 1, a, J); }
__device__ __forceinline__ void zero_rows(Frame& F, bf16_t* p, int rows, int cols, int ld) {
    const int per = cols / 8, n = rows * per;
    for (int i = F.vcu * (NWAVES * 64) + F.tid; i < n; i += F.G * NWAVES * 64) *(u32x4*)(p + (size_t)(i / per) * ld + (i % per) * 8) = (u32x4){0u, 0u, 0u, 0u};
}
template <bool F8, bool IN_BF16>
__device__ __forceinline__ void norm_row(const void* xrow, const u32x2 (&raw)[4], const float* g, bf16_t* orow, int lane, f32x4 (&v)[4]) {
    const f32x4* gr = (const f32x4*)g + lane; float ss = 0.f;
#pragma unroll
    for (int j = 0; j < 4; ++j) {
        if constexpr (IN_BF16) { const u32x2 w = raw[j]; v[j] = (f32x4){__uint_as_float(w.x << 16), __uint_as_float(w.x & 0xffff0000u), __uint_as_float(w.y << 16), __uint_as_float(w.y & 0xffff0000u)}; }
        else v[j] = *((const f32x4*)xrow + lane + 64 * j);
        ss += (v[j].x * v[j].x + v[j].y * v[j].y) + (v[j].z * v[j].z + v[j].w * v[j].w); }
    const float rs = rsqrtf(wave_sum(ss) * (1.0f / D) + EPS);
#pragma unroll
    for (int j = 0; j < 4; ++j) { const f32x4 gg = gr[64 * j]; v[j] = v[j] * rs * gg;
        if constexpr (F8) *(unsigned*)((unsigned char*)orow + 4 * (lane + 64 * j)) = pk4_fp8(v[j].x, v[j].y, v[j].z, v[j].w);
        else { u32x2 w; w.x = pk2(v[j].x, v[j].y); w.y = pk2(v[j].z, v[j].w); *(u32x2*)(orow + 4 * (lane + 64 * j)) = w; } }
}
__device__ __forceinline__ void stream_in_phase(Frame& F, const float* x, bf16_t* xs, float* ss) {
    const int gw = F.vcu * NWAVES + F.wave, NGW = F.G * NWAVES;
    for (int m = gw; m < T; m += NGW) { const f32x4* xr = (const f32x4*)(x + (size_t)m * D) + F.lane; f32x4 v[4]; float s = 0.f;
#pragma unroll
        for (int j = 0; j < 4; ++j) { v[j] = xr[64 * j]; s += (v[j].x * v[j].x + v[j].y * v[j].y) + (v[j].z * v[j].z + v[j].w * v[j].w); }
#pragma unroll
        for (int j = 0; j < 4; ++j) { u32x2 w; w.x = pk2(v[j].x, v[j].y); w.y = pk2(v[j].z, v[j].w); *(u32x2*)(xs + (size_t)m * D + 4 * (F.lane + 64 * j)) = w; }
        s = wave_sum(s);
        if (F.lane < 4) ss[(size_t)m * 4 + F.lane] = F.lane == 0 ? s : 0.f; }
}
constexpr int CW_PAIR = 12288, CW_TK = 20480;
constexpr size_t WS_ROUTE = WS_LIST + 4 * MiB;
__device__ __forceinline__ void norm_router_phase(Frame& F, const bf16_t* x, const float* g, bf16_t* out, const float* router, int* route_e, float* route_w) {
    const int RPB = T / F.G;
    volatile LAS int* lpair = (volatile LAS int*)(F.lds + RING_OFF);
    if (F.tid < 64) lpair[F.tid] = 0;
    __syncthreads();
    const int rpw = RPB / NWAVES;
    u32x2 nraw[4];
    { const u32x2* xr0 = (const u32x2*)(x + (size_t)(F.vcu * RPB + F.wave * rpw) * D) + F.lane;
#pragma unroll
      for (int j = 0; j < 4; ++j) nraw[j] = xr0[64 * j]; }
    for (int k = 0; k < rpw; ++k) {
        const int lr = F.wave * rpw + k, row = F.vcu * RPB + lr; f32x4 v[4]; u32x2 raw[4];
#pragma unroll
        for (int j = 0; j < 4; ++j) raw[j] = nraw[j];
        if (k + 1 < rpw) { const u32x2* xr1 = (const u32x2*)(x + (size_t)(row + 1) * D) + F.lane;
#pragma unroll
          for (int j = 0; j < 4; ++j) nraw[j] = xr1[64 * j]; }
        norm_row<true, true>(nullptr, raw, g, (bf16_t*)((unsigned char*)out + (size_t)row * D), F.lane, v);
        float p[8];
#pragma unroll
        for (int e = 0; e < 8; ++e) p[e] = 0.f;
#pragma unroll
        for (int j = 0; j < 4; ++j) { const f32x4* rr = (const f32x4*)(router + (size_t)(4 * (F.lane + 64 * j)) * 8);
#pragma unroll
            for (int c = 0; c < 4; ++c) { const f32x4 r0 = rr[2 * c], r1 = rr[2 * c + 1]; const float y = v[j][c];
                p[0] += y * r0.x; p[1] += y * r0.y; p[2] += y * r0.z; p[3] += y * r0.w; p[4] += y * r1.x; p[5] += y * r1.y; p[6] += y * r1.z; p[7] += y * r1.w; } }
#pragma unroll
        for (int e = 0; e < 8; ++e) p[e] = wave_sum(p[e]);
        if (F.lane == 0) {
            int i0 = 0; float v0 = p[0];
#pragma unroll
            for (int e = 1; e < 8; ++e) if (p[e] > v0) { v0 = p[e]; i0 = e; }
            int i1 = -1; float v1 = -3.0e38f;
#pragma unroll
            for (int e = 0; e < 8; ++e) if (e != i0 && p[e] > v1) { v1 = p[e]; i1 = e; }
            route_e[row] = i0 | (i1 << 4); route_w[row] = 1.0f / (1.0f + __expf(v1 - v0));
            __hip_atomic_fetch_add((LAS int*)&lpair[i0 * 8 + i1], 1, __ATOMIC_RELAXED, __HIP_MEMORY_SCOPE_WORKGROUP);
        }
    }
    __syncthreads();
    if (F.tid < 64 && lpair[F.tid] > 0) __hip_atomic_fetch_add(F.ctl + CW_PAIR + 64 * F.tid, (unsigned)lpair[F.tid], RLX_AGENT);
    __syncthreads();
}
__device__ __forceinline__ void route_assign_phase(Frame& F, const int* route_e, const float* route_w, int* list, float* wl) {
    const int RPB = T / F.G;
    volatile LAS int* pn = (volatile LAS int*)(F.lds + RING_OFF);
    volatile LAS int* sq = pn + 64; volatile LAS int* lp = pn + 128; volatile LAS int* lb = pn + 192; volatile LAS int* lc = pn + 256; volatile LAS int* lcb = pn + 272;
    if (F.tid < 64) { pn[F.tid] = (int)__hip_atomic_load(F.ctl + CW_PAIR + 64 * F.tid, RLX_AGENT); sq[F.tid] = 0; lp[F.tid] = 0; }
    if (F.tid < 16) lc[F.tid] = 0;
    __syncthreads();
    if (F.tid == 0) {
        int d[8], r[8], R = 0;
        for (int e = 0; e < 8; ++e) { int c = 0; for (int f = 0; f < 8; ++f) c += pn[e * 8 + f]; r[e] = c & 255; d[e] = r[e]; R += r[e]; }
        for (int m = R >> 8; m > 0; --m) { int be = -1, br = -1; for (int e = 0; e < 8; ++e) if (d[e] >= 0 && r[e] > br) { br = r[e]; be = e; } if (be < 0 || br <= 0) break; d[be] = r[be] - 256; r[be] = -1; }
        for (int e = 0; e < 8; ++e) for (int f = 0; f < 8 && d[e] > 0; ++f) if (f != e && d[f] < 0) { int take = d[e]; if (-d[f] < take) take = -d[f]; if (pn[e * 8 + f] < take) take = pn[e * 8 + f]; sq[e * 8 + f] = take; d[e] -= take; d[f] += take; }
    }
    __syncthreads();
    int e0 = 0, e1 = 1, pi = 0, li = 0; float w0 = 0.f;
    if (F.tid < RPB) { const int tok = F.vcu * RPB + F.tid; const int pe = route_e[tok]; e0 = pe & 15; e1 = pe >> 4; w0 = route_w[tok]; pi = e0 * 8 + e1;
        li = __hip_atomic_fetch_add((LAS int*)&lp[pi], 1, __ATOMIC_RELAXED, __HIP_MEMORY_SCOPE_WORKGROUP); }
    __syncthreads();
    if (F.tid < 64) lb[F.tid] = (lp[F.tid] > 0 && sq[F.tid] > 0) ? (int)__hip_atomic_fetch_add(F.ctl + CW_TK + 64 * F.tid, (unsigned)lp[F.tid], RLX_AGENT) : 0x40000000;
    __syncthreads();
    int p0 = 0, p1 = 0;
    if (F.tid < RPB) { if (lb[pi] + li < sq[pi]) { const int t = e0; e0 = e1; e1 = t; w0 = 1.0f - w0; }
        p0 = __hip_atomic_fetch_add((LAS int*)&lc[e0], 1, __ATOMIC_RELAXED, __HIP_MEMORY_SCOPE_WORKGROUP);
        p1 = __hip_atomic_fetch_add((LAS int*)&lc[8 + e1], 1, __ATOMIC_RELAXED, __HIP_MEMORY_SCOPE_WORKGROUP); }
    __syncthreads();
    if (F.tid < 16) lcb[F.tid] = (int)__hip_atomic_fetch_add(F.ctl + CW_CNT + 64 * F.tid, (unsigned)lc[F.tid], RLX_AGENT);
    __syncthreads();
    if (F.tid < RPB) { const int tok = F.vcu * RPB + F.tid; const size_t a0 = (size_t)e0 * T + lcb[e0] + p0, a1 = (size_t)(8 + e1) * T + lcb[8 + e1] + p1;
        list[a0] = tok; wl[a0] = w0; list[a1] = tok; wl[a1] = 1.0f - w0; }
    __syncthreads();
}
__device__ __forceinline__ void prepmix_token(const bf16_t* pr, const bf16_t* dr, const bf16_t* yc, bf16_t* mx, const float* g_a, const float* g_n, const float* g_c, int lane) {
    { const u32x2 hf = *(const u32x2*)(dr + 4 * lane), hb = *(const u32x2*)(dr + 256 + 4 * lane), ga = *(const u32x2*)(pr + C_GA + 4 * lane);
      float v[4];
      v[0] = (__uint_as_float(hf.x << 16) + __uint_as_float(hb.x << 16)) * gelu_tanh(__uint_as_float(ga.x << 16));
      v[1] = (__uint_as_float(hf.x & 0xffff0000u) + __uint_as_float(hb.x & 0xffff0000u)) * gelu_tanh(__uint_as_float(ga.x & 0xffff0000u));
      v[2] = (__uint_as_float(hf.y << 16) + __uint_as_float(hb.y << 16)) * gelu_tanh(__uint_as_float(ga.y << 16));
      v[3] = (__uint_as_float(hf.y & 0xffff0000u) + __uint_as_float(hb.y & 0xffff0000u)) * gelu_tanh(__uint_as_float(ga.y & 0xffff0000u));
      const float rs = rsqrtf(wave_sum(v[0] * v[0] + v[1] * v[1] + v[2] * v[2] + v[3] * v[3]) * (1.0f / 256.0f) + EPS);
      const f32x4 g = *(const f32x4*)(g_a + 4 * lane);
      u32x2 w; w.x = pk2(v[0] * rs * g.x, v[1] * rs * g.y); w.y = pk2(v[2] * rs * g.z, v[3] * rs * g.w); *(u32x2*)(mx + 4 * lane) = w; }
    { const u32x2 of = *(const u32x2*)(dr + 512 + 4 * lane), ob = *(const u32x2*)(dr + 768 + 4 * lane), hg = *(const u32x2*)(pr + C_HG + 4 * lane);
      float v[4];
      v[0] = __uint_as_float(of.x << 16) + __uint_as_float(ob.x << 16); v[1] = __uint_as_float(of.x & 0xffff0000u) + __uint_as_float(ob.x & 0xffff0000u);
      v[2] = __uint_as_float(of.y << 16) + __uint_as_float(ob.y << 16); v[3] = __uint_as_float(of.y & 0xffff0000u) + __uint_as_float(ob.y & 0xffff0000u);
      float ss = v[0] * v[0] + v[1] * v[1] + v[2] * v[2] + v[3] * v[3];
      ss += xor_shfl<1>(ss); ss += xor_shfl<2>(ss); ss += xor_shfl<4>(ss); ss += xor_shfl<8>(ss);
      const float rs = rsqrtf(ss * (1.0f / 64.0f) + EPS);
      const f32x4 g = *(const f32x4*)(g_n + 4 * (lane & 15));
      u32x2 w; w.x = pk2(v[0] * rs * g.x * siluf_(__uint_as_float(hg.x << 16)), v[1] * rs * g.y * siluf_(__uint_as_float(hg.x & 0xffff0000u)));
      w.y = pk2(v[2] * rs * g.z * siluf_(__uint_as_float(hg.y << 16)), v[3] * rs * g.w * siluf_(__uint_as_float(hg.y & 0xffff0000u)));
      *(u32x2*)(mx + 256 + 4 * lane) = w; }
    { const u32x4 y = *(const u32x4*)yc;
      float v[8] = {__uint_as_float(y.x << 16), __uint_as_float(y.x & 0xffff0000u), __uint_as_float(y.y << 16), __uint_as_float(y.y & 0xffff0000u),
                    __uint_as_float(y.z << 16), __uint_as_float(y.z & 0xffff0000u), __uint_as_float(y.w << 16), __uint_as_float(y.w & 0xffff0000u)};
      float ss = 0.f;
#pragma unroll
      for (int i = 0; i < 8; ++i) ss += v[i] * v[i];
      const float rs = rsqrtf(wave_sum(ss) * (1.0f / 512.0f) + EPS);
      const f32x4 g0 = *(const f32x4*)(g_c + 8 * lane), g1 = *(const f32x4*)(g_c + 8 * lane + 4);
      u32x4 w; w.x = pk2(v[0] * rs * g0.x, v[1] * rs * g0.y); w.y = pk2(v[2] * rs * g0.z, v[3] * rs * g0.w); w.z = pk2(v[4] * rs * g1.x, v[5] * rs * g1.y); w.w = pk2(v[6] * rs * g1.z, v[7] * rs * g1.w);
      *(u32x4*)(mx + 512 + 8 * lane) = w; }
}
__device__ __forceinline__ pg8::MoeMap moe_map_setup(Frame& F, int rank, int& ntiles) {
    volatile LAS int* tp = (volatile LAS int*)(F.MISC + 16);
    __syncthreads();
    if (F.tid < 8) tp[9 + F.tid] = (int)__hip_atomic_load(F.ctl + CW_CNT + 64 * (rank * 8 + F.tid), RLX_AGENT);
    __syncthreads();
    if (F.tid == 0) { int acc = 0; for (int e = 0; e < 8; ++e) { tp[e] = acc; acc += (tp[9 + e] + 255) >> 8; } tp[8] = acc; }
    __syncthreads();
    ntiles = tp[8];
    pg8::MoeMap mm; mm.tp = (const LAS int*)(F.lds + MISC_OFF + 64); return mm;
}

namespace att {
constexpr int DQK = 96, DV = 64, NW = 8, QBLK = 32, KVBLK = 64, LDQ = 96, LDK = 96, LDV = 64;
constexpr float SCALE = 0.10206207261596575f;
constexpr float QSCALE = SCALE * 1.4426950408889634f;
constexpr size_t SHM_V = 16384, SHM_K = 16384, SHM_ATTN = 2 * SHM_V + 2 * SHM_K + NW * 64 * 4;
using s16x4 = __attribute__((ext_vector_type(4))) short;
#define KSWZ(row, colB) ((row) * 256 + ((colB) ^ (((row) & 7) << 4)))
#define SBAR() __builtin_amdgcn_sched_barrier(0)
__device__ __forceinline__ int crow(int r, int hi) { return (r & 3) + 8 * (r >> 2) + 4 * hi; }
__device__ __forceinline__ unsigned cvtpk(float lo, float hi) { unsigned r; asm volatile("v_cvt_pk_bf16_f32 %0, %1, %2" : "=v"(r) : "v"(lo), "v"(hi)); return r; }
template <bool SHIFT> __device__ __forceinline__ void expsum(f32x16& p0, f32x16& p1, float& l_reg, float negM) {
  float ps = 0;
#pragma unroll
  for (int r = 0; r < 16; ++r) { p0[r] = __builtin_amdgcn_exp2f(SHIFT ? p0[r] + negM : p0[r]); ps += p0[r]; }
#pragma unroll
  for (int r = 0; r < 16; ++r) { p1[r] = __builtin_amdgcn_exp2f(SHIFT ? p1[r] + negM : p1[r]); ps += p1[r]; }
  l_reg += ps;
}
__device__ __forceinline__ void packP(const f32x16& p0, const f32x16& p1, bf16x8& pa0, bf16x8& pa1, bf16x8& pa2, bf16x8& pa3) {
#define PK4(P, BASE, OUT) do { unsigned a0 = cvtpk(P[BASE + 0], P[BASE + 1]), a1 = cvtpk(P[BASE + 2], P[BASE + 3]);   \
    unsigned b0 = cvtpk(P[BASE + 4], P[BASE + 5]), b1 = cvtpk(P[BASE + 6], P[BASE + 7]);                              \
    auto r0 = __builtin_amdgcn_permlane32_swap(a0, b0, false, false); auto r1 = __builtin_amdgcn_permlane32_swap(a1, b1, false, false); \
    u32x4 w = {r0[0], r1[0], r0[1], r1[1]}; OUT = *reinterpret_cast<bf16x8*>(&w); } while (0)
  PK4(p0, 0, pa0); PK4(p0, 8, pa1); PK4(p1, 0, pa2); PK4(p1, 8, pa3);
#undef PK4
}
__device__ __forceinline__ void qkt(f32x16& p0, f32x16& p1, const char* Ks, const bf16x8* qr, int r32, int hi) {
  p0 = f32x16{}; p1 = f32x16{};
#pragma unroll
  for (int d0 = 0; d0 < 6; ++d0) { int cb = (d0 * 16 + hi * 8) * 2;
    bf16x8 b0 = *reinterpret_cast<const bf16x8*>(Ks + KSWZ(r32, cb));
    bf16x8 b1 = *reinterpret_cast<const bf16x8*>(Ks + KSWZ(32 + r32, cb));
    p0 = __builtin_amdgcn_mfma_f32_32x32x16_bf16(b0, qr[d0], p0, 0, 0, 0);
    p1 = __builtin_amdgcn_mfma_f32_32x32x16_bf16(b1, qr[d0], p1, 0, 0, 0); }
}
__device__ __forceinline__ int v_st(int k, int c) { const int kk = (k & ~0xC) | ((k & 4) << 1) | ((k & 8) >> 1); return ((kk >> 3) * 4 + (c >> 5)) * 512 + ((kk & 7) * 32 + (c & 31)) * 2; }
__device__ __forceinline__ int v_rd_base(int lane) { return ((lane & 3) << 3) | (((lane >> 2) & 3) << 6) | (((lane >> 4) & 1) << 5) | (((lane >> 5) & 1) << 8); }
constexpr int v_rd_off(int d0, int ks, int half) { return d0 * 512 + ks * 4096 + half * 2048; }
template <int OFF> __device__ __forceinline__ s16x4 tr_read(int vb) {
  s16x4 r; asm volatile("ds_read_b64_tr_b16 %0, %1 offset:%2" : "=&v"(r) : "v"(vb), "i"(OFF) : "memory"); return r;
}
template <int D0> __device__ __forceinline__ void pv_one(f32x16& od, int vb, bf16x8 pa0, bf16x8 pa1, bf16x8 pa2, bf16x8 pa3) {
  const s16x4 l0 = tr_read<v_rd_off(D0, 0, 0)>(vb), h0 = tr_read<v_rd_off(D0, 0, 1)>(vb), l1 = tr_read<v_rd_off(D0, 1, 0)>(vb), h1 = tr_read<v_rd_off(D0, 1, 1)>(vb);
  const s16x4 l2 = tr_read<v_rd_off(D0, 2, 0)>(vb), h2 = tr_read<v_rd_off(D0, 2, 1)>(vb), l3 = tr_read<v_rd_off(D0, 3, 0)>(vb), h3 = tr_read<v_rd_off(D0, 3, 1)>(vb);
  asm volatile("s_waitcnt lgkmcnt(0)" ::: "memory"); SBAR();
#define PK(L, H) (bf16x8){L[0], L[1], L[2], L[3], H[0], H[1], H[2], H[3]}
  od = __builtin_amdgcn_mfma_f32_32x32x16_bf16(pa0, PK(l0, h0), od, 0, 0, 0);
  od = __builtin_amdgcn_mfma_f32_32x32x16_bf16(pa1, PK(l1, h1), od, 0, 0, 0);
  od = __builtin_amdgcn_mfma_f32_32x32x16_bf16(pa2, PK(l2, h2), od, 0, 0, 0);
  od = __builtin_amdgcn_mfma_f32_32x32x16_bf16(pa3, PK(l3, h3), od, 0, 0, 0);
#undef PK
}
__device__ __forceinline__ void pv_d0(f32x16* o, int vb, bf16x8 pa0, bf16x8 pa1, bf16x8 pa2, bf16x8 pa3) {
  pv_one<0>(o[0], vb, pa0, pa1, pa2, pa3); pv_one<1>(o[1], vb, pa0, pa1, pa2, pa3);
}
__device__ __forceinline__ unsigned cvtpk_s(float lo, float hi) { unsigned r; asm("v_cvt_pk_bf16_f32 %0, %1, %2" : "=v"(r) : "v"(lo), "v"(hi)); return r; }
template <bool SHIFT> __device__ __forceinline__ void exp_chunk(f32x16& p, int lo, int hi, float& ps, float negM) {
#pragma unroll
  for (int r = 0; r < 16; ++r) if (r >= lo && r < hi) { p[r] = __builtin_amdgcn_exp2f(SHIFT ? p[r] + negM : p[r]); ps += p[r]; }
}
__device__ __forceinline__ bf16x8 pack8(const f32x16& P, int base) {
  const unsigned a0 = cvtpk_s(P[base + 0], P[base + 1]), a1 = cvtpk_s(P[base + 2], P[base + 3]), b0 = cvtpk_s(P[base + 4], P[base + 5]), b1 = cvtpk_s(P[base + 6], P[base + 7]);
  auto r0 = __builtin_amdgcn_permlane32_swap(a0, b0, false, false); auto r1 = __builtin_amdgcn_permlane32_swap(a1, b1, false, false);
  u32x4 w = {r0[0], r1[0], r0[1], r1[1]}; return *reinterpret_cast<bf16x8*>(&w);
}
template <bool SHIFT, bool QK, bool PV> __device__ __forceinline__ void pipe_iter(f32x16 (&sn)[2], f32x16 (&sc)[2], const bf16x8 (&pp)[4], bf16x8 (&pn)[4], f32x16* o, const char* Kn, int vbp,
                                                                                   const bf16x8* qr, int r32, int hi, float& l_reg, float negM) {
  float ps = 0.f;
  if constexpr (QK) {
    sn[0] = f32x16{}; sn[1] = f32x16{};
#pragma unroll
    for (int d0 = 0; d0 < 6; ++d0) { const int cb = (d0 * 16 + hi * 8) * 2;
      const bf16x8 kb0 = *reinterpret_cast<const bf16x8*>(Kn + KSWZ(r32, cb)), kb1 = *reinterpret_cast<const bf16x8*>(Kn + KSWZ(32 + r32, cb));
      sn[0] = __builtin_amdgcn_mfma_f32_32x32x16_bf16(kb0, qr[d0], sn[0], 0, 0, 0);
      sn[1] = __builtin_amdgcn_mfma_f32_32x32x16_bf16(kb1, qr[d0], sn[1], 0, 0, 0);
      if (d0 < 3) exp_chunk<SHIFT>(sc[0], d0 == 0 ? 0 : (d0 == 1 ? 6 : 11), d0 == 0 ? 6 : (d0 == 1 ? 11 : 16), ps, negM);
      else        exp_chunk<SHIFT>(sc[1], d0 == 3 ? 0 : (d0 == 4 ? 6 : 11), d0 == 3 ? 6 : (d0 == 4 ? 11 : 16), ps, negM);
      SBAR();
    }
  } else { exp_chunk<SHIFT>(sc[0], 0, 16, ps, negM); exp_chunk<SHIFT>(sc[1], 0, 16, ps, negM); }
  l_reg += ps;
  if constexpr (PV) {
#define PK(L, H) (bf16x8){L[0], L[1], L[2], L[3], H[0], H[1], H[2], H[3]}
    { const s16x4 l0 = tr_read<v_rd_off(0, 0, 0)>(vbp), h0 = tr_read<v_rd_off(0, 0, 1)>(vbp), l1 = tr_read<v_rd_off(0, 1, 0)>(vbp), h1 = tr_read<v_rd_off(0, 1, 1)>(vbp);
      const s16x4 l2 = tr_read<v_rd_off(0, 2, 0)>(vbp), h2 = tr_read<v_rd_off(0, 2, 1)>(vbp), l3 = tr_read<v_rd_off(0, 3, 0)>(vbp), h3 = tr_read<v_rd_off(0, 3, 1)>(vbp);
      asm volatile("s_waitcnt lgkmcnt(0)" ::: "memory"); SBAR();
      o[0] = __builtin_amdgcn_mfma_f32_32x32x16_bf16(pp[0], PK(l0, h0), o[0], 0, 0, 0);
      o[0] = __builtin_amdgcn_mfma_f32_32x32x16_bf16(pp[1], PK(l1, h1), o[0], 0, 0, 0);
      pn[0] = pack8(sc[0], 0); SBAR();
      o[0] = __builtin_amdgcn_mfma_f32_32x32x16_bf16(pp[2], PK(l2, h2), o[0], 0, 0, 0);
      o[0] = __builtin_amdgcn_mfma_f32_32x32x16_bf16(pp[3], PK(l3, h3), o[0], 0, 0, 0);
      pn[1] = pack8(sc[0], 8); SBAR(); }
    { const s16x4 l0 = tr_read<v_rd_off(1, 0, 0)>(vbp), h0 = tr_read<v_rd_off(1, 0, 1)>(vbp), l1 = tr_read<v_rd_off(1, 1, 0)>(vbp), h1 = tr_read<v_rd_off(1, 1, 1)>(vbp);
      const s16x4 l2 = tr_read<v_rd_off(1, 2, 0)>(vbp), h2 = tr_read<v_rd_off(1, 2, 1)>(vbp), l3 = tr_read<v_rd_off(1, 3, 0)>(vbp), h3 = tr_read<v_rd_off(1, 3, 1)>(vbp);
      asm volatile("s_waitcnt lgkmcnt(0)" ::: "memory"); SBAR();
      o[1] = __builtin_amdgcn_mfma_f32_32x32x16_bf16(pp[0], PK(l0, h0), o[1], 0, 0, 0);
      o[1] = __builtin_amdgcn_mfma_f32_32x32x16_bf16(pp[1], PK(l1, h1), o[1], 0, 0, 0);
      pn[2] = pack8(sc[1], 0); SBAR();
      o[1] = __builtin_amdgcn_mfma_f32_32x32x16_bf16(pp[2], PK(l2, h2), o[1], 0, 0, 0);
      o[1] = __builtin_amdgcn_mfma_f32_32x32x16_bf16(pp[3], PK(l3, h3), o[1], 0, 0, 0);
      pn[3] = pack8(sc[1], 8); SBAR(); }
#undef PK
  } else { pn[0] = pack8(sc[0], 0); pn[1] = pack8(sc[0], 8); pn[2] = pack8(sc[1], 0); pn[3] = pack8(sc[1], 8); }
}
template <bool SHIFT> __device__ __forceinline__ void attn_unit(const bf16_t* __restrict__ Qb, const bf16_t* __restrict__ Kh, const bf16_t* __restrict__ Vh, bf16_t* __restrict__ Ob, int ldo, int seq, float negM, char* lds, int wv) {
  const int tid = launder(tid_of(wv)), wid = tid >> 6, lane = tid & 63, r32 = lane & 31, hi = lane >> 5;
  if (__builtin_amdgcn_readfirstlane(wid) >= 4) __builtin_amdgcn_s_setprio(1);
  char* V_lds = lds; char* K_lds = lds + 2 * SHM_V;
  float* ws = (float*)(lds + 2 * SHM_V + 2 * SHM_K) + wid * 64; float* li_l = ws;
  float l_reg = 0; f32x16 o[2] = {}; bf16x8 qr[6];
  const bf16_t* Qw = Qb + (long)(wid * QBLK + r32) * LDQ + hi * 8;
#pragma unroll
  for (int d0 = 0; d0 < 6; ++d0) qr[d0] = *reinterpret_cast<const bf16x8*>(Qw + d0 * 16);
  const int sr = tid >> 4, sc = (tid & 15) * 8, vst0 = v_st(sr, sc & 63), vst1 = v_st(32 + sr, sc & 63);
  const bool kact = sc < DQK, vact = sc < DV;
  const int vb0 = (int)(uintptr_t)V_lds + v_rd_base(lane);
  const int NT = seq / KVBLK;
  struct { bf16x8 vs0, vs1, ks0, ks1; } sr_[1];
#define SLOAD(i, kt, vt) do { const int _k0 = ((kt) < NT ? (kt) : NT - 1) * KVBLK, _v0 = ((vt) < NT ? (vt) : NT - 1) * KVBLK; \
    if (vact) { sr_[i].vs0 = *reinterpret_cast<const bf16x8*>(&Vh[(long)(_v0 + sr) * LDV + sc]); sr_[i].vs1 = *reinterpret_cast<const bf16x8*>(&Vh[(long)(_v0 + 32 + sr) * LDV + sc]); } \
    if (kact) { sr_[i].ks0 = *reinterpret_cast<const bf16x8*>(&Kh[(long)(_k0 + sr) * LDK + sc]); sr_[i].ks1 = *reinterpret_cast<const bf16x8*>(&Kh[(long)(_k0 + 32 + sr) * LDK + sc]); } } while (0)
#define SWRITE_K(b, i) do { if (kact) { int kc = sc * 2; *(bf16x8*)(K_lds + (b) * SHM_K + KSWZ(sr, kc)) = sr_[i].ks0; *(bf16x8*)(K_lds + (b) * SHM_K + KSWZ(32 + sr, kc)) = sr_[i].ks1; } } while (0)
#define SWRITE_V(b, i) do { if (vact) { *(bf16x8*)(V_lds + (b) * SHM_V + vst0) = sr_[i].vs0; *(bf16x8*)(V_lds + (b) * SHM_V + vst1) = sr_[i].vs1; } } while (0)
#define SWAIT() asm volatile("s_waitcnt vmcnt(0)" ::: "memory")
  f32x16 sA[2], sB[2]; bf16x8 pX[4], pY[4];
  SLOAD(0, 0, 0); asm volatile("s_waitcnt vmcnt(0)" ::: "memory"); SWRITE_K(0, 0); SWRITE_V(0, 0);
  SLOAD(0, 1, 1); asm volatile("s_waitcnt vmcnt(0)" ::: "memory"); SWRITE_K(1, 0);
  __syncthreads();
  { sA[0] = f32x16{}; sA[1] = f32x16{};
#pragma unroll
    for (int d0 = 0; d0 < 6; ++d0) { const int cb = (d0 * 16 + hi * 8) * 2;
      const bf16x8 b0 = *reinterpret_cast<const bf16x8*>(K_lds + KSWZ(r32, cb)), b1 = *reinterpret_cast<const bf16x8*>(K_lds + KSWZ(32 + r32, cb));
      sA[0] = __builtin_amdgcn_mfma_f32_32x32x16_bf16(b0, qr[d0], sA[0], 0, 0, 0); sA[1] = __builtin_amdgcn_mfma_f32_32x32x16_bf16(b1, qr[d0], sA[1], 0, 0, 0); } }
  SLOAD(0, 2, 1); SBAR(); pipe_iter<SHIFT, true, false>(sB, sA, pY, pX, o, K_lds + SHM_K, 0, qr, r32, hi, l_reg, negM); SBAR();
  __syncthreads(); SWAIT(); SWRITE_K(0, 0); SWRITE_V(1, 0); __syncthreads();
  for (int t = 1; t + 1 < NT; t += 2) {
    SLOAD(0, t + 2, t + 1); SBAR(); pipe_iter<SHIFT, true, true>(sA, sB, pX, pY, o, K_lds, vb0, qr, r32, hi, l_reg, negM); SBAR();
    __syncthreads(); SWAIT(); SWRITE_K(1, 0); SWRITE_V(0, 0); __syncthreads();
    SLOAD(0, t + 3, t + 2); SBAR(); pipe_iter<SHIFT, true, true>(sB, sA, pY, pX, o, K_lds + SHM_K, vb0 + (int)SHM_V, qr, r32, hi, l_reg, negM); SBAR();
    __syncthreads(); SWAIT(); SWRITE_K(0, 0); SWRITE_V(1, 0); __syncthreads();
  }
  SBAR(); pipe_iter<SHIFT, false, true>(sA, sB, pX, pY, o, K_lds, vb0, qr, r32, hi, l_reg, negM);
  pv_d0(o, vb0 + (int)SHM_V, pY[0], pY[1], pY[2], pY[3]);
  { auto rr = __builtin_amdgcn_permlane32_swap(__float_as_uint(l_reg), __float_as_uint(l_reg), false, false); l_reg = __uint_as_float(rr[0]) + __uint_as_float(rr[1]); }
  if (hi == 0) li_l[r32] = l_reg; asm volatile("s_waitcnt lgkmcnt(0)" ::: "memory");
  float rli[16];
#pragma unroll
  for (int r = 0; r < 16; ++r) rli[r] = __builtin_amdgcn_rcpf(li_l[crow(r, hi)]);
  bf16_t* Ow = Ob + (long)(wid * QBLK) * ldo;
#pragma unroll
  for (int r = 0; r < 16; ++r) { int orow = crow(r, hi);
#pragma unroll
    for (int d0 = 0; d0 < 2; ++d0) Ow[(long)orow * ldo + d0 * 32 + r32] = (bf16_t)f2bf(o[d0][r] * rli[r]); }
  __builtin_amdgcn_s_setprio(0);
  __syncthreads();
#undef SLOAD
#undef SWRITE_K
#undef SWRITE_V
#undef SWAIT
}
#undef KSWZ
#undef SBAR
}
namespace mla {
__device__ __forceinline__ int crow(int r, int hi) { return (r & 3) + 8 * (r >> 2) + 4 * hi; }
__device__ __forceinline__ float half_swap_sum(float v) { auto rr = __builtin_amdgcn_permlane32_swap(__float_as_uint(v), __float_as_uint(v), false, false); return __uint_as_float(rr[0]) + __uint_as_float(rr[1]); }
__device__ __forceinline__ float sumsq8(bf16x8 v) { float s = 0.f;
#pragma unroll
    for (int j = 0; j < 8; ++j) { const float f = bf2f((bf16_t)v[j]); s += f * f; } return s; }
__device__ __forceinline__ unsigned pk2rne(float lo, float hi) { unsigned r; asm volatile("v_cvt_pk_bf16_f32 %0, %1, %2" : "=v"(r) : "v"(lo), "v"(hi)); return r; }
__device__ __forceinline__ void store_blk(bf16_t* p  , const float (&v)[16]) {
#pragma unroll
    for (int q4 = 0; q4 < 4; ++q4) { u32x2 w; w.x = pk2rne(v[4 * q4], v[4 * q4 + 1]); w.y = pk2rne(v[4 * q4 + 2], v[4 * q4 + 3]); *(u32x2*)(p + 8 * q4) = w; }
}
__device__ __forceinline__ void rope_regs(float (&v)[16], const float (&cs)[8], const float (&sn)[8]) {
#pragma unroll
    for (int r = 0; r < 8; ++r) { const float x1 = v[r], x2 = v[r + 8]; v[r] = x1 * cs[r] - x2 * sn[r]; v[r + 8] = x2 * cs[r] + x1 * sn[r]; }
}
constexpr int QP = 528, KP = 272, L_WQ = 0, L_WKV = 96 * QP, L_END = L_WKV + 128 * KP, L_CS = L_END;
__device__ __forceinline__ void stage_load(int hd, int tid, const bf16_t* Wuq_t, const bf16_t* Wukv_t, u32x4 (&pq)[6], u32x4 (&pk)[4]) {
#pragma unroll
    for (int i = 0; i < 6; ++i) { const int id = tid + 512 * i; pq[i] = *(const u32x4*)(Wuq_t + (size_t)(hd * 96 + (id >> 5)) * 256 + (id & 31) * 8); }
#pragma unroll
    for (int i = 0; i < 4; ++i) { const int id = tid + 512 * i; pk[i] = *(const u32x4*)(Wukv_t + (size_t)(hd * 128 + (id >> 4)) * 128 + (id & 15) * 8); }
}
__device__ __forceinline__ void stage_store(int tid, const u32x4 (&pq)[6], const u32x4 (&pk)[4], char* lds) {
#pragma unroll
    for (int i = 0; i < 6; ++i) { const int id = tid + 512 * i; *(u32x4*)(lds + L_WQ + (id >> 5) * QP + (id & 31) * 16) = pq[i]; }
#pragma unroll
    for (int i = 0; i < 4; ++i) { const int id = tid + 512 * i; *(u32x4*)(lds + L_WKV + (id >> 4) * KP + (id & 15) * 16) = pk[i]; }
}
__device__ __forceinline__ void q_path(int tid, int tok, int r32, int hi, const bf16_t* pr, const bf16_t* Wuq_t, const bf16_t* Wukv_t, const float* gq, bf16_t* Qo, char* lds) {
    bf16x8 xt[16]; float ss = 0.f;
#pragma unroll
    for (int s = 0; s < 16; ++s) { xt[s] = *(const bf16x8*)(pr + C_CQ + 16 * s + 8 * hi); ss += sumsq8(xt[s]); }
    const float rs_in = rsqrtf(half_swap_sum(ss) * (1.0f / 256.0f) + EPS);
    u32x4 pq[6], pk[4]; stage_load(0, tid, Wuq_t, Wukv_t, pq, pk);
#pragma unroll 1
    for (int hd = 0; hd < 8; ++hd) {
        lds_barrier(); stage_store(tid, pq, pk, lds); lds_barrier(); if (hd < 7) stage_load(hd + 1, tid, Wuq_t, Wukv_t, pq, pk);
        f32x16 acc[3];
#pragma unroll
        for (int cb = 0; cb < 3; ++cb) acc[cb] = f32x16{};
        { bf16x8 wf[3], wn[3];
#pragma unroll
          for (int cb = 0; cb < 3; ++cb) wf[cb] = *(const bf16x8*)(lds + L_WQ + (cb * 32 + r32) * QP + 16 * hi);
#pragma unroll
          for (int s = 0; s < 16; ++s) {
#pragma unroll
            for (int cb = 0; cb < 3; ++cb) wn[cb] = (s + 1 < 16) ? *(const bf16x8*)(lds + L_WQ + (cb * 32 + r32) * QP + 16 * hi + 32 * (s + 1)) : wf[cb];
            __builtin_amdgcn_sched_barrier(0);
#pragma unroll
            for (int cb = 0; cb < 3; ++cb) acc[cb] = __builtin_amdgcn_mfma_f32_32x32x16_bf16(wf[cb], xt[s], acc[cb], 0, 0, 0);
#pragma unroll
            for (int cb = 0; cb < 3; ++cb) wf[cb] = wn[cb];
            __builtin_amdgcn_sched_barrier(0); } }
        float ss2 = 0.f;
#pragma unroll
        for (int cb = 0; cb < 3; ++cb)
#pragma unroll
            for (int r = 0; r < 16; ++r) { acc[cb][r] *= rs_in; ss2 += acc[cb][r] * acc[cb][r]; }
        const float r2 = rsqrtf(half_swap_sum(ss2) * (1.0f / 96.0f) + EPS) * att::QSCALE;
        bf16_t* qrow = Qo + ((size_t)((tok >> 11) * 8 + hd) * SEQ + (tok & (SEQ - 1))) * 96 + 4 * hi;
#pragma unroll
        for (int cb = 0; cb < 3; ++cb) { float v[16];
#pragma unroll
            for (int q4 = 0; q4 < 4; ++q4) { const f32x4 g = *(const f32x4*)(gq + cb * 32 + 8 * q4 + 4 * hi);
                v[4 * q4] = acc[cb][4 * q4] * r2 * g.x; v[4 * q4 + 1] = acc[cb][4 * q4 + 1] * r2 * g.y; v[4 * q4 + 2] = acc[cb][4 * q4 + 2] * r2 * g.z; v[4 * q4 + 3] = acc[cb][4 * q4 + 3] * r2 * g.w; }
            if (cb == 2) { float cs[8], sn[8]; { const f32x4* cp = (const f32x4*)(lds + L_CS + tid * 64); const f32x4 c0 = cp[0], c1 = cp[1], s0 = cp[2], s1 = cp[3];
                cs[0] = c0.x; cs[1] = c0.y; cs[2] = c0.z; cs[3] = c0.w; cs[4] = c1.x; cs[5] = c1.y; cs[6] = c1.z; cs[7] = c1.w; sn[0] = s0.x; sn[1] = s0.y; sn[2] = s0.z; sn[3] = s0.w; sn[4] = s1.x; sn[5] = s1.y; sn[6] = s1.z; sn[7] = s1.w; }
                rope_regs(v, cs, sn); }
            store_blk(qrow + cb * 32, v); }
    }
}
__device__ __forceinline__ void kv_path(int tid, int tok, int r32, int hi, const bf16_t* pr, const bf16_t* Wuq_t, const bf16_t* Wukv_t, const float* gk, bf16_t* Ko, bf16_t* Vo, char* lds) {
    bf16x8 xt[8]; float ss = 0.f;
#pragma unroll
    for (int s = 0; s < 8; ++s) { xt[s] = *(const bf16x8*)(pr + C_CKV + 16 * s + 8 * hi); ss += sumsq8(xt[s]); }
    const float rs_in = rsqrtf(half_swap_sum(ss) * (1.0f / 128.0f) + EPS);
    float kr[16], sskr = 0.f;
#pragma unroll
    for (int q4 = 0; q4 < 4; ++q4) { const u32x2 w = *(const u32x2*)(pr + C_KR + 8 * q4 + 4 * hi);
        kr[4 * q4] = __uint_as_float(w.x << 16); kr[4 * q4 + 1] = __uint_as_float(w.x & 0xffff0000u); kr[4 * q4 + 2] = __uint_as_float(w.y << 16); kr[4 * q4 + 3] = __uint_as_float(w.y & 0xffff0000u); }
#pragma unroll
    for (int r = 0; r < 16; ++r) sskr += kr[r] * kr[r];
    u32x4 pq[6], pk[4]; stage_load(0, tid, Wuq_t, Wukv_t, pq, pk);
#pragma unroll 1
    for (int hd = 0; hd < 8; ++hd) {
        lds_barrier(); stage_store(tid, pq, pk, lds); lds_barrier(); if (hd < 7) stage_load(hd + 1, tid, Wuq_t, Wukv_t, pq, pk);
        f32x16 acc[4];
#pragma unroll
        for (int cb = 0; cb < 4; ++cb) acc[cb] = f32x16{};
        { bf16x8 wf[4], wn[4];
#pragma unroll
          for (int cb = 0; cb < 4; ++cb) wf[cb] = *(const bf16x8*)(lds + L_WKV + (cb * 32 + r32) * KP + 16 * hi);
#pragma unroll
          for (int s = 0; s < 8; ++s) {
#pragma unroll
            for (int cb = 0; cb < 4; ++cb) wn[cb] = (s + 1 < 8) ? *(const bf16x8*)(lds + L_WKV + (cb * 32 + r32) * KP + 16 * hi + 32 * (s + 1)) : wf[cb];
            __builtin_amdgcn_sched_barrier(0);
#pragma unroll
            for (int cb = 0; cb < 4; ++cb) acc[cb] = __builtin_amdgcn_mfma_f32_32x32x16_bf16(wf[cb], xt[s], acc[cb], 0, 0, 0);
#pragma unroll
            for (int cb = 0; cb < 4; ++cb) wf[cb] = wn[cb];
            __builtin_amdgcn_sched_barrier(0); } }
        float ssk = sskr;
#pragma unroll
        for (int cb = 0; cb < 4; ++cb)
#pragma unroll
            for (int r = 0; r < 16; ++r) { acc[cb][r] *= rs_in; if (cb < 2) ssk += acc[cb][r] * acc[cb][r]; }
        const float rk = rsqrtf(half_swap_sum(ssk) * (1.0f / 96.0f) + EPS);
        bf16_t* krow = Ko + ((size_t)((tok >> 11) * 8 + hd) * SEQ + (tok & (SEQ - 1))) * 96 + 4 * hi; bf16_t* vrow = Vo + ((size_t)((tok >> 11) * 8 + hd) * SEQ + (tok & (SEQ - 1))) * 64 + 4 * hi;
#pragma unroll
        for (int cb = 0; cb < 3; ++cb) { float v[16];
#pragma unroll
            for (int q4 = 0; q4 < 4; ++q4) { const f32x4 g = *(const f32x4*)(gk + cb * 32 + 8 * q4 + 4 * hi);
#pragma unroll
                for (int c = 0; c < 4; ++c) { const float x = (cb < 2) ? acc[cb < 2 ? cb : 0][4 * q4 + c] : kr[4 * q4 + c]; v[4 * q4 + c] = x * rk * g[c]; } }
            if (cb == 2) { float cs[8], sn[8]; { const f32x4* cp = (const f32x4*)(lds + L_CS + tid * 64); const f32x4 c0 = cp[0], c1 = cp[1], s0 = cp[2], s1 = cp[3];
                cs[0] = c0.x; cs[1] = c0.y; cs[2] = c0.z; cs[3] = c0.w; cs[4] = c1.x; cs[5] = c1.y; cs[6] = c1.z; cs[7] = c1.w; sn[0] = s0.x; sn[1] = s0.y; sn[2] = s0.z; sn[3] = s0.w; sn[4] = s1.x; sn[5] = s1.y; sn[6] = s1.z; sn[7] = s1.w; }
                rope_regs(v, cs, sn); }
            store_blk(krow + cb * 32, v); }
#pragma unroll
        for (int cb = 2; cb < 4; ++cb) { float v[16];
#pragma unroll
            for (int r = 0; r < 16; ++r) v[r] = acc[cb][r];
            store_blk(vrow + (cb - 2) * 32, v); }
    }
}
__device__ __forceinline__ void block_item(int blk, const bf16_t* PROJ, const int* positions, const bf16_t* Wuq_t, const bf16_t* Wukv_t, const float* gq, const float* gk, bf16_t* Qo, bf16_t* Ko, bf16_t* Vo, char* lds, int wv) {
    const int tid = launder(tid_of(wv)), wave = tid >> 6, lane = tid & 63, r32 = lane & 31, hi = lane >> 5;
    const int tile = blk * 4 + (wave & 3), tok = tile * 32 + r32;
    const bf16_t* pr = PROJ + (size_t)tok * DINP;
    { float cs[8], sn[8]; const int pos = positions[tok];
#pragma unroll
      for (int r = 0; r < 8; ++r) rope_cs(pos, crow(r, hi), cs[r], sn[r]);
      f32x4* cp = (f32x4*)(lds + L_CS + tid * 64);
      cp[0] = (f32x4){cs[0], cs[1], cs[2], cs[3]}; cp[1] = (f32x4){cs[4], cs[5], cs[6], cs[7]}; cp[2] = (f32x4){sn[0], sn[1], sn[2], sn[3]}; cp[3] = (f32x4){sn[4], sn[5], sn[6], sn[7]}; }
    if (wave < 4) q_path(tid, tok, r32, hi, pr, Wuq_t, Wukv_t, gq, Qo, lds);
    else kv_path(tid, tok, r32, hi, pr, Wuq_t, Wukv_t, gk, Ko, Vo, lds);
    __syncthreads();
}
}
namespace lru {
constexpr int XA_PITCH = 144, XA_BYTES = 5120;
constexpr int LDS_XA = 0, LDS_CW = 8 * XA_BYTES, LDS_TS = LDS_CW + 5 * 64 * 4, LDS_END = LDS_TS + 2 * 8 * 2 * 64 * 4;
__device__ __forceinline__ int crow(int r, int hi) { return (r & 3) + 8 * (r >> 2) + 4 * hi; }
__device__ __forceinline__ float bcast_half(float v, int src_lane) { return lane_bcast(v, src_lane); }
__device__ __forceinline__ void unit(int un, int l, const bf16_t* PROJ, const float* conv_w, const float* conv_b, const float* lru_wa, const float* lru_ba, const float* lru_wx, const float* lru_bx,
                                     const float* lru_lam, bf16_t* DIRS, char* lds, int wv) {
    const int tid = launder(tid_of(wv)), wave = tid >> 6, lane = tid & 63, r32 = lane & 31, hi = lane >> 5;
    const int dir = un & 1, n = (un >> 1) & 3, b = un >> 3;
    char* xa = lds + LDS_XA + wave * XA_BYTES; float* CW = (float*)(lds + LDS_CW); float* TS = (float*)(lds + LDS_TS);
    __syncthreads();
    if (tid < 320) { const int k = tid >> 6, c = tid & 63; CW[k * 64 + c] = (k < 4) ? conv_w[(l * 4 + k) * 256 + n * 64 + c] : conv_b[l * 256 + n * 64 + c]; }
    bf16x8 wf[2][2][4];
    { const size_t wbase = (size_t)((l * 2 + dir) * 4 + n) * 4096;
#pragma unroll
      for (int g = 0; g < 2; ++g) { const float* W = (g == 0 ? lru_wa : lru_wx) + wbase;
#pragma unroll
        for (int ob = 0; ob < 2; ++ob)
#pragma unroll
          for (int s4 = 0; s4 < 4; ++s4) { u32x4 pk;
#pragma unroll
            for (int jj = 0; jj < 4; ++jj) { const int c0 = 16 * s4 + 8 * hi + 2 * jj; pk[jj] = pk2(W[(size_t)c0 * 64 + 32 * ob + r32], W[(size_t)(c0 + 1) * 64 + 32 * ob + r32]); }
            wf[g][ob][s4] = *reinterpret_cast<bf16x8*>(&pk); } } }
    float ba[2], bx[2], sp8[2], RC[2];
#pragma unroll
    for (int ob = 0; ob < 2; ++ob) { const int ch = (l * 2 + dir) * 256 + n * 64 + 32 * ob + r32; ba[ob] = lru_ba[ch]; bx[ob] = lru_bx[ch]; sp8[ob] = -8.0f * log1pf(__expf(-lru_lam[ch])); RC[ob] = 0.f; }
    __syncthreads();
    const size_t rowb = (size_t)b * SEQ;
    unsigned opk[2][8];
#define LRU_STORE_OUT(s0_) do { _Pragma("unroll") for (int ob = 0; ob < 2; ++ob) _Pragma("unroll") for (int r = 0; r < 16; ++r) { const int tokidx = crow(r, hi); const int t = dir ? (SEQ - 1 - (s0_) - tokidx) : ((s0_) + tokidx); \
        DIRS[(rowb + t) * D + dir * 256 + n * 64 + 32 * ob + r32] = (bf16_t)((r & 1) ? (opk[ob][r >> 1] >> 16) : (opk[ob][r >> 1] & 0xffffu)); } } while (0)
    for (int rho = 0; rho < 8; ++rho) {
        const int s0 = rho * 256 + wave * 32;
        const int tmin = dir ? (SEQ - 1 - s0 - 31) : s0;
        u32x4 sv[5];
#pragma unroll
        for (int i = 0; i < 5; ++i) { const int cidx = lane + 64 * i; sv[i] = (u32x4){0u, 0u, 0u, 0u}; if (cidx < 280) { const int j = cidx >> 3, ck = cidx & 7, t = tmin - 2 + j;
            if (t >= 0 && t < SEQ) sv[i] = *(const u32x4*)(PROJ + (rowb + t) * DINP + C_XA + n * 64 + ck * 8); } }
        if (rho > 0) LRU_STORE_OUT(s0 - 256);
#pragma unroll
        for (int i = 0; i < 5; ++i) { const int cidx = lane + 64 * i; if (cidx < 280) { const int j = cidx >> 3, ck = cidx & 7; *(u32x4*)(xa + j * XA_PITCH + ck * 16) = sv[i]; } }
        asm volatile("s_waitcnt lgkmcnt(0)" ::: "memory");
        bf16x8 xcA[4];
        { const int jb = dir ? 31 - r32 : r32;
#pragma unroll
          for (int s4 = 0; s4 < 4; ++s4) { const int c0 = 16 * s4 + 8 * hi; float acc8[8];
            { const f32x4 b0 = *(const f32x4*)(CW + 4 * 64 + c0), b1 = *(const f32x4*)(CW + 4 * 64 + c0 + 4); acc8[0] = b0.x; acc8[1] = b0.y; acc8[2] = b0.z; acc8[3] = b0.w; acc8[4] = b1.x; acc8[5] = b1.y; acc8[6] = b1.z; acc8[7] = b1.w; }
#pragma unroll
            for (int k = 0; k < 4; ++k) { const u32x4 xv = *(const u32x4*)(xa + (jb + k) * XA_PITCH + c0 * 2);
                const f32x4 w0 = *(const f32x4*)(CW + k * 64 + c0), w1 = *(const f32x4*)(CW + k * 64 + c0 + 4);
                acc8[0] += w0.x * __uint_as_float(xv.x << 16); acc8[1] += w0.y * __uint_as_float(xv.x & 0xffff0000u); acc8[2] += w0.z * __uint_as_float(xv.y << 16); acc8[3] += w0.w * __uint_as_float(xv.y & 0xffff0000u);
                acc8[4] += w1.x * __uint_as_float(xv.z << 16); acc8[5] += w1.y * __uint_as_float(xv.z & 0xffff0000u); acc8[6] += w1.z * __uint_as_float(xv.w << 16); acc8[7] += w1.w * __uint_as_float(xv.w & 0xffff0000u); }
            u32x4 pk; pk.x = pk2(acc8[0], acc8[1]); pk.y = pk2(acc8[2], acc8[3]); pk.z = pk2(acc8[4], acc8[5]); pk.w = pk2(acc8[6], acc8[7]);
            xcA[s4] = *reinterpret_cast<bf16x8*>(&pk); } }
        float P[2][16], Q[2][16];
        float Atile[2], Utile[2];
#pragma unroll
        for (int ob = 0; ob < 2; ++ob) {
            f32x16 ga = f32x16{}, gx = f32x16{};
#pragma unroll
            for (int s4 = 0; s4 < 4; ++s4) { ga = __builtin_amdgcn_mfma_f32_32x32x16_bf16(xcA[s4], wf[0][ob][s4], ga, 0, 0, 0); gx = __builtin_amdgcn_mfma_f32_32x32x16_bf16(xcA[s4], wf[1][ob][s4], gx, 0, 0, 0); }
            const int ch = 32 * ob + r32;
            const float cw0 = CW[ch], cw1 = CW[64 + ch], cw2 = CW[128 + ch], cw3 = CW[192 + ch], cbias = CW[256 + ch];
            float A4[4], U4[4];
#pragma unroll
            for (int q = 0; q < 4; ++q) {
                const int wb = dir ? 28 - (8 * q + 4 * hi) : (8 * q + 4 * hi);
                float win[7];
#pragma unroll
                for (int i = 0; i < 7; ++i) win[i] = bf2f(*(const bf16_t*)(xa + (wb + i) * XA_PITCH + ch * 2));
                float hrun = 0.f, arun = 1.f;
#pragma unroll
                for (int jj = 0; jj < 4; ++jj) { const int r = 4 * q + jj;
                    float xc;
                    if (dir) xc = cbias + cw0 * win[3 - jj] + cw1 * win[4 - jj] + cw2 * win[5 - jj] + cw3 * win[6 - jj];
                    else     xc = cbias + cw0 * win[jj] + cw1 * win[jj + 1] + cw2 * win[jj + 2] + cw3 * win[jj + 3];
                    const float rg = sigmoidf_(ga[r] + ba[ob]), ig = sigmoidf_(gx[r] + bx[ob]);
                    const float log_a = rg * sp8[ob], a = __expf(log_a), mult = sqrtf(fmaxf(1.0f - a * a, 0.f));
                    const float u = mult * (ig * xc);
                    hrun = a * hrun + u; arun = arun * a;
                    P[ob][r] = arun; Q[ob][r] = hrun; }
                A4[q] = arun; U4[q] = hrun; }
            float c = 0.f, Ac = 1.f, cin[4], Acin[4];
#pragma unroll
            for (int st = 0; st < 8; ++st) { const int q = st >> 1, own = st & 1;
                if (hi == own) { cin[q] = c; Acin[q] = Ac; }
                const float cn = A4[q] * c + U4[q], An = Ac * A4[q];
                c = bcast_half(cn, r32 + 32 * own); Ac = bcast_half(An, r32 + 32 * own); }
#pragma unroll
            for (int r = 0; r < 16; ++r) { const int q = r >> 2; const float pa = P[ob][r]; Q[ob][r] = pa * cin[q] + Q[ob][r]; P[ob][r] = pa * Acin[q]; }
            Atile[ob] = Ac; Utile[ob] = c;
        }
        float* ts = TS + (rho & 1) * (8 * 2 * 64);
        if (hi == 0) {
#pragma unroll
            for (int ob = 0; ob < 2; ++ob) { ts[(wave * 2 + 0) * 64 + 32 * ob + r32] = Atile[ob]; ts[(wave * 2 + 1) * 64 + 32 * ob + r32] = Utile[ob]; } }
        __syncthreads();
        float CIN[2];
#pragma unroll
        for (int ob = 0; ob < 2; ++ob) { float c = RC[ob]; CIN[ob] = c;
#pragma unroll
            for (int w2 = 0; w2 < 8; ++w2) { if (w2 == wave) CIN[ob] = c; c = ts[(w2 * 2 + 0) * 64 + 32 * ob + r32] * c + ts[(w2 * 2 + 1) * 64 + 32 * ob + r32]; }
            RC[ob] = c; }
#pragma unroll
        for (int ob = 0; ob < 2; ++ob)
#pragma unroll
            for (int r = 0; r < 16; r += 2) opk[ob][r >> 1] = f2bf(P[ob][r] * CIN[ob] + Q[ob][r]) | (f2bf(P[ob][r + 1] * CIN[ob] + Q[ob][r + 1]) << 16);
    }
    LRU_STORE_OUT(7 * 256 + wave * 32);
#undef LRU_STORE_OUT
    __syncthreads();
}
}
namespace hgrn {
constexpr int QP = 136, TP = 144;
constexpr int L_QT = 0, L_KT = 64 * QP, L_KTT = 2 * 64 * QP, L_VT = L_KTT + 64 * TP, L_SC2 = L_VT + 64 * TP, L_SC2_END = L_SC2 + 1024;
__device__ __forceinline__ int crow(int r, int hi) { return (r & 3) + 8 * (r >> 2) + 4 * hi; }
__device__ __forceinline__ unsigned pkr(float lo, float hi) { unsigned r; asm volatile("v_cvt_pk_bf16_f32 %0, %1, %2" : "=v"(r) : "v"(lo), "v"(hi)); return r; }
__device__ __forceinline__ bf16x8 ld2x8(const char* p) { const u32x2 a = *(const u32x2*)p, b = *(const u32x2*)(p + 16); u32x4 w = {a.x, a.y, b.x, b.y}; return *reinterpret_cast<bf16x8*>(&w); }
__device__ __forceinline__ bf16x8 pack8(const f32x16& x, int s) { u32x4 w; w.x = pkr(x[8 * s], x[8 * s + 1]); w.y = pkr(x[8 * s + 2], x[8 * s + 3]); w.z = pkr(x[8 * s + 4], x[8 * s + 5]); w.w = pkr(x[8 * s + 6], x[8 * s + 7]); return *reinterpret_cast<bf16x8*>(&w); }
constexpr int L_BUF = L_SC2_END;
constexpr int QQP = 272, L_QQ = 2 * L_BUF, L_QQBUF = 64 * QQP;
__device__ __forceinline__ void qq_chunk(int ci, int dir, int colQ, size_t rowb, const bf16_t* PROJ, char* qqbuf, int c, int tg) {
    float q[16];
    { const int s0 = ci * 64 + tg * 16; const int t0 = dir ? SEQ - 1 - s0 : s0; unsigned o = (unsigned)(rowb + t0) * (unsigned)(DINP * 2) + (unsigned)colQ * 2u; const int tstep = dir ? -(DINP * 2) : (DINP * 2);
#pragma unroll
      for (int j = 0; j < 16; ++j) { q[j] = siluf_(bf2f(*(const bf16_t*)((const char*)PROJ + o))) * 0.125f; o += (unsigned)tstep; } }
#pragma unroll
    for (int j4 = 0; j4 < 4; ++j4) *(f32x4*)(qqbuf + c * QQP + (tg * 16 + 4 * j4) * 4) = (f32x4){q[4 * j4], q[4 * j4 + 1], q[4 * j4 + 2], q[4 * j4 + 3]};
}
__device__ __forceinline__ void unit(int un, int l, const bf16_t* PROJ, const float* lb_logits, bf16_t* DIRS, char* lds, int wv) {
    const int tid = launder(tid_of(wv)), wave = tid >> 6, lane = tid & 63, r32 = lane & 31, hi = lane >> 5;
    const int dir = un & 1, head = (un >> 1) & 3, b = un >> 3;
    const size_t rowb = (size_t)b * SEQ;
    __syncthreads();
    if (wave < 4) qq_chunk(0, dir, C_HQ + head * 64 + 16 * wave + (lane & 15), rowb, PROJ, lds + L_QQ, 16 * wave + (lane & 15), lane >> 4);
    __syncthreads();
    if (wave >= 4) {
        const int c = 16 * (wave - 4) + (lane & 15), tg = lane >> 4;
        float lb = 0.f;
        if (l == 1) { const int col = head * 64 + c; lb = 1.0f / (1.0f + __expf(lb_logits[(0 * 2 + dir) * 256 + col] - lb_logits[(1 * 2 + dir) * 256 + col])); }
        const int colF = (dir ? C_HFB : C_HFF) + head * 64 + c, colV = C_HI + head * 64 + c;
        bf16_t zr[16], vr[16];
        const char* pbase = (const char*)PROJ;
        const unsigned offF = (unsigned)colF * 2u, dV = (unsigned)(colV - colF) * 2u; const int tstep = dir ? -(DINP * 2) : (DINP * 2);
#define HG_LOAD(ci) do { const int s0 = (ci) * 64 + tg * 16; const int t0 = dir ? SEQ - 1 - s0 : s0; unsigned o = (unsigned)(rowb + t0) * (unsigned)(DINP * 2) + offF; \
        _Pragma("unroll") for (int j = 0; j < 16; ++j) { zr[j] = *(const bf16_t*)(pbase + o); vr[j] = *(const bf16_t*)(pbase + (o + dV)); o += (unsigned)tstep; } } while (0)
        HG_LOAD(0);
#pragma unroll 1
        for (int ci = 0; ci < 33; ++ci) {
            if (ci < 32) {
                char* buf = lds + (ci & 1) * L_BUF;
                char* QT = buf + L_QT; char* KT = buf + L_KT; char* KTT = buf + L_KTT; char* VT = buf + L_VT; float* SC = (float*)(buf + L_SC2);
                float bl[16], kk[16], qq[16]; unsigned vpk[8];
                { float run = 0.f;
#pragma unroll
                  for (int j = 0; j < 16; ++j) { const float f = lb + (1.0f - lb) * sigmoidf_(bf2f(zr[j])); run += 0.6931471805599453f * __builtin_amdgcn_logf(f); bl[j] = run; kk[j] = 1.0f - f; }
                  { const char* qb = lds + L_QQ + (ci & 1) * L_QQBUF + c * QQP + tg * 64;
#pragma unroll
                    for (int j4 = 0; j4 < 4; ++j4) { const f32x4 v = *(const f32x4*)(qb + 16 * j4); qq[4 * j4] = v.x; qq[4 * j4 + 1] = v.y; qq[4 * j4 + 2] = v.z; qq[4 * j4 + 3] = v.w; } }
#pragma unroll
                  for (int j = 0; j < 8; ++j) vpk[j] = (unsigned)vr[2 * j] | ((unsigned)vr[2 * j + 1] << 16); }
                if (ci + 1 < 32) HG_LOAD(ci + 1);
                const float t0 = lane_bcast(bl[15], lane & 15), t1 = lane_bcast(bl[15], (lane & 15) + 16), t2 = lane_bcast(bl[15], (lane & 15) + 32), t3 = lane_bcast(bl[15], (lane & 15) + 48);
                const float off = (tg > 0 ? t0 : 0.f) + (tg > 1 ? t1 : 0.f) + (tg > 2 ? t2 : 0.f), bref = t0 + t1, blast = (t0 + t1) + (t2 + t3);
                unsigned kpk[8]; float ktp = 0.f;
#pragma unroll
                for (int j = 0; j < 16; ++j) { const float bc = bl[j] + off; const float dq = fminf(fmaxf(bc - bref, -80.f), 80.f);
                    const float e2 = __builtin_amdgcn_exp2f(1.4426950408889634f * dq); const float qt = qq[j] * e2, kt = kk[j] * __builtin_amdgcn_rcpf(e2);
                    const int t = tg * 16 + j; const unsigned qk = pkr(qt, kt); *(bf16_t*)(QT + t * QP + c * 2) = (bf16_t)(qk & 0xffffu); *(bf16_t*)(KT + t * QP + c * 2) = (bf16_t)(qk >> 16);
                    if (j & 1) kpk[j >> 1] = pkr(ktp, kt); else ktp = kt; }
                *(u32x4*)(KTT + c * TP + tg * 32) = (u32x4){kpk[0], kpk[1], kpk[2], kpk[3]}; *(u32x4*)(KTT + c * TP + tg * 32 + 16) = (u32x4){kpk[4], kpk[5], kpk[6], kpk[7]};
                *(u32x4*)(VT + c * TP + tg * 32) = (u32x4){vpk[0], vpk[1], vpk[2], vpk[3]}; *(u32x4*)(VT + c * TP + tg * 32 + 16) = (u32x4){vpk[4], vpk[5], vpk[6], vpk[7]};
                if (tg == 0) { SC[c] = __expf(bref); SC[64 + c] = __expf(blast); SC[128 + c] = __expf(blast - bref); }
            }
            lds_barrier();
        }
#undef HG_LOAD
    } else {
        const int tb = (wave >> 1) & 1, eb = wave & 1;
        f32x16 S0 = f32x16{}, S1 = f32x16{};
#pragma unroll 1
        for (int ci = -1; ci < 32; ++ci) {
            if (ci + 2 < 32) qq_chunk(ci + 2, dir, C_HQ + head * 64 + 16 * wave + (lane & 15), rowb, PROJ, lds + L_QQ + ((ci + 2) & 1) * L_QQBUF, 16 * wave + (lane & 15), lane >> 4);
            if (ci >= 0) {
                const char* buf = lds + (ci & 1) * L_BUF;
                const char* QT = buf + L_QT; const char* KT = buf + L_KT; const char* KTT = buf + L_KTT; const char* VT = buf + L_VT; const float* SC = (const float*)(buf + L_SC2);
                bf16x8 qf[4];
#pragma unroll
                for (int k4 = 0; k4 < 4; ++k4) qf[k4] = ld2x8(QT + (32 * tb + r32) * QP + (16 * k4 + 4 * hi) * 2);
                f32x16 o = f32x16{};
#pragma unroll
                for (int sb = 0; sb < 2; ++sb) { if (sb <= tb) {
                    f32x16 pt = f32x16{};
#pragma unroll
                    for (int k4 = 0; k4 < 4; ++k4) { const bf16x8 kf = ld2x8(KT + (32 * sb + r32) * QP + (16 * k4 + 4 * hi) * 2); pt = __builtin_amdgcn_mfma_f32_32x32x16_bf16(kf, qf[k4], pt, 0, 0, 0); }
                    if (sb == tb) {
#pragma unroll
                        for (int r = 0; r < 16; ++r) pt[r] = (crow(r, hi) <= r32) ? pt[r] : 0.f; }
#pragma unroll
                    for (int s2 = 0; s2 < 2; ++s2) { const bf16x8 vf = ld2x8(VT + (32 * eb + r32) * TP + (32 * sb + 16 * s2 + 4 * hi) * 2); o = __builtin_amdgcn_mfma_f32_32x32x16_bf16(pack8(pt, s2), vf, o, 0, 0, 0); } } }
#pragma unroll
                for (int cb = 0; cb < 2; ++cb) { f32x16 sp;
#pragma unroll
                    for (int r = 0; r < 16; ++r) sp[r] = (cb == 0 ? S0[r] : S1[r]) * SC[32 * cb + crow(r, hi)];
#pragma unroll
                    for (int s2 = 0; s2 < 2; ++s2) o = __builtin_amdgcn_mfma_f32_32x32x16_bf16(qf[2 * cb + s2], pack8(sp, s2), o, 0, 0, 0); }
#pragma unroll
                for (int cb = 0; cb < 2; ++cb) { f32x16 ds = f32x16{};
#pragma unroll
                    for (int ks = 0; ks < 4; ++ks) { const bf16x8 af = *(const bf16x8*)(KTT + (32 * cb + r32) * TP + (16 * ks + 8 * hi) * 2), bfr = *(const bf16x8*)(VT + (32 * eb + r32) * TP + (16 * ks + 8 * hi) * 2);
                        ds = __builtin_amdgcn_mfma_f32_32x32x16_bf16(af, bfr, ds, 0, 0, 0); }
#pragma unroll
                    for (int r = 0; r < 16; ++r) { const int c = 32 * cb + crow(r, hi); const float el = SC[64 + c], en = SC[128 + c];
                        if (cb == 0) S0[r] = el * S0[r] + en * ds[r]; else S1[r] = el * S1[r] + en * ds[r]; } }
#pragma unroll
                for (int r = 0; r < 16; r += 2) { const int s = ci * 64 + 32 * tb + crow(r, hi); const int t = dir ? SEQ - 1 - s : s;
                    const unsigned ob = ((unsigned)(rowb + t) * (unsigned)D + (unsigned)(512 + dir * 256 + head * 64 + 32 * eb + r32)) * 2u; const unsigned pk = pkr(o[r], o[r + 1]);
                    *(bf16_t*)((char*)DIRS + ob) = (bf16_t)(pk & 0xffffu); *(bf16_t*)((char*)DIRS + (dir ? ob - (unsigned)(D * 2) : ob + (unsigned)(D * 2))) = (bf16_t)(pk >> 16); }
            }
            lds_barrier();
        }
    }
}
}
#ifndef DUP_GEMM
#define DUP_GEMM 1
#endif
#ifndef WIN_WGM
#define WIN_WGM 8
#endif
#ifndef DUP_WGM
#define DUP_WGM 4
#endif
#ifndef UP_WGM
#define UP_WGM 4
#endif
#ifndef DUP_WOUT
#define DUP_WOUT 1
#endif
#ifndef DUP_DDOWN
#define DUP_DDOWN 1
#endif
#ifndef DUP_MDOWN
#define DUP_MDOWN 1
#endif
#ifndef DUP_PM
#define DUP_PM 1
#endif
#ifndef DUP_PREP
#define DUP_PREP 1
#endif
#ifndef DUP_HG
#define DUP_HG 1
#endif
#ifndef DUP_LRU
#define DUP_LRU 1
#endif
#ifndef DUP_ATT
#define DUP_ATT 1
#endif
#ifndef DUP_SEQ
#define DUP_SEQ 1
#endif
#ifndef DUP_MLA
#define DUP_MLA 1
#endif
#ifndef DUP_NORM
#define DUP_NORM 1
#endif
#ifndef DUP_CVT
#define DUP_CVT 1
#endif
__global__ void __launch_bounds__(NWAVES * 64, 2) mk_fwd(MkArgs args) {
    extern __shared__ __attribute__((aligned(16))) unsigned char lds_raw[];
    Frame F;
    F.lds = (LAS unsigned char*)lds_raw; F.MISC = (volatile LAS unsigned*)(F.lds + MISC_OFF);
    F.wv = __builtin_amdgcn_readfirstlane((int)threadIdx.x >> 6); relaunder(F);
    F.G = gridDim.x; { const int bx = blockIdx.x; F.vcu = (F.G % 8 == 0) ? (bx % 8) * (F.G / 8) + bx / 8 : bx; }
    unsigned char* ws = args.ws; F.ctl = (unsigned*)(ws + WS_CTL);
    for (int u = F.tid; u < (LDS_BYTES - LDSCTL_OFF) / 4; u += NWAVES * 64) ((LAS unsigned*)(F.lds + LDSCTL_OFF))[u] = 0u;
    __syncthreads();
    XcdBarrier bar = xcd_barrier_post(F.ctl + CW_BAR + args.li * 4096, F.MISC + 8, F.wv);
    const int lo = args.ph_lo, hi = args.ph_hi;
#define IN(k) (lo <= (k) && (k) < hi && (relaunder(F), true))
#ifndef DUP_BAR
#define DUP_BAR 1
#endif
#define END_PHASE(k) do { if ((k) + 1 < hi) { for (int rb = 0; rb < DUP_BAR; ++rb) xcd_barrier(bar); } } while (0)
#define gw (F.vcu * NWAVES + F.wave)
    const int NGW = F.G * NWAVES;
    const float* x = (const float*)args.in[0]; float* out = args.out;
    bf16_t* HB = (bf16_t*)(ws + WS_HB); bf16_t* PROJ = (bf16_t*)(ws + WS_PROJ); bf16_t* DIRS = (bf16_t*)((unsigned char*)out + OUT_DIRS); bf16_t* YC = (bf16_t*)((unsigned char*)out + OUT_YC); bf16_t* XS = (bf16_t*)(ws + WS_XS);
    int* list = (int*)(ws + WS_LIST); float* wl = (float*)(ws + WS_LIST + 2 * MiB);

    if (IN(P_PREP)) {
        float* scr = (float*)(lds_raw + RING_OFF + F.wave * 8448);
#pragma unroll 1
        for (int rep = 0; rep < DUP_PREP; ++rep)
        for (int it = gw; it < N_SMALL_FIRST; it += NGW) { TrJob J; int local; if (small_job(it, args, J, local)) tr_item(J, local, scr, F.lane); }
        for (int l = 0; l < 2; ++l) zero_rows(F, (bf16_t*)(ws + WS_WIN) + (size_t)l * DINP * D + (size_t)DIN * D, DINP - DIN, D, D);
        zero_rows(F, (bf16_t*)(ws + WS_WGU) + (size_t)(21 * 256 + 64) * D, 64, D, D);
        zero_rows(F, (bf16_t*)(ws + WS_WGU) + (size_t)(21 * 256 + 192) * D, 64, D, D);
        zero_rows(F, (bf16_t*)(ws + WS_WDN) + DFF, D, DFFP - DFF, DFFP);
#pragma unroll 1
        for (int rep = 0; rep < DUP_NORM; ++rep) stream_in_phase(F, x, XS, (float*)(ws + WS_SS) + 8 * T);
        END_PHASE(P_PREP);
    }
    for (int l = 0; l < 2; ++l) {
        if (IN(PH(l, PL_WIN))) {
            pg8::ProbDense pb{XS, (const bf16_t*)(ws + WS_WIN) + (size_t)l * DINP * D, D, D}; pg8::StaticOrder S;
            S.init(T / 256, DINP / 256, F.G, (int)blockIdx.x, WIN_WGM);
            pg8::EpiStoreBf16 E{PROJ, DINP, (const float*)(ws + WS_SS) + (l == 1 ? 4 * T : 8 * T)};
#pragma unroll 1
            for (int rep = 0; rep < DUP_GEMM; ++rep) pg8::gemm_phase(F.lds + RING_OFF, F.lds + ROWTAB_OFF, pb, S, E, F.wv);
            if ((int)blockIdx.x >= 128) {
                relaunder(F);
                const int fw = ((int)blockIdx.x - 128) * NWAVES + F.wave, FW = 128 * NWAVES;
                if (l == 0) { for (int it = N_SMALL_FIRST + fw; it < N_SMALL_ITEMS; it += FW) { TrJob J; int local; if (small_job(it, args, J, local)) tr_item(J, local, nullptr, F.lane); }
                    for (int it = fw; it < N_MOE_W3_L0; it += FW) { TrJob J; int local; moe_job_w3l0(it, args, J, local); tr_item(J, local, nullptr, F.lane); } }
                else { for (int it = fw; it < N_MOE_EARLY; it += FW) { TrJob J; int local; moe_job_early(it, args, J, local); tr_item(J, local, nullptr, F.lane); } }
            }
            END_PHASE(PH(l, PL_WIN));
        }
        if (IN(PH(l, PL_MLA))) {
            const bf16_t* Wuq_t = (const bf16_t*)(ws + WS_WUQ) + (size_t)l * 768 * 256; const bf16_t* Wukv_t = (const bf16_t*)(ws + WS_WUKV) + (size_t)l * 1024 * 128;
#pragma unroll 1
            for (int rep = 0; rep < DUP_MLA; ++rep)
            for (int blk = F.vcu; blk < T / 128; blk += F.G)
                mla::block_item(blk, PROJ, (const int*)args.in[1], Wuq_t, Wukv_t, (const float*)args.in[18] + l * 96, (const float*)args.in[19] + l * 96, (bf16_t*)(ws + WS_Q), (bf16_t*)(ws + WS_K), (bf16_t*)(ws + WS_V), (char*)lds_raw + RING_OFF, F.wv);
            END_PHASE(PH(l, PL_MLA));
        }
        if (IN(PH(l, PL_MIXERS))) {
            const bf16_t* Qg = (const bf16_t*)(ws + WS_Q); const bf16_t* Kg = (const bf16_t*)(ws + WS_K); const bf16_t* Vg = (const bf16_t*)(ws + WS_V);
            unsigned* qctr = F.ctl + CW_QUEUE + 64 * l;
            float negM;
            { const float* gq = (const float*)args.in[18] + l * 96; const float* gk = (const float*)args.in[19] + l * 96; float mq = 0.f, mk = 0.f;
              for (int j = F.lane; j < 96; j += 64) { mq = fmaxf(mq, fabsf(gq[j])); mk = fmaxf(mk, fabsf(gk[j])); }
#pragma unroll
              for (int o2 = 0; o2 < 1; ++o2) { mq = fmaxf(mq, xor_shfl<1>(mq)); mq = fmaxf(mq, xor_shfl<2>(mq)); mq = fmaxf(mq, xor_shfl<4>(mq)); mq = fmaxf(mq, xor_shfl<8>(mq)); mq = fmaxf(mq, xor_shfl<16>(mq)); mq = half_max(mq);
                  mk = fmaxf(mk, xor_shfl<1>(mk)); mk = fmaxf(mk, xor_shfl<2>(mk)); mk = fmaxf(mk, xor_shfl<4>(mk)); mk = fmaxf(mk, xor_shfl<8>(mk)); mk = fmaxf(mk, xor_shfl<16>(mk)); mk = half_max(mk); }
              negM = -9.797958971132712f * mq * mk * 1.4426950408889634f; }
#pragma unroll 1
            for (int rep = 0; rep < DUP_ATT; ++rep) {
            volatile LAS int* qslot = (volatile LAS int*)(F.MISC + 12);
            __syncthreads();
            if (F.tid == 0) qslot[0] = (int)__hip_atomic_fetch_add(qctr, 1u, RLX_AGENT);
            __syncthreads();
            int u = qslot[0];
#pragma unroll 1
            while (u < 1280 * (rep + 1)) {
                int nxt = 0;
                if (F.tid == 0) nxt = (int)__hip_atomic_fetch_add(qctr, 1u, RLX_AGENT);
                const int uu = u - 1280 * rep;
                if (uu < 128) { for (int r2 = 0; r2 < DUP_HG; ++r2) hgrn::unit(uu, l, PROJ, (const float*)args.in[12], DIRS, (char*)lds_raw + RING_OFF, F.wv); }
                else if (uu < 256) { for (int r2 = 0; r2 < DUP_LRU; ++r2) lru::unit(uu - 128, l, PROJ, (const float*)args.in[4], (const float*)args.in[5], (const float*)args.in[6], (const float*)args.in[7], (const float*)args.in[8], (const float*)args.in[9],
                                             (const float*)args.in[10], DIRS, (char*)lds_raw + RING_OFF, F.wv); }
                else { const int unit = uu - 256; const int bh = unit >> 3, qb = unit & 7, b = bh >> 3, h = bh & 7; const size_t row0 = (size_t)b * SEQ;
                    if (negM < -40.f) att::attn_unit<true>(Qg + ((size_t)bh * SEQ + qb * 256) * 96, Kg + (size_t)bh * SEQ * 96, Vg + (size_t)bh * SEQ * 64, YC + ((size_t)bh * SEQ + qb * 256) * 64, 64, SEQ, negM, (char*)lds_raw + RING_OFF, F.wv);
                    else att::attn_unit<false>(Qg + ((size_t)bh * SEQ + qb * 256) * 96, Kg + (size_t)bh * SEQ * 96, Vg + (size_t)bh * SEQ * 64, YC + ((size_t)bh * SEQ + qb * 256) * 64, 64, SEQ, negM, (char*)lds_raw + RING_OFF, F.wv); }
                relaunder(F);
                if (F.tid == 0) qslot[0] = nxt;
                __syncthreads();
                u = qslot[0];
                __syncthreads();
            }
            }
            END_PHASE(PH(l, PL_MIXERS));
        }
        if (IN(PH(l, PL_PREPMIX))) {
            const float* g_a = (const float*)args.in[11] + l * 256; const float* g_n = (const float*)args.in[13] + l * 64; const float* g_c = (const float*)args.in[20] + l * 512;
#pragma unroll 1
            for (int rep = 0; rep < DUP_PM; ++rep)
            for (int m = gw; m < T; m += NGW) prepmix_token(PROJ + (size_t)m * DINP, DIRS + (size_t)m * D, (const bf16_t*)YC + ((size_t)((m >> 11) * 8 + (F.lane >> 3)) * SEQ + (m & (SEQ - 1))) * 64 + (F.lane & 7) * 8, HB + (size_t)m * D, g_a, g_n, g_c, F.lane);
            END_PHASE(PH(l, PL_PREPMIX));
        }
        if (IN(PH(l, PL_WOUT))) {
            pg8::ProbDense pb{HB, (const bf16_t*)(ws + WS_WOUT) + (size_t)l * D * D, D, D}; pg8::StaticOrder S; S.init(T / 256, D / 256, F.G, (int)blockIdx.x);
            if (l == 0) { pg8::EpiResid<false> E{XS, XS, D, (float*)(ws + WS_SS)};
                pg8::gemm_phase(F.lds + RING_OFF, F.lds + ROWTAB_OFF, pb, S, E, F.wv); }
            else { pg8::EpiResid<false> E{XS, XS, D, (float*)nullptr};
                pg8::gemm_phase(F.lds + RING_OFF, F.lds + ROWTAB_OFF, pb, S, E, F.wv); }
            END_PHASE(PH(l, PL_WOUT));
        }
        if (l == 1 && IN(PH(l, PL_NORM2))) {
            {
                float* scr = (float*)(lds_raw + RING_OFF + 16384 + F.wave * 8448);
                norm_router_phase(F, XS, (const float*)args.in[22] + D, HB, (const float*)args.in[25], (int*)(ws + WS_ROUTE), (float*)(ws + WS_ROUTE + 256 * 1024));
#pragma unroll 1
                for (int rep = 0; rep < DUP_CVT; ++rep)
                for (int it = gw; it < N_MOE_LATE; it += NGW) { TrJob J; int local; moe_job_late(it, args, J, local); tr_item(J, local, scr, F.lane); }
            }
            END_PHASE(PH(l, PL_NORM2));
        }
        if (l == 0) {
            if (IN(PH(0, PL_UP0))) {
                pg8::ProbDense pb{XS, (const bf16_t*)(ws + WS_WGU), D, D}; pg8::StaticOrder S; S.init(T / 256, NGU / 256, F.G, (int)blockIdx.x, DUP_WGM);
                pg8::EpiSwiglu E{(bf16_t*)(ws + WS_ACT), DFFP, (const float*)(ws + WS_SS)};
#pragma unroll 1
                for (int rep = 0; rep < DUP_GEMM; ++rep) pg8::gemm_phase(F.lds + RING_OFF, F.lds + ROWTAB_OFF, pb, S, E, F.wv);
                END_PHASE(PH(0, PL_UP0));
            }
            if (IN(PH(0, PL_DOWN0))) {
                pg8::ProbDense pb{(const bf16_t*)(ws + WS_ACT), (const bf16_t*)(ws + WS_WDN), DFFP, DFFP}; pg8::StaticOrder S; S.init(T / 256, D / 256, F.G, (int)blockIdx.x);
                { pg8::EpiResid<false> E{XS, XS, D, (float*)(ws + WS_SS) + 4 * T};
                pg8::gemm_phase(F.lds + RING_OFF, F.lds + ROWTAB_OFF, pb, S, E, F.wv); }
                END_PHASE(PH(0, PL_DOWN0));
            }
        } else {
            if (IN(PH(1, PL_NORMN))) { route_assign_phase(F, (const int*)(ws + WS_ROUTE), (const float*)(ws + WS_ROUTE + 256 * 1024), list, wl); xcd_barrier(bar); }
#pragma unroll 1
            for (int r = 0; r < 2; ++r) {
                if (IN(PH(1, PL_UP0 + 2 * r))) {
                    int ntiles; pg8::MoeMap mm = moe_map_setup(F, r, ntiles);
                    pg8::ProbMoeUp pb{HB, (const bf16_t*)(ws + WS_W13), D, D, mm, list + (size_t)r * 8 * T, wl + (size_t)r * 8 * T}; pg8::StaticOrder S; S.init(ntiles, 2 * DEX / 256, F.G, (int)blockIdx.x, UP_WGM);
                    pg8::EpiSwigluMoe E{ws + WS_ACTM, DEX, mm};
#pragma unroll 1
                    for (int rep = 0; rep < DUP_GEMM; ++rep) pg8::gemm_phase(F.lds + RING_OFF, F.lds + ROWTAB_OFF, pb, S, E, F.wv);
                    END_PHASE(PH(1, PL_UP0 + 2 * r));
                }
                if (IN(PH(1, PL_DOWN0 + 2 * r))) {
                    int ntiles; pg8::MoeMap mm = moe_map_setup(F, r, ntiles);
                    const int nfull = ntiles < 128 ? ntiles : 128, nleft = ntiles - nfull;
                    { pg8::ProbMoeDown pb{(const bf16_t*)(ws + WS_ACTM), (const bf16_t*)(ws + WS_W2), DEX, DEX, mm}; pg8::StaticOrder S; S.init(nfull, D / 256, F.G, (int)blockIdx.x);
                      if (r == 0) { pg8::EpiScatterMoe<false> E{XS, XS, D, mm, list + (size_t)r * 8 * T, 1.0f / (F8_WSCALE * F8_ASCALE)}; pg8::gemm_phase(F.lds + RING_OFF, F.lds + ROWTAB_OFF, pb, S, E, F.wv); }
                      else { pg8::EpiScatterMoe<true> E{XS, out, D, mm, list + (size_t)r * 8 * T, 1.0f / (F8_WSCALE * F8_ASCALE)}; pg8::gemm_phase(F.lds + RING_OFF, F.lds + ROWTAB_OFF, pb, S, E, F.wv); } }
                    if (nleft > 0) {
                        bf16_t* Pscr = (bf16_t*)(ws + WS_PART);
                        { pg8::ProbMoeDownSlice pb{(const bf16_t*)(ws + WS_ACTM), (const bf16_t*)(ws + WS_W2), DEX, DEX / 7, DEX, nfull, mm}; pg8::StaticOrder S; S.init(nleft, 28, F.G, (int)blockIdx.x);
                          pg8::EpiPartialBf16 E{Pscr, 1.0f / (F8_WSCALE * F8_ASCALE)};
                          pg8::gemm_phase(F.lds + RING_OFF, F.lds + ROWTAB_OFF, pb, S, E, F.wv); }
                        xcd_barrier(bar);
                        relaunder(F);
                        for (int rw = gw; rw < nleft * 4 * 256; rw += NGW) { const int it = rw >> 8, rr = rw & 255, lt = it >> 2, n = it & 3, c4 = F.lane * 4; int e, ltl, cnt; mm.locate(nfull + lt, e, ltl, cnt);
                            const int lr = ltl * 256 + rr;
                            if (lr < cnt) { const int tok = list[(size_t)r * 8 * T + (size_t)e * T + lr]; const size_t oo = (size_t)tok * D + n * 256 + c4; const u32x2 xw = *(const u32x2*)(XS + oo); u32x2 w[7];
                                f32x4 v = (f32x4){__uint_as_float(xw.x << 16), __uint_as_float(xw.x & 0xffff0000u), __uint_as_float(xw.y << 16), __uint_as_float(xw.y & 0xffff0000u)};
#pragma unroll
                                for (int sl = 0; sl < 7; ++sl) w[sl] = *(const u32x2*)(Pscr + (size_t)(lt * 28 + sl * 4 + n) * 65536 + (size_t)rr * 256 + c4);
#pragma unroll
                                for (int sl = 0; sl < 7; ++sl) { v.x += __uint_as_float(w[sl].x << 16); v.y += __uint_as_float(w[sl].x & 0xffff0000u); v.z += __uint_as_float(w[sl].y << 16); v.w += __uint_as_float(w[sl].y & 0xffff0000u); }
                                if (r == 1) *(f32x4*)(out + oo) = v; else { u32x2 z; z.x = pk2(v.x, v.y); z.y = pk2(v.z, v.w); *(u32x2*)(XS + oo) = z; } } } }
                    if (r == 0) END_PHASE(PH(1, PL_DOWN0 + 2 * r));
                }
            }
        }
    }
#undef IN
#undef END_PHASE
#undef gw
}
static int g_grid = 0;
static void launch_mk(hipStream_t st, MkArgs a, int lo, int hi, int li) {
    a.ph_lo = lo; a.ph_hi = hi; a.li = li; a.pad = 0;
    hipLaunchKernelGGL(mk_fwd, dim3(g_grid), dim3(NWAVES * 64), LDS_BYTES, st, a);
    const hipError_t le = hipPeekAtLastError();
    if (le != hipSuccess) fprintf(stderr, "kernel_launch: mk_fwd launch [%d,%d) failed: %s\n", lo, hi, hipGetErrorName(le));
}
extern "C" void kernel_launch(void* const* d_in, const int* in_sizes, int n_in, void* d_out, int out_size, void* d_ws, size_t ws_size, hipStream_t stream) {
    if (n_in != 29 || in_sizes[0] != T * D || out_size != T * D || ws_size < WS_END) { fprintf(stderr, "kernel_launch: unexpected shapes (n_in %d, in0 %d, out %d, ws %zu)\n", n_in, n_in > 0 ? in_sizes[0] : -1, out_size, ws_size); return; }
    if (g_grid == 0) {
        int dev = 0, cus = 0;
        if (hipGetDevice(&dev) != hipSuccess || hipDeviceGetAttribute(&cus, hipDeviceAttributeMultiprocessorCount, dev) != hipSuccess) { fprintf(stderr, "kernel_launch: device query failed\n"); g_grid = -1; return; }
        if (hipFuncSetAttribute((const void*)mk_fwd, hipFuncAttributeMaxDynamicSharedMemorySize, LDS_BYTES) != hipSuccess) { fprintf(stderr, "kernel_launch: hipFuncSetAttribute failed\n"); g_grid = -1; return; }
        int per_cu = 0;
        if (hipOccupancyMaxActiveBlocksPerMultiprocessor(&per_cu, (const void*)mk_fwd, NWAVES * 64, LDS_BYTES) != hipSuccess || per_cu < 1) fprintf(stderr, "kernel_launch: occupancy query reports %d blocks per CU\n", per_cu);
        (void)hipGetLastError();
        g_grid = cus;
        if (g_grid != 256) { fprintf(stderr, "kernel_launch: built for 256 CUs, found %d\n", cus); g_grid = -1; return; }
    }
    if (g_grid < 0) return;
    unsigned char* ws = (unsigned char*)d_ws;
    (void)hipMemsetAsync(ws + WS_CTL, 0, MiB, stream);
    MkArgs a{};
    for (int i = 0; i < 29; ++i) a.in[i] = d_in[i];
    a.out = (float*)d_out; a.ws = ws;
    launch_mk(stream, a, 0, P_TOTAL, 0);
}
```

```cpp
#include <hip/hip_runtime.h>
#include <cstdio>
#include <cstdint>

typedef unsigned short bf16_t;
typedef float f32x4 __attribute__((ext_vector_type(4)));
typedef unsigned u32x4 __attribute__((ext_vector_type(4)));
typedef unsigned u32x2 __attribute__((ext_vector_type(2)));
#define LAS __attribute__((address_space(3)))

constexpr int NB = 16, SEQ = 2048, T = NB * SEQ, D = 1024;
constexpr int DIN = 2208, DINP = 2304;
constexpr int C_XA = 0, C_GA = 256, C_HQ = 512, C_HFF = 768, C_HFB = 1024, C_HI = 1280, C_HG = 1536, C_CQ = 1792, C_CKV = 2048, C_KR = 2176;
constexpr int DFF = 2752, DFFP = 2816, NGU = 5632;
constexpr int DEX = 3584, NE = 8;
constexpr float EPS = 1e-6f;

constexpr size_t MiB = 1u << 20;
constexpr size_t WS_CTL = 0;
constexpr size_t WS_WIN = 1 * MiB;
constexpr size_t WS_WOUT = 10 * MiB;
constexpr size_t WS_WGU = 14 * MiB;
constexpr size_t WS_WDN = 25 * MiB;
constexpr size_t WS_WUQ = 31 * MiB;
constexpr size_t WS_WUKV = 32 * MiB;
constexpr size_t WS_LIST = 33 * MiB;
constexpr size_t WS_HB = 38 * MiB;
constexpr size_t WS_PROJ = 102 * MiB;
constexpr size_t WS_Q = 246 * MiB, WS_K = 294 * MiB;
constexpr size_t WS_XS8 = 294 * MiB;
constexpr size_t WS_V = 342 * MiB;
constexpr size_t WS_XS = 440 * MiB;
constexpr size_t OUT_DIRS = 0, OUT_YC = 64 * MiB;
constexpr size_t WS_SS = 504 * MiB;
constexpr size_t WS_ACT = 102 * MiB;
constexpr size_t WS_W13 = 374 * MiB;
constexpr size_t WS_W2 = 214 * MiB;
constexpr size_t WS_ACTM = 246 * MiB;
constexpr size_t WS_PART = 102 * MiB;
constexpr size_t WS_END = 508 * MiB;
constexpr int CW_CNT = 8192;

__device__ __forceinline__ unsigned pk4_fp8(float a, float b, float c, float d) {
    a = __builtin_amdgcn_fmed3f(a, -448.f, 448.f); b = __builtin_amdgcn_fmed3f(b, -448.f, 448.f); c = __builtin_amdgcn_fmed3f(c, -448.f, 448.f); d = __builtin_amdgcn_fmed3f(d, -448.f, 448.f);
    int pk = __builtin_amdgcn_cvt_pk_fp8_f32(a, b, 0, false); pk = __builtin_amdgcn_cvt_pk_fp8_f32(c, d, pk, true); return (unsigned)pk; }
__device__ __forceinline__ float bf2f(bf16_t b) { return __uint_as_float(((unsigned)b) << 16); }
__device__ __forceinline__ unsigned f2bf(float f) { unsigned u = __float_as_uint(f); return (u + 0x7fffu + ((u >> 16) & 1u)) >> 16; }
__device__ __forceinline__ unsigned pk2(float lo, float hi) { return f2bf(lo) | (f2bf(hi) << 16); }
__device__ __forceinline__ int lane_id_v() { int r; asm volatile("v_mbcnt_lo_u32_b32 %0, -1, 0\n\tv_mbcnt_hi_u32_b32 %0, -1, %0" : "=v"(r)); return r; }
__device__ __forceinline__ int launder_s(int v) { asm volatile("" : "+s"(v)); return v; }
__device__ __forceinline__ int tid_of(int wv) { return launder_s(wv) * 64 + lane_id_v(); }
template <int M> __device__ __forceinline__ float xor_shfl(float v) { static_assert(M > 0 && M < 32, "swizzle range"); return __int_as_float(__builtin_amdgcn_ds_swizzle(__float_as_int(v), (M << 10) | 0x1F)); }
__device__ __forceinline__ float half_sum(float v) { auto rr = __builtin_amdgcn_permlane32_swap(__float_as_uint(v), __float_as_uint(v), false, false); return __uint_as_float(rr[0]) + __uint_as_float(rr[1]); }
__device__ __forceinline__ float half_max(float v) { auto rr = __builtin_amdgcn_permlane32_swap(__float_as_uint(v), __float_as_uint(v), false, false); return fmaxf(__uint_as_float(rr[0]), __uint_as_float(rr[1])); }
__device__ __forceinline__ float lane_bcast(float v, int src_lane) { return __int_as_float(__builtin_amdgcn_ds_bpermute(src_lane << 2, __float_as_int(v))); }
__device__ __forceinline__ void lds_barrier() { asm volatile("s_waitcnt lgkmcnt(0)" ::: "memory"); __builtin_amdgcn_s_barrier(); asm volatile("" ::: "memory"); }
__device__ __forceinline__ float wave_sum(float v) {
    v += xor_shfl<1>(v); v += xor_shfl<2>(v); v += xor_shfl<4>(v); v += xor_shfl<8>(v); v += xor_shfl<16>(v);
    return half_sum(v);
}
__device__ __forceinline__ float sigmoidf_(float x) { return __builtin_amdgcn_rcpf(1.0f + __builtin_amdgcn_exp2f(-1.4426950408889634f * x)); }
__device__ __forceinline__ float siluf_(float x) { return x * __builtin_amdgcn_rcpf(1.0f + __builtin_amdgcn_exp2f(-1.4426950408889634f * x)); }
__device__ __forceinline__ float gelu_tanh(float x) { const float u = 0.7978845608028654f * (x + 0.044715f * x * x * x); const float t = 1.0f - 2.0f * __builtin_amdgcn_rcpf(1.0f + __builtin_amdgcn_exp2f(2.885390081777927f * u)); return 0.5f * x * (1.0f + t); }

__constant__ float c_invfreq[16] = {1.0f, 0.5623413251903491f, 0.31622776601683794f, 0.1778279410038923f, 0.1f, 0.05623413251903491f, 0.031622776601683794f, 0.01778279410038923f,
                                    0.01f, 0.005623413251903491f, 0.0031622776601683794f, 0.001778279410038923f, 0.001f, 0.0005623413251903491f, 0.00031622776601683794f, 0.0001778279410038923f};
__device__ __forceinline__ void rope_cs(int pos, int i, float& c, float& s) {
    const float ang = (float)pos * c_invfreq[i];
    const double rev = (double)ang * 0.15915494309189535; const float fr = (float)(rev - floor(rev));
    s = __builtin_amdgcn_sinf(fr); c = __builtin_amdgcn_cosf(fr);
}

constexpr float F8_WSCALE = 64.f;
constexpr float F8_ASCALE = 8.f;
struct TrJob { const float* src; bf16_t* dst; const float* kscale; int K, N, lds, ldd, mode, radd, f8; };
__device__ __forceinline__ void tr_item(const TrJob& J, int item, float*  , int lane) {
    const int nblk = J.N / 32, kb = item / nblk, nb = item % nblk, k0 = 64 * kb, n0 = 32 * nb, c = lane & 7, r = lane >> 3;
    const float* sp = J.src + (size_t)(k0 + 8 * r) * J.lds + n0 + 4 * c;
    f32x4 v[8];
#pragma unroll
    for (int i = 0; i < 8; ++i) v[i] = *(const f32x4*)(sp + (size_t)i * J.lds);
    if (J.kscale) {
#pragma unroll
        for (int i = 0; i < 8; ++i) v[i] *= J.kscale[k0 + 8 * r + i]; }
#pragma unroll
    for (int j = 0; j < 4; ++j) { const int sn = n0 + 4 * c + j; const int dn = J.mode ? ((sn >> 7) * 256 + J.radd + (sn & 127)) : sn;
        if (J.f8) { u32x2 o; o.x = pk4_fp8(v[0][j] * F8_WSCALE, v[1][j] * F8_WSCALE, v[2][j] * F8_WSCALE, v[3][j] * F8_WSCALE); o.y = pk4_fp8(v[4][j] * F8_WSCALE, v[5][j] * F8_WSCALE, v[6][j] * F8_WSCALE, v[7][j] * F8_WSCALE);
            *(u32x2*)((unsigned char*)J.dst + (size_t)dn * J.ldd + k0 + 8 * r) = o; }
        else { u32x4 o; o.x = pk2(v[0][j], v[1][j]); o.y = pk2(v[2][j], v[3][j]); o.z = pk2(v[4][j], v[5][j]); o.w = pk2(v[6][j], v[7][j]);
            *(u32x4*)(J.dst + (size_t)dn * J.ldd + k0 + 8 * r) = o; } }
}
typedef short bf16x8 __attribute__((ext_vector_type(8)));
typedef float f32x16 __attribute__((ext_vector_type(16)));
#define GAS __attribute__((address_space(1)))
typedef GAS unsigned gu32;
#define RLX_AGENT __ATOMIC_RELAXED, __HIP_MEMORY_SCOPE_AGENT

constexpr int NWAVES = 8;
__device__ __forceinline__ int launder(int v) { asm volatile("" : "+v"(v)); return v; }
constexpr int RING_OFF = 0, RING_BYTES = 131072;
constexpr int LDSCTL_OFF = RING_BYTES, MISC_OFF = LDSCTL_OFF + 320;
constexpr int ROWTAB_OFF = RING_BYTES + 1024;
constexpr int LDS_BYTES = 147456;
constexpr int CW_QUEUE = 16384;
constexpr int CW_BAR = 65536;

#define XB_TMO      128
#define XB_XCNT(j)  (256  + 64 * (j))
#define XB_XSUB(j)  (1280 + 64 * (j))
#define XB_XGEN(j)  (2304 + 64 * (j))
#define XB_TOP      3328
#define XB_TOPGEN   3392
#define XCD_BAR_WORDS 3456
#define XB_SPIN_CAP (1u << 18)
__device__ __forceinline__ unsigned xb_ld(unsigned* p)              { return __hip_atomic_load(p, __ATOMIC_RELAXED, __HIP_MEMORY_SCOPE_AGENT); }
__device__ __forceinline__ unsigned xb_add(unsigned* p, unsigned v) { return __hip_atomic_fetch_add(p, v, __ATOMIC_RELAXED, __HIP_MEMORY_SCOPE_AGENT); }
__device__ __forceinline__ unsigned xb_xcc_id() { return (unsigned)__builtin_amdgcn_s_getreg((3 << 11) | 20) & 0xFu; }
#define XB_SPIN(cond, bar) do { unsigned _sp = 0; while (cond) { __builtin_amdgcn_s_sleep(1); \
    if ((++_sp & 255u) == 0u) { if (xb_ld(&(bar)[XB_TMO])) break; if (_sp > XB_SPIN_CAP) { atomicAdd(&(bar)[XB_TMO], 1u); break; } } } } while (0)
struct XcdBarrier { unsigned* bar; unsigned x; volatile LAS unsigned* st; int wv; };
__device__ __forceinline__ XcdBarrier xcd_barrier_post(unsigned* bar, volatile LAS unsigned* st, int wv) {
    XcdBarrier b; b.bar = bar; b.x = xb_xcc_id(); b.st = st; b.wv = wv;
    if (tid_of(wv) == 0) (void)xb_add(&bar[XB_XCNT(b.x)], 1u);
    return b;
}
__device__ __forceinline__ void xcd_barrier_complete(unsigned* bar, unsigned x, unsigned& nloc, unsigned& nx) {
    const unsigned G = gridDim.x * gridDim.y * gridDim.z;
    unsigned sum, cnt, mine, sp = 0u;
    for (;;) {
        sum = 0u; cnt = 0u; mine = 0u;
#pragma unroll
        for (unsigned j = 0; j < 16; ++j) { const unsigned c = xb_ld(&bar[XB_XCNT(j)]); sum += c; cnt += (c > 0u) ? 1u : 0u; mine = (j == x) ? c : mine; }
        if (sum == G) break;
        __builtin_amdgcn_s_sleep(1);
        if ((++sp & 255u) == 0u) { if (xb_ld(&bar[XB_TMO])) break; if (sp > XB_SPIN_CAP) { atomicAdd(&bar[XB_TMO], 1u); break; } }
    }
    nloc = mine > 0u ? mine : 1u; nx = cnt > 0u ? cnt : 1u;
}
__device__ __forceinline__ void xcd_barrier(const XcdBarrier& b) {
    asm volatile("s_waitcnt vmcnt(0)" ::: "memory");
    __syncthreads();
    if (tid_of(b.wv) == 0) {
        unsigned* bar = b.bar;
        __builtin_amdgcn_s_waitcnt(0);
        unsigned nloc = b.st[0], nx = b.st[1];
        if (nloc == 0u) { xcd_barrier_complete(bar, b.x, nloc, nx); b.st[0] = nloc; b.st[1] = nx; }
        const unsigned old = xb_add(&bar[XB_XSUB(b.x)], 1u);
        const unsigned gen = old / nloc;
        if (old + 1u == (gen + 1u) * nloc) {
            __builtin_amdgcn_fence(__ATOMIC_RELEASE, "agent");
            asm volatile("s_waitcnt vmcnt(0)" ::: "memory");
            const unsigned og = xb_add(&bar[XB_TOP], 1u);
            const unsigned tg = og / nx;
            if (og + 1u == (tg + 1u) * nx) xb_add(&bar[XB_TOPGEN], 1u);
            else XB_SPIN(xb_ld(&bar[XB_TOPGEN]) == tg, bar);
            __builtin_amdgcn_fence(__ATOMIC_ACQUIRE, "agent");
            xb_add(&bar[XB_XGEN(b.x)], 1u);
            asm volatile("s_waitcnt vmcnt(0)" ::: "memory");
        } else {
            XB_SPIN(xb_ld(&bar[XB_XGEN(b.x)]) == gen, bar);
            __builtin_amdgcn_fence(__ATOMIC_ACQUIRE, "agent");
            asm volatile("s_waitcnt vmcnt(0)" ::: "memory");
        }
    }
    __syncthreads();
}

namespace pg8 {
typedef int i32x4v __attribute__((ext_vector_type(4)));
typedef int i32x8v __attribute__((ext_vector_type(8)));
constexpr int BM = 256, BK = 64, HALF = 128, HTB = HALF * BK * 2, STAGE_BYTES = 8 * HTB, NXCD = 8, WGM = 8;
__host__ __device__ __forceinline__ int lds_byte(int r, int c) { const int st = (r >> 4) * 2 + (c >> 5), rr = r & 15, cc = c & 31, ob = rr * 64 + cc * 2; return st * 1024 + (ob ^ (((ob >> 9) & 1) << 5)); }
__host__ __device__ __forceinline__ void stage_rc(int b, int& R, int& C) { const int st = b / 1024, sb = b % 1024, swz = sb ^ (((sb >> 9) & 1) << 5); R = (st >> 1) * 16 + swz / 64; C = (st & 1) * 32 + (swz % 64) / 2; }
__host__ __device__ __forceinline__ int perm32(int rho) { const int n = rho >> 4, i = rho & 15; return 8 * (i >> 2) + 4 * n + (i & 3); }
struct Unit { int pm, pn; };
constexpr int RST_OFF = 4096, RST_UNITS = 11;
struct StaticOrder {
    int nM, nN, nwg, G, c, wgm;
    __device__ __forceinline__ void init(int nM_, int nN_, int G_, int c_, int wgm_ = WGM) { nM = nM_; nN = nN_; nwg = nM * nN; G = G_; c = c_; wgm = wgm_; }
    __device__ __forceinline__ bool next(int i, Unit& u) const {
        const long L = (long)i * G + c; if (L >= nwg) return false;
        int wgid = (int)L; { const int q = nwg / NXCD, r = nwg % NXCD, xcd = wgid % NXCD, off = wgid / NXCD; wgid = (xcd < r ? xcd * (q + 1) : r * (q + 1) + (xcd - r) * q) + off; }
        const int nig = wgm * nN, gid = wgid / nig, fm = gid * wgm, gsz = (nM - fm) < wgm ? (nM - fm) : wgm;
        u.pm = fm + ((wgid % nig) % gsz); u.pn = (wgid % nig) / gsz; return true;
    }
};
__device__ __forceinline__ f32x4 mma_f8(bf16x8 b0, bf16x8 b1, bf16x8 a0, bf16x8 a1, f32x4 c) {
    const i32x8v B = __builtin_shufflevector(__builtin_bit_cast(i32x4v, b0), __builtin_bit_cast(i32x4v, b1), 0, 1, 2, 3, 4, 5, 6, 7);
    const i32x8v A = __builtin_shufflevector(__builtin_bit_cast(i32x4v, a0), __builtin_bit_cast(i32x4v, a1), 0, 1, 2, 3, 4, 5, 6, 7);
    return __builtin_amdgcn_mfma_scale_f32_16x16x128_f8f6f4(B, A, c, 0, 0, 0, 0, 0, 0);
}
__device__ __forceinline__ const char* sgpr_ptr(const char* p) { asm volatile("" : "+s"(p)); return p; }
__device__ __forceinline__ unsigned cvt_pk_bf16(float lo, float hi) { unsigned r; asm volatile("v_cvt_pk_bf16_f32 %0, %1, %2" : "=v"(r) : "v"(lo), "v"(hi)); return r; }


template <int ESZ_>
struct ProbDenseT {
    static constexpr bool GATHER = false; static constexpr int ESZ = ESZ_;
    const bf16_t* A; const bf16_t* Bt; int lda, K;
    __device__ __forceinline__ int ldb_() const { return K; }
    __device__ __forceinline__ size_t a_base(const Unit& u) const { return (size_t)(u.pm * BM) * lda * ESZ; }
    __device__ __forceinline__ const char* b_base(const Unit& u) const { return (const char*)Bt + (size_t)u.pn * BM * K * ESZ; }
};
using ProbDense = ProbDenseT<2>; using ProbDense8 = ProbDenseT<1>;
struct MoeMap {
    const LAS int* tp;
    __device__ __forceinline__ void locate(int pm, int& e, int& lt, int& cnt) const {
        const i32x4v a = *(const LAS i32x4v*)tp, b = *(const LAS i32x4v*)(tp + 4);
        e = (pm >= a.y) + (pm >= a.z) + (pm >= a.w) + (pm >= b.x) + (pm >= b.y) + (pm >= b.z) + (pm >= b.w);
        e = __builtin_amdgcn_readfirstlane(e); lt = __builtin_amdgcn_readfirstlane(pm - tp[e]); cnt = __builtin_amdgcn_readfirstlane(tp[9 + e]);
    }
};
struct ProbMoeUp {
    static constexpr bool GATHER = true; static constexpr int ESZ = 1;
    const bf16_t* A; const bf16_t* Bt; int lda, K; MoeMap mm; const int* list; const float* wl;
    __device__ __forceinline__ int ldb_() const { return K; }
    __device__ __forceinline__ size_t row_idx(const Unit& u, int row) const { int e, lt, cnt; mm.locate(u.pm, e, lt, cnt); const int r = lt * BM + row; return (size_t)e * T + (r < cnt ? r : cnt - 1); }
    __device__ __forceinline__ size_t a_base(const Unit&) const { return 0; }
    __device__ __forceinline__ const char* b_base(const Unit& u) const { int e, lt, cnt; mm.locate(u.pm, e, lt, cnt); return (const char*)Bt + ((size_t)e * (2 * DEX) + (size_t)u.pn * BM) * K * ESZ; }
};
struct ProbMoeDown {
    static constexpr bool GATHER = false; static constexpr int ESZ = 1;
    const bf16_t* A; const bf16_t* Bt; int lda, K; MoeMap mm;
    __device__ __forceinline__ int ldb_() const { return K; }
    __device__ __forceinline__ size_t a_base(const Unit& u) const { return (size_t)(u.pm * BM) * lda * ESZ; }
    __device__ __forceinline__ const char* b_base(const Unit& u) const { int e, lt, cnt; mm.locate(u.pm, e, lt, cnt); return (const char*)Bt + ((size_t)e * D + (size_t)u.pn * BM) * K * ESZ; }
};

struct ProbMoeDownSlice {
    static constexpr bool GATHER = false; static constexpr int ESZ = 1;
    const bf16_t* A; const bf16_t* Bt; int lda, K, kfull, tile0; MoeMap mm;
    __device__ __forceinline__ int ldb_() const { return kfull; }
    __device__ __forceinline__ size_t a_base(const Unit& u) const { return ((size_t)((tile0 + u.pm) * BM) * lda + (size_t)(u.pn >> 2) * K) * ESZ; }
    __device__ __forceinline__ const char* b_base(const Unit& u) const { int e, lt, cnt; mm.locate(tile0 + u.pm, e, lt, cnt); return (const char*)Bt + (((size_t)e * D + (size_t)(u.pn & 3) * BM) * kfull + (size_t)(u.pn >> 2) * K) * ESZ; }
};
struct EpiPartialBf16 {
    static constexpr bool TOKTAB = false; static constexpr bool TAB = false; static constexpr int NVM = 32; static constexpr bool PERM = false;
    bf16_t* P; float scale;
    __device__ __forceinline__ void operator()(const f32x4 (&acc)[2][2][4][2], const Unit& u, int wr, int wc, int fr, int fq, LAS unsigned char* rt, int slot) const {
        bf16_t* tile = P + (size_t)(u.pm * 28 + u.pn) * (BM * BM) + (size_t)(wr * 64 + fr) * BM + wc * 32 + 4 * fq;
#pragma unroll
        for (int ai = 0; ai < 2; ++ai)
#pragma unroll
            for (int m = 0; m < 4; ++m)
#pragma unroll
                for (int bj = 0; bj < 2; ++bj)
#pragma unroll
                    for (int n = 0; n < 2; ++n) { const f32x4 v = acc[ai][bj][m][n] * scale; u32x2 w; w.x = cvt_pk_bf16(v.x, v.y); w.y = cvt_pk_bf16(v.z, v.w);
                        *(u32x2*)(tile + (size_t)(ai * HALF + m * 16) * BM + bj * HALF + n * 16) = w; }
    }
};
__device__ __forceinline__ float row_rs(const float* ss, int row) {
    const f32x4* p = (const f32x4*)(ss + (size_t)row * 16); const f32x4 a = p[0], b = p[1], c = p[2], d = p[3];
    return rsqrtf((((a.x + a.y) + (a.z + a.w)) + ((b.x + b.y) + (b.z + b.w)) + ((c.x + c.y) + (c.z + c.w)) + ((d.x + d.y) + (d.z + d.w))) * (1.0f / D) + EPS);
}
struct EpiStoreBf16 {
    static constexpr bool TOKTAB = false; static constexpr bool TAB = true; static constexpr int NVM = 16; static constexpr bool PERM = true;
    bf16_t* O; int ldc; const float* ss;
    __device__ __forceinline__ void operator()(const f32x4 (&acc)[2][2][4][2], const Unit& u, int wr, int wc, int fr, int fq, LAS unsigned char* rt, int slot) const {
        const int row0 = u.pm * BM + wr * 64 + fr, col0 = u.pn * BM + wc * 32 + 8 * fq;
        float rsv[2][4];
#pragma unroll
        for (int ai = 0; ai < 2; ++ai)
#pragma unroll
            for (int m = 0; m < 4; ++m) rsv[ai][m] = ss ? ((const LAS float*)(rt + RST_OFF))[slot * 256 + wr * 64 + fr + ai * HALF + m * 16] : 1.0f;
#pragma unroll
        for (int ai = 0; ai < 2; ++ai)
#pragma unroll
            for (int m = 0; m < 4; ++m) { bf16_t* rowp = O + (size_t)(row0 + ai * HALF + m * 16) * ldc + col0; const float rs = rsv[ai][m];
#pragma unroll
                for (int bj = 0; bj < 2; ++bj) { const f32x4 v0 = acc[ai][bj][m][0] * rs, v1 = acc[ai][bj][m][1] * rs;
                    u32x4 w; w.x = cvt_pk_bf16(v0[0], v0[1]); w.y = cvt_pk_bf16(v0[2], v0[3]); w.z = cvt_pk_bf16(v1[0], v1[1]); w.w = cvt_pk_bf16(v1[2], v1[3]);
                    *(u32x4*)(rowp + bj * HALF) = w; } }
    }
};
__device__ __forceinline__ void bf16x8_to_f32(const u32x4& w, f32x4& lo, f32x4& hi) {
    lo = (f32x4){__uint_as_float(w.x << 16), __uint_as_float(w.x & 0xffff0000u), __uint_as_float(w.y << 16), __uint_as_float(w.y & 0xffff0000u)};
    hi = (f32x4){__uint_as_float(w.z << 16), __uint_as_float(w.z & 0xffff0000u), __uint_as_float(w.w << 16), __uint_as_float(w.w & 0xffff0000u)};
}
template <bool IN_F32>
struct EpiResid {
    static constexpr bool TOKTAB = false; static constexpr bool TAB = false; static constexpr int NVM = 16; static constexpr bool PERM = true;
    const void* resid; bf16_t* out; int ldc; float* ss; unsigned char* x8;
    static constexpr int RB = IN_F32 ? 2 : 4;
    __device__ __forceinline__ void operator()(const f32x4 (&acc)[2][2][4][2], const Unit& u, int wr, int wc, int fr, int fq, LAS unsigned char* rt, int slot) const {
        const int row0 = u.pm * BM + wr * 64 + fr, col0 = u.pn * BM + wc * 32 + 8 * fq;
#pragma unroll
        for (int ai = 0; ai < 2; ++ai)
#pragma unroll
            for (int mb = 0; mb < 4; mb += RB) {
                f32x4 rf[RB][2][2]; u32x4 rb[RB][2];
#pragma unroll
                for (int m2 = 0; m2 < RB; ++m2) { const size_t off = (size_t)(row0 + ai * HALF + (mb + m2) * 16) * ldc + col0;
#pragma unroll
                    for (int bj = 0; bj < 2; ++bj) {
                        if constexpr (IN_F32) { rf[m2][bj][0] = *(const f32x4*)((const float*)resid + off + bj * HALF); rf[m2][bj][1] = *(const f32x4*)((const float*)resid + off + bj * HALF + 4); }
                        else rb[m2][bj] = *(const u32x4*)((const bf16_t*)resid + off + bj * HALF); } }
#pragma unroll
                for (int m2 = 0; m2 < RB; ++m2) { const int m = mb + m2, row = row0 + ai * HALF + m * 16; const size_t off = (size_t)row * ldc + col0; float s = 0.f;
#pragma unroll
                    for (int bj = 0; bj < 2; ++bj) { f32x4 v0, v1;
                        if constexpr (IN_F32) { v0 = rf[m2][bj][0]; v1 = rf[m2][bj][1]; } else bf16x8_to_f32(rb[m2][bj], v0, v1);
                        v0 += acc[ai][bj][m][0]; v1 += acc[ai][bj][m][1];
                        u32x4 w; w.x = cvt_pk_bf16(v0.x, v0.y); w.y = cvt_pk_bf16(v0.z, v0.w); w.z = cvt_pk_bf16(v1.x, v1.y); w.w = cvt_pk_bf16(v1.z, v1.w);
                        *(u32x4*)(out + off + bj * HALF) = w;
                        if (x8) { u32x2 w8; w8.x = pk4_fp8(v0.x * F8_ASCALE, v0.y * F8_ASCALE, v0.z * F8_ASCALE, v0.w * F8_ASCALE); w8.y = pk4_fp8(v1.x * F8_ASCALE, v1.y * F8_ASCALE, v1.z * F8_ASCALE, v1.w * F8_ASCALE); *(u32x2*)(x8 + off + bj * HALF) = w8; }
                        if (ss) s += ((v0.x * v0.x + v0.y * v0.y) + (v0.z * v0.z + v0.w * v0.w)) + ((v1.x * v1.x + v1.y * v1.y) + (v1.z * v1.z + v1.w * v1.w)); }
                    if (ss) { s += xor_shfl<16>(s); s = half_sum(s); if (fq == 0) ((LAS float*)rt)[wc * 256 + (row - u.pm * BM)] = s; } }
                asm volatile("" ::: "memory"); }
        if (ss) {
            __syncthreads();
            const int t = wr * 256 + wc * 64 + fq * 16 + fr;
            if (t < 256) { const LAS float* q = (const LAS float*)rt + t; ss[((size_t)u.pm * BM + t) * 4 + u.pn] = (q[0] + q[256]) + (q[512] + q[768]); }
        }
    }
};
__device__ __forceinline__ float silu_fast(float x) { return x * __builtin_amdgcn_rcpf(1.0f + __builtin_amdgcn_exp2f(-1.4426950408889634f * x)); }
typedef float f32x2v __attribute__((ext_vector_type(2)));
__device__ __forceinline__ f32x4 swiglu4(const f32x4& g, const f32x4& u, float c1, float k) {
    const f32x2v c1v = {c1, c1}, kv = {k, k};
    const f32x2v ga = {g.x, g.y}, gb = {g.z, g.w}, ua = {u.x, u.y}, ub = {u.z, u.w};
    const f32x2v aa = ga * c1v, ab = gb * c1v;
    f32x2v ta = {__builtin_amdgcn_exp2f(aa.x), __builtin_amdgcn_exp2f(aa.y)}, tb = {__builtin_amdgcn_exp2f(ab.x), __builtin_amdgcn_exp2f(ab.y)};
    const f32x2v da = __builtin_elementwise_fma(ta, kv, kv), db = __builtin_elementwise_fma(tb, kv, kv);
    const f32x2v ra = {__builtin_amdgcn_rcpf(da.x), __builtin_amdgcn_rcpf(da.y)}, rb = {__builtin_amdgcn_rcpf(db.x), __builtin_amdgcn_rcpf(db.y)};
    const f32x2v oa = (ga * ua) * ra, ob = (gb * ub) * rb;
    return (f32x4){oa.x, oa.y, ob.x, ob.y};
}
struct EpiSwiglu {
    static constexpr bool TOKTAB = false; static constexpr bool TAB = true; static constexpr int NVM = 8; static constexpr bool PERM = true;
    bf16_t* O; int ldc; const float* ss; float wsc;
    __device__ __forceinline__ void operator()(const f32x4 (&acc)[2][2][4][2], const Unit& u, int wr, int wc, int fr, int fq, LAS unsigned char* rt, int slot) const {
        const int row0 = u.pm * BM + wr * 64 + fr, col0 = u.pn * HALF + wc * 32 + 8 * fq;
        float rsv[2][4];
#pragma unroll
        for (int ai = 0; ai < 2; ++ai)
#pragma unroll
            for (int m = 0; m < 4; ++m) rsv[ai][m] = ss ? ((const LAS float*)(rt + RST_OFF))[slot * 256 + wr * 64 + fr + ai * HALF + m * 16] : 1.0f;
#pragma unroll
        for (int ai = 0; ai < 2; ++ai)
#pragma unroll
            for (int m = 0; m < 4; ++m) { bf16_t* rowp = O + (size_t)(row0 + ai * HALF + m * 16) * ldc + col0; const float rs = rsv[ai][m] * wsc;
                const float c1 = -1.4426950408889634f * rs, k = __builtin_amdgcn_rcpf(rs * rs);
                const f32x4 o0 = swiglu4(acc[ai][0][m][0], acc[ai][1][m][0], c1, k), o1 = swiglu4(acc[ai][0][m][1], acc[ai][1][m][1], c1, k);
                u32x4 w; w.x = cvt_pk_bf16(o0[0], o0[1]); w.y = cvt_pk_bf16(o0[2], o0[3]); w.z = cvt_pk_bf16(o1[0], o1[1]); w.w = cvt_pk_bf16(o1[2], o1[3]);
                *(u32x4*)rowp = w; }
    }
};
struct EpiSwigluMoe {
    static constexpr bool TOKTAB = false; static constexpr bool TAB = false; static constexpr int NVM = 8; static constexpr bool PERM = true;
    unsigned char* O; int ldc; MoeMap mm;
    __device__ __forceinline__ void operator()(const f32x4 (&acc)[2][2][4][2], const Unit& u, int wr, int wc, int fr, int fq, LAS unsigned char* rt, int slot) const {
        int e, lt, cnt; mm.locate(u.pm, e, lt, cnt);
        const int trow0 = wr * 64 + fr, col0 = u.pn * HALF + wc * 32 + 8 * fq;
        float w8[2][4];
#pragma unroll
        for (int ai = 0; ai < 2; ++ai)
#pragma unroll
            for (int m = 0; m < 4; ++m) { const int tr = trow0 + ai * HALF + m * 16; const float w = ((const LAS float*)(rt + 2048 + slot))[tr]; w8[ai][m] = (lt * BM + tr < cnt) ? w : 0.f; }
#pragma unroll
        for (int ai = 0; ai < 2; ++ai)
#pragma unroll
            for (int m = 0; m < 4; ++m) { const int tr = trow0 + ai * HALF + m * 16;
                unsigned char* rowp = O + (size_t)(u.pm * BM + tr) * ldc + col0;
                const float wgt = w8[ai][m], c1 = -1.4426950408889634f / F8_WSCALE, k = wgt > 0.f ? __builtin_amdgcn_rcpf(wgt * (F8_ASCALE / (F8_WSCALE * F8_WSCALE))) : 1.0e30f;
                const f32x4 o0 = swiglu4(acc[ai][0][m][0], acc[ai][1][m][0], c1, k), o1 = swiglu4(acc[ai][0][m][1], acc[ai][1][m][1], c1, k);
                u32x2 w; w.x = pk4_fp8(o0[0], o0[1], o0[2], o0[3]); w.y = pk4_fp8(o1[0], o1[1], o1[2], o1[3]);
                *(u32x2*)rowp = w; }
    }
};
template <bool OUT_F32>
struct EpiScatterMoe {
    static constexpr bool TAB = false; static constexpr bool TOKTAB = true; static constexpr int NVM = 0; static constexpr bool PERM = true;
    const bf16_t* xs; void* out; int ldc; MoeMap mm; const int* list; float scale;
    __device__ __forceinline__ int tok_of(const Unit& u, int row) const { int e, lt, cnt; mm.locate(u.pm, e, lt, cnt); const int lr = lt * BM + row; return lr < cnt ? list[(size_t)e * T + lr] : -1; }
    __device__ __forceinline__ void operator()(const f32x4 (&acc)[2][2][4][2], const Unit& u, int wr, int wc, int fr, int fq, LAS unsigned char* rt, int slot) const {
        const int trow0 = wr * 64 + fr, col0 = u.pn * BM + wc * 32 + 8 * fq;
        int tok[2][4];
#pragma unroll
        for (int ai = 0; ai < 2; ++ai)
#pragma unroll
            for (int m = 0; m < 4; ++m) tok[ai][m] = ((const LAS int*)(rt + RST_OFF))[slot * 256 + trow0 + ai * HALF + m * 16];
#pragma unroll
        for (int ai = 0; ai < 2; ++ai) {
            u32x4 rb[4][2];
#pragma unroll
            for (int m = 0; m < 4; ++m) { const bf16_t* rowp = xs + (size_t)(tok[ai][m] >= 0 ? tok[ai][m] : 0) * ldc + col0;
#pragma unroll
                for (int bj = 0; bj < 2; ++bj) rb[m][bj] = *(const u32x4*)(rowp + bj * HALF); }
#pragma unroll
            for (int m = 0; m < 4; ++m) { if (tok[ai][m] >= 0) { const size_t off = (size_t)tok[ai][m] * ldc + col0;
#pragma unroll
                for (int bj = 0; bj < 2; ++bj) { f32x4 v0, v1; bf16x8_to_f32(rb[m][bj], v0, v1); v0 += acc[ai][bj][m][0] * scale; v1 += acc[ai][bj][m][1] * scale;
                    if constexpr (OUT_F32) { *(f32x4*)((float*)out + off + bj * HALF) = v0; *(f32x4*)((float*)out + off + bj * HALF + 4) = v1; }
                    else { u32x4 w; w.x = cvt_pk_bf16(v0.x, v0.y); w.y = cvt_pk_bf16(v0.z, v0.w); w.z = cvt_pk_bf16(v1.x, v1.y); w.w = cvt_pk_bf16(v1.z, v1.w); *(u32x4*)((bf16_t*)out + off + bj * HALF) = w; } } } }
            asm volatile("" ::: "memory"); }
    }
};

template <class Prob, class Epi>
__device__ __forceinline__ void gemm_phase(LAS unsigned char* lds, LAS unsigned char* rowtab, const Prob& pb, const StaticOrder& S, const Epi& E, int wv) {
    const int tid = launder(tid_of(wv)), wid = __builtin_amdgcn_readfirstlane(tid >> 6), lane = tid & 63, wr = wid >> 2, wc = wid & 3, fr = lane & 15, fq = lane >> 4;
    const int K = pb.K, nt = K * Prob::ESZ / (2 * BK);
    int R0, C0; stage_rc(tid * 16, R0, C0);
    const unsigned c2 = (unsigned)C0 * 2u;
    const unsigned voffB = (unsigned)((Epi::PERM ? ((R0 & ~31) + perm32(R0 & 31)) : R0) * pb.ldb_()) * (unsigned)Prob::ESZ + c2;
    const unsigned voffA = Prob::GATHER ? 0u : (unsigned)(R0 * pb.lda) * (unsigned)Prob::ESZ + c2;
    const size_t step64B = (size_t)64 * pb.ldb_() * Prob::ESZ, step64A = (size_t)64 * pb.lda * Prob::ESZ, hstepA = (size_t)HALF * pb.lda * Prob::ESZ;
    const size_t hstepB = (size_t)HALF * pb.ldb_() * Prob::ESZ;
    const unsigned ldsw = (unsigned)wid * 1024u;
    const int aoff = lds_byte(wr * 64 + fr, fq * 8), boff = lds_byte(wc * 32 + fr, fq * 8);
    const char* Ab = (const char*)pb.A;
    LAS unsigned char* tabl = rowtab + R0 * 4;
    int slotC = 0, slotN = 1024;
    const unsigned rowbytes = (unsigned)(pb.lda * Prob::ESZ);
#define PG8_TABLES(un, slot) do { if constexpr (Prob::GATHER) { if (wid < 4) { const size_t _ix = pb.row_idx(un, tid); \
        __builtin_amdgcn_global_load_lds((const unsigned*)(pb.list + _ix), (LAS unsigned*)(rowtab + (slot) + wid * 256), 4, 0, 0); \
        __builtin_amdgcn_global_load_lds((const unsigned*)(pb.wl + _ix), (LAS unsigned*)(rowtab + 2048 + (slot) + wid * 256), 4, 0, 0); } } } while (0)
#define PG8_SA(b, h) (((b) * 2 + (h)) * HTB)
#define PG8_SB(b, h) ((4 + (b) * 2 + (h)) * HTB)
#define PG8_STAGE2(bufoff, g0, v0, g1, v1) do { const char* _p0 = sgpr_ptr((const char*)(g0)); const char* _p1 = sgpr_ptr((const char*)(g1)); const unsigned _v0 = (unsigned)launder((int)(v0)), _v1 = (unsigned)launder((int)(v1)); \
        __builtin_amdgcn_global_load_lds((const unsigned*)(_p0 + _v0), (LAS unsigned*)(lds + (bufoff) + ldsw), 16, 0, 0); \
        __builtin_amdgcn_global_load_lds((const unsigned*)(_p1 + _v1), (LAS unsigned*)(lds + (bufoff) + ldsw + 8192), 16, 0, 0); } while (0)
#define PG8_STAGE_B(bufoff, gbase) PG8_STAGE2(bufoff, gbase, voffB, (gbase) + step64B, voffB)
#define PG8_STAGE_A(bufoff, gbase) do { if constexpr (Prob::GATHER) PG8_STAGE2(bufoff, gbase, q0, gbase, q1); else PG8_STAGE2(bufoff, (gbase) + aofs, voffA, (gbase) + aofs + step64A, voffA); } while (0)
#define PG8_AOFF(nx, h, q0, q1) do { if constexpr (Prob::GATHER) { const LAS unsigned* _t = (const LAS unsigned*)(tabl + ((nx) ? slotN : slotC) + (h) * 512); q0 = _t[0] * rowbytes + c2; q1 = _t[64] * rowbytes + c2; } \
        else { aofs = ((nx) ? aN : aC) + (h) * hstepA; } } while (0)
#define PG8_LDA(dst, b, h) do { _Pragma("unroll") for (int m = 0; m < 4; ++m) _Pragma("unroll") for (int k = 0; k < 2; ++k) dst[m][k] = *(const LAS bf16x8*)(lds + PG8_SA(b, h) + aoff + m * 2048 + k * 1024); } while (0)
#define PG8_LDB(dst, b, h) do { _Pragma("unroll") for (int n = 0; n < 2; ++n) _Pragma("unroll") for (int k = 0; k < 2; ++k) dst[n][k] = *(const LAS bf16x8*)(lds + PG8_SB(b, h) + boff + n * 2048 + k * 1024); } while (0)
#define PG8_MMA(ai, bj, At, Bt) do { __builtin_amdgcn_s_setprio(1); _Pragma("unroll") for (int m = 0; m < 4; ++m) _Pragma("unroll") for (int n = 0; n < 2; ++n) { \
        if constexpr (Prob::ESZ == 1) acc[ai][bj][m][n] = mma_f8(Bt[n][0], Bt[n][1], At[m][0], At[m][1], acc[ai][bj][m][n]); \
        else { _Pragma("unroll") for (int k = 0; k < 2; ++k) acc[ai][bj][m][n] = __builtin_amdgcn_mfma_f32_16x16x32_bf16(Bt[n][k], At[m][k], acc[ai][bj][m][n], 0, 0, 0); } } __builtin_amdgcn_s_setprio(0); } while (0)
#define PG8_WAIT_V(n) asm volatile("s_waitcnt vmcnt(" #n ")" ::: "memory")
#define PG8_WAIT_V8F(first) do { if (first) asm volatile("s_waitcnt vmcnt(%0)" :: "n"(8 + Epi::NVM) : "memory"); else asm volatile("s_waitcnt vmcnt(8)" ::: "memory"); } while (0)
#define PG8_WAIT_L(n) asm volatile("s_waitcnt lgkmcnt(" #n ")" ::: "memory")
#define PG8_BAR __builtin_amdgcn_s_barrier()
#define PG8_SCHED __builtin_amdgcn_sched_barrier(0)
    Unit cur, nxt; int ui = 0;
    if (!S.next(0, cur)) return;
    f32x4 acc[2][2][4][2];
#pragma unroll
    for (int a = 0; a < 2; ++a)
#pragma unroll
        for (int b = 0; b < 2; ++b)
#pragma unroll
            for (int m = 0; m < 4; ++m)
#pragma unroll
                for (int n = 0; n < 2; ++n) acc[a][b][m][n] = (f32x4){0.f, 0.f, 0.f, 0.f};
    bf16x8 At[4][2], B0[2][2], B1[2][2];
    size_t aC = 0, aN = 0, aofs = 0;
    unsigned q0 = 0, q1 = 0;
    if constexpr (Prob::GATHER) { PG8_TABLES(cur, 0); PG8_WAIT_V(0); PG8_BAR; }
    else aC = pb.a_base(cur);
    const char* cB = pb.b_base(cur);
    PG8_STAGE_B(PG8_SB(0, 0), cB); PG8_STAGE_B(PG8_SB(0, 1), cB + hstepB);
    PG8_AOFF(false, 0, q0, q1); PG8_STAGE_A(PG8_SA(0, 0), Ab); PG8_AOFF(false, 1, q0, q1); PG8_STAGE_A(PG8_SA(0, 1), Ab);
    if (wr == 1) PG8_BAR;
    PG8_WAIT_V(2); PG8_BAR;
    PG8_STAGE_B(PG8_SB(1, 0), cB + 128); PG8_AOFF(false, 0, q0, q1); PG8_STAGE_A(PG8_SA(1, 0), Ab + 128); PG8_STAGE_B(PG8_SB(1, 1), cB + hstepB + 128);
    if constexpr (Epi::TOKTAB) {
        LAS int* tkT = (LAS int*)(rowtab + RST_OFF);
        for (int i0 = 0; i0 < RST_UNITS + 1; i0 += 2) { Unit um; const int iu = i0 + __builtin_amdgcn_readfirstlane(tid >> 8);
            if (iu < RST_UNITS && S.next(iu, um)) tkT[iu * 256 + (tid & 255)] = E.tok_of(um, tid & 255); }
        __syncthreads();
    }
    if constexpr (Epi::TAB) {
        if (E.ss != nullptr) {
            LAS float* rsT = (LAS float*)(rowtab + RST_OFF);
            for (int i0 = 0; i0 < RST_UNITS + 1; i0 += 2) { Unit um; const int iu = i0 + __builtin_amdgcn_readfirstlane(tid >> 8);
                if (iu < RST_UNITS && S.next(iu, um)) { const f32x4 q4 = *(const f32x4*)(E.ss + ((size_t)um.pm * BM + (tid & 255)) * 4);
                    rsT[iu * 256 + (tid & 255)] = rsqrtf(((q4.x + q4.y) + (q4.z + q4.w)) * (1.0f / D) + EPS); } }
            __syncthreads();
        }
    }
    PG8_WAIT_V(6); PG8_BAR;
    for (;;) {
        const bool has_next = S.next(ui + 1, nxt);
        const char* nB = has_next ? pb.b_base(nxt) : cB;
        if constexpr (Prob::GATHER) { if (has_next) PG8_TABLES(nxt, slotN); }
        else aN = has_next ? pb.a_base(nxt) : aC;
        for (int t = 0; t < nt; t += 2) {
            const bool last = (t == nt - 2);
            const char* a1 = Ab + (size_t)(t + 1) * 128;
            const char* a2 = last ? Ab : Ab + (size_t)(t + 2) * 128; const char* b2 = last ? nB : cB + (size_t)(t + 2) * 128;
            const char* a3 = a2 + 128; const char* b3 = b2 + 128;
            PG8_AOFF(false, 1, q0, q1); PG8_LDB(B0, 0, 0); PG8_LDB(B1, 0, 1); PG8_SCHED; PG8_LDA(At, 0, 0); PG8_STAGE_A(PG8_SA(1, 1), a1);
            PG8_WAIT_V8F(t == 0); PG8_WAIT_L(0); PG8_BAR; PG8_MMA(0, 0, At, B0); PG8_MMA(0, 1, At, B1); PG8_BAR; PG8_SCHED;
            PG8_AOFF(last, 0, q0, q1); PG8_LDA(At, 0, 1); PG8_STAGE_B(PG8_SB(0, 0), b2); PG8_STAGE_B(PG8_SB(0, 1), b2 + hstepB); PG8_STAGE_A(PG8_SA(0, 0), a2);
            PG8_WAIT_V8F(t == 0); PG8_WAIT_L(0); PG8_BAR; PG8_MMA(1, 0, At, B0); PG8_MMA(1, 1, At, B1); PG8_BAR; PG8_SCHED;
            PG8_AOFF(last, 1, q0, q1); PG8_LDB(B0, 1, 0); PG8_LDB(B1, 1, 1); PG8_SCHED; PG8_LDA(At, 1, 0); PG8_STAGE_A(PG8_SA(0, 1), a2);
            PG8_WAIT_V(8); PG8_WAIT_L(0); PG8_BAR; PG8_MMA(0, 0, At, B0); PG8_MMA(0, 1, At, B1); PG8_BAR; PG8_SCHED;
            PG8_AOFF(last, 0, q0, q1); PG8_LDA(At, 1, 1); PG8_STAGE_B(PG8_SB(1, 0), b3); PG8_STAGE_B(PG8_SB(1, 1), b3 + hstepB); PG8_STAGE_A(PG8_SA(1, 0), a3);
            PG8_WAIT_V(8); PG8_WAIT_L(0); PG8_BAR; PG8_MMA(1, 0, At, B0); PG8_MMA(1, 1, At, B1); PG8_BAR; PG8_SCHED;
        }
        if (wr == 0) PG8_BAR;
        { const int le = lane_id_v(); E(acc, cur, wr, wc, le & 15, le >> 4, rowtab, (Epi::TAB || Epi::TOKTAB) ? ui : slotC); }
        if (!has_next) break;
#pragma unroll
        for (int a = 0; a < 2; ++a)
#pragma unroll
            for (int b = 0; b < 2; ++b)
#pragma unroll
                for (int m = 0; m < 4; ++m)
#pragma unroll
                    for (int n = 0; n < 2; ++n) acc[a][b][m][n] = (f32x4){0.f, 0.f, 0.f, 0.f};
        cur = nxt; cB = nB; ++ui;
        if constexpr (Prob::GATHER) { slotC ^= 1024; slotN ^= 1024; }
        else {
            aC = aN;
        }
        if (wr == 1) PG8_BAR;
    }
    PG8_WAIT_V(0);
    PG8_BAR;
#undef PG8_SA
#undef PG8_SB
#undef PG8_STAGE2
#undef PG8_TABLES
#undef PG8_STAGE_A
#undef PG8_STAGE_B
#undef PG8_AOFF
#undef PG8_LDA
#undef PG8_LDB
#undef PG8_MMA
#undef PG8_WAIT_V
#undef PG8_WAIT_V8F
#undef PG8_WAIT_L
#undef PG8_BAR
#undef PG8_SCHED
}
}

struct MkArgs { const void* in[29]; float* out; unsigned char* ws; int ph_lo, ph_hi, li, pad; };
struct Frame {
    LAS unsigned char* lds; volatile LAS unsigned* MISC; unsigned* ctl;
    int tid, lane, wave, vcu, G, wv;
};
__device__ __forceinline__ void relaunder(Frame& F) { F.tid = launder(tid_of(F.wv)); F.lane = F.tid & 63; F.wave = __builtin_amdgcn_readfirstlane(F.tid >> 6); }
enum { P_PREP = 0, PL_WIN = 0, PL_MLA = 1, PL_MIXERS = 2, PL_PREPMIX = 3, PL_WOUT = 4, PL_NORM2 = 5, PL_UP0 = 6, PL_DOWN0 = 7, PL_UP1 = 8, PL_DOWN1 = 9, PL_NORMN = 10, PL_COUNT = 11, P_TOTAL = 1 + 2 * PL_COUNT };
__host__ __device__ constexpr int PH(int l, int k) { return 1 + l * PL_COUNT + k; }

__device__ __forceinline__ bool small_job(int item, const MkArgs& a, TrJob& J, int& local) {
    unsigned char* ws = a.ws;
    const float* w_in = (const float*)a.in[3]; const float* w_out = (const float*)a.in[21]; const float* uq = (const float*)a.in[15]; const float* ukv = (const float*)a.in[17];
    const float* qn = (const float*)a.in[14]; const float* kvn = (const float*)a.in[16]; const float* gu = (const float*)a.in[23]; const float* dn = (const float*)a.in[24];
    int r = item;
    for (int l = 0; l < 2; ++l) {
        if (r < 1104) { J = TrJob{w_in + (size_t)l * D * DIN, (bf16_t*)(ws + WS_WIN) + (size_t)l * DINP * D, (const float*)a.in[2] + l * D, D, DIN, DIN, D, 0, 0}; local = r; return true; } r -= 1104;
        if (r < 512) { J = TrJob{w_out + (size_t)l * D * D, (bf16_t*)(ws + WS_WOUT) + (size_t)l * D * D, nullptr, D, D, D, D, 0, 0}; local = r; return true; } r -= 512;
        if (r < 96) { J = TrJob{uq + (size_t)l * 256 * 768, (bf16_t*)(ws + WS_WUQ) + (size_t)l * 768 * 256, qn + l * 256, 256, 768, 768, 256, 0, 0}; local = r; return true; } r -= 96;
        if (r < 64) { J = TrJob{ukv + (size_t)l * 128 * 1024, (bf16_t*)(ws + WS_WUKV) + (size_t)l * 1024 * 128, kvn + l * 128, 128, 1024, 1024, 128, 0, 0}; local = r; return true; } r -= 64;
    }
    if (r < 1376) { J = TrJob{gu, (bf16_t*)(ws + WS_WGU), (const float*)a.in[22], D, DFF, 2 * DFF, D, 1, 0, 1}; local = r; return true; } r -= 1376;
    if (r < 1376) { J = TrJob{gu + DFF, (bf16_t*)(ws + WS_WGU), (const float*)a.in[22], D, DFF, 2 * DFF, D, 1, 128, 1}; local = r; return true; } r -= 1376;
    if (r < 1376) { J = TrJob{dn, (bf16_t*)(ws + WS_WDN), nullptr, DFF, D, D, DFFP, 0, 0}; local = r; return true; }
    return false;
}
constexpr int N_SMALL_ITEMS = 2 * (1104 + 512 + 96 + 64) + 3 * 1376;
constexpr int N_SMALL_FIRST = 1104;
__device__ __forceinline__ void moe_job_of(int e, int ty, const MkArgs& a, TrJob& J) {
    const float* w1 = (const float*)a.in[26]; const float* w3 = (const float*)a.in[27]; const float* w2 = (const float*)a.in[28];
    if (ty == 0) J = TrJob{w1 + (size_t)e * D * DEX, (bf16_t*)(a.ws + WS_W13 + (size_t)e * 2 * DEX * D), nullptr, D, DEX, DEX, D, 1, 0, 1};
    else if (ty == 1) J = TrJob{w3 + (size_t)e * D * DEX, (bf16_t*)(a.ws + WS_W13 + (size_t)e * 2 * DEX * D), nullptr, D, DEX, DEX, D, 1, 128, 1};
    else J = TrJob{w2 + (size_t)e * DEX * D, (bf16_t*)(a.ws + WS_W2 + (size_t)e * D * DEX), nullptr, DEX, D, D, DEX, 0, 0, 1};
}
constexpr int N_MOE_EARLY = 8 * 1792, N_MOE_LATE = 16 * 1792;
__device__ __forceinline__ void moe_job_early(int item, const MkArgs& a, TrJob& J, int& local) { const int e = item / 1792; local = item - e * 1792; moe_job_of(e, 0, a, J); }
__device__ __forceinline__ void moe_job_late(int item, const MkArgs& a, TrJob& J, int& local) { const int job = item / 1792; local = item - job * 1792; moe_job_of(job >> 1, 1 + (job & 1), a, J); }
__device__ __forceinline__ void zero_rows(Frame& F, bf16_t* p, int rows, int cols, int ld) {
    const int per = cols / 8, n = rows * per;
    for (int i = F.vcu * (NWAVES * 64) + F.tid; i < n; i += F.G * NWAVES * 64) *(u32x4*)(p + (size_t)(i / per) * ld + (i % per) * 8) = (u32x4){0u, 0u, 0u, 0u};
}
template <bool F8, bool IN_BF16>
__device__ __forceinline__ void norm_row(const void* xrow, const u32x2 (&raw)[4], const float* g, bf16_t* orow, int lane, f32x4 (&v)[4]) {
    const f32x4* gr = (const f32x4*)g + lane; float ss = 0.f;
#pragma unroll
    for (int j = 0; j < 4; ++j) {
        if constexpr (IN_BF16) { const u32x2 w = raw[j]; v[j] = (f32x4){__uint_as_float(w.x << 16), __uint_as_float(w.x & 0xffff0000u), __uint_as_float(w.y << 16), __uint_as_float(w.y & 0xffff0000u)}; }
        else v[j] = *((const f32x4*)xrow + lane + 64 * j);
        ss += (v[j].x * v[j].x + v[j].y * v[j].y) + (v[j].z * v[j].z + v[j].w * v[j].w); }
    const float rs = rsqrtf(wave_sum(ss) * (1.0f / D) + EPS);
#pragma unroll
    for (int j = 0; j < 4; ++j) { const f32x4 gg = gr[64 * j]; v[j] = v[j] * rs * gg;
        if constexpr (F8) *(unsigned*)((unsigned char*)orow + 4 * (lane + 64 * j)) = pk4_fp8(v[j].x, v[j].y, v[j].z, v[j].w);
        else { u32x2 w; w.x = pk2(v[j].x, v[j].y); w.y = pk2(v[j].z, v[j].w); *(u32x2*)(orow + 4 * (lane + 64 * j)) = w; } }
}
__device__ __forceinline__ void stream_in_phase(Frame& F, const float* x, bf16_t* xs, float* ss) {
    const int gw = F.vcu * NWAVES + F.wave, NGW = F.G * NWAVES;
    for (int m = gw; m < T; m += NGW) { const f32x4* xr = (const f32x4*)(x + (size_t)m * D) + F.lane; f32x4 v[4]; float s = 0.f;
#pragma unroll
        for (int j = 0; j < 4; ++j) { v[j] = xr[64 * j]; s += (v[j].x * v[j].x + v[j].y * v[j].y) + (v[j].z * v[j].z + v[j].w * v[j].w); }
#pragma unroll
        for (int j = 0; j < 4; ++j) { u32x2 w; w.x = pk2(v[j].x, v[j].y); w.y = pk2(v[j].z, v[j].w); *(u32x2*)(xs + (size_t)m * D + 4 * (F.lane + 64 * j)) = w; }
        s = wave_sum(s);
        if (F.lane < 4) ss[(size_t)m * 4 + F.lane] = F.lane == 0 ? s : 0.f; }
}
constexpr int CW_PAIR = 12288, CW_TK = 20480;
constexpr size_t WS_ROUTE = WS_LIST + 4 * MiB;
__device__ __forceinline__ void norm_router_phase(Frame& F, const bf16_t* x, const float* g, bf16_t* out, const float* router, int* route_e, float* route_w) {
    const int RPB = T / F.G;
    volatile LAS int* lpair = (volatile LAS int*)(F.lds + RING_OFF);
    if (F.tid < 64) lpair[F.tid] = 0;
    __syncthreads();
    const int rpw = RPB / NWAVES;
    u32x2 nraw[4];
    { const u32x2* xr0 = (const u32x2*)(x + (size_t)(F.vcu * RPB + F.wave * rpw) * D) + F.lane;
#pragma unroll
      for (int j = 0; j < 4; ++j) nraw[j] = xr0[64 * j]; }
    for (int k = 0; k < rpw; ++k) {
        const int lr = F.wave * rpw + k, row = F.vcu * RPB + lr; f32x4 v[4]; u32x2 raw[4];
#pragma unroll
        for (int j = 0; j < 4; ++j) raw[j] = nraw[j];
        if (k + 1 < rpw) { const u32x2* xr1 = (const u32x2*)(x + (size_t)(row + 1) * D) + F.lane;
#pragma unroll
          for (int j = 0; j < 4; ++j) nraw[j] = xr1[64 * j]; }
        norm_row<true, true>(nullptr, raw, g, (bf16_t*)((unsigned char*)out + (size_t)row * D), F.lane, v);
        float p[8];
#pragma unroll
        for (int e = 0; e < 8; ++e) p[e] = 0.f;
#pragma unroll
        for (int j = 0; j < 4; ++j) { const f32x4* rr = (const f32x4*)(router + (size_t)(4 * (F.lane + 64 * j)) * 8);
#pragma unroll
            for (int c = 0; c < 4; ++c) { const f32x4 r0 = rr[2 * c], r1 = rr[2 * c + 1]; const float y = v[j][c];
                p[0] += y * r0.x; p[1] += y * r0.y; p[2] += y * r0.z; p[3] += y * r0.w; p[4] += y * r1.x; p[5] += y * r1.y; p[6] += y * r1.z; p[7] += y * r1.w; } }
#pragma unroll
        for (int e = 0; e < 8; ++e) p[e] = wave_sum(p[e]);
        if (F.lane == 0) {
            int i0 = 0; float v0 = p[0];
#pragma unroll
            for (int e = 1; e < 8; ++e) if (p[e] > v0) { v0 = p[e]; i0 = e; }
            int i1 = -1; float v1 = -3.0e38f;
#pragma unroll
            for (int e = 0; e < 8; ++e) if (e != i0 && p[e] > v1) { v1 = p[e]; i1 = e; }
            route_e[row] = i0 | (i1 << 4); route_w[row] = 1.0f / (1.0f + __expf(v1 - v0));
            __hip_atomic_fetch_add((LAS int*)&lpair[i0 * 8 + i1], 1, __ATOMIC_RELAXED, __HIP_MEMORY_SCOPE_WORKGROUP);
        }
    }
    __syncthreads();
    if (F.tid < 64 && lpair[F.tid] > 0) __hip_atomic_fetch_add(F.ctl + CW_PAIR + 64 * F.tid, (unsigned)lpair[F.tid], RLX_AGENT);
    __syncthreads();
}
__device__ __forceinline__ void route_assign_phase(Frame& F, const int* route_e, const float* route_w, int* list, float* wl) {
    const int RPB = T / F.G;
    volatile LAS int* pn = (volatile LAS int*)(F.lds + RING_OFF);
    volatile LAS int* sq = pn + 64; volatile LAS int* lp = pn + 128; volatile LAS int* lb = pn + 192; volatile LAS int* lc = pn + 256; volatile LAS int* lcb = pn + 272;
    if (F.tid < 64) { pn[F.tid] = (int)__hip_atomic_load(F.ctl + CW_PAIR + 64 * F.tid, RLX_AGENT); sq[F.tid] = 0; lp[F.tid] = 0; }
    if (F.tid < 16) lc[F.tid] = 0;
    __syncthreads();
    if (F.tid == 0) {
        int d[8], r[8], R = 0;
        for (int e = 0; e < 8; ++e) { int c = 0; for (int f = 0; f < 8; ++f) c += pn[e * 8 + f]; r[e] = c & 255; d[e] = r[e]; R += r[e]; }
        for (int m = R >> 8; m > 0; --m) { int be = -1, br = -1; for (int e = 0; e < 8; ++e) if (d[e] >= 0 && r[e] > br) { br = r[e]; be = e; } if (be < 0 || br <= 0) break; d[be] = r[be] - 256; r[be] = -1; }
        for (int e = 0; e < 8; ++e) for (int f = 0; f < 8 && d[e] > 0; ++f) if (f != e && d[f] < 0) { int take = d[e]; if (-d[f] < take) take = -d[f]; if (pn[e * 8 + f] < take) take = pn[e * 8 + f]; sq[e * 8 + f] = take; d[e] -= take; d[f] += take; }
    }
    __syncthreads();
    int e0 = 0, e1 = 1, pi = 0, li = 0; float w0 = 0.f;
    if (F.tid < RPB) { const int tok = F.vcu * RPB + F.tid; const int pe = route_e[tok]; e0 = pe & 15; e1 = pe >> 4; w0 = route_w[tok]; pi = e0 * 8 + e1;
        li = __hip_atomic_fetch_add((LAS int*)&lp[pi], 1, __ATOMIC_RELAXED, __HIP_MEMORY_SCOPE_WORKGROUP); }
    __syncthreads();
    if (F.tid < 64) lb[F.tid] = (lp[F.tid] > 0 && sq[F.tid] > 0) ? (int)__hip_atomic_fetch_add(F.ctl + CW_TK + 64 * F.tid, (unsigned)lp[F.tid], RLX_AGENT) : 0x40000000;
    __syncthreads();
    int p0 = 0, p1 = 0;
    if (F.tid < RPB) { if (lb[pi] + li < sq[pi]) { const int t = e0; e0 = e1; e1 = t; w0 = 1.0f - w0; }
        p0 = __hip_atomic_fetch_add((LAS int*)&lc[e0], 1, __ATOMIC_RELAXED, __HIP_MEMORY_SCOPE_WORKGROUP);
        p1 = __hip_atomic_fetch_add((LAS int*)&lc[8 + e1], 1, __ATOMIC_RELAXED, __HIP_MEMORY_SCOPE_WORKGROUP); }
    __syncthreads();
    if (F.tid < 16) lcb[F.tid] = (int)__hip_atomic_fetch_add(F.ctl + CW_CNT + 64 * F.tid, (unsigned)lc[F.tid], RLX_AGENT);
    __syncthreads();
    if (F.tid < RPB) { const int tok = F.vcu * RPB + F.tid; const size_t a0 = (size_t)e0 * T + lcb[e0] + p0, a1 = (size_t)(8 + e1) * T + lcb[8 + e1] + p1;
        list[a0] = tok; wl[a0] = w0; list[a1] = tok; wl[a1] = 1.0f - w0; }
    __syncthreads();
}
__device__ __forceinline__ void prepmix_token(const bf16_t* pr, const bf16_t* dr, const bf16_t* yc, bf16_t* mx, const float* g_a, const float* g_n, const float* g_c, int lane) {
    { const u32x2 hf = *(const u32x2*)(dr + 4 * lane), hb = *(const u32x2*)(dr + 256 + 4 * lane), ga = *(const u32x2*)(pr + C_GA + 4 * lane);
      float v[4];
      v[0] = (__uint_as_float(hf.x << 16) + __uint_as_float(hb.x << 16)) * gelu_tanh(__uint_as_float(ga.x << 16));
      v[1] = (__uint_as_float(hf.x & 0xffff0000u) + __uint_as_float(hb.x & 0xffff0000u)) * gelu_tanh(__uint_as_float(ga.x & 0xffff0000u));
      v[2] = (__uint_as_float(hf.y << 16) + __uint_as_float(hb.y << 16)) * gelu_tanh(__uint_as_float(ga.y << 16));
      v[3] = (__uint_as_float(hf.y & 0xffff0000u) + __uint_as_float(hb.y & 0xffff0000u)) * gelu_tanh(__uint_as_float(ga.y & 0xffff0000u));
      const float rs = rsqrtf(wave_sum(v[0] * v[0] + v[1] * v[1] + v[2] * v[2] + v[3] * v[3]) * (1.0f / 256.0f) + EPS);
      const f32x4 g = *(const f32x4*)(g_a + 4 * lane);
      u32x2 w; w.x = pk2(v[0] * rs * g.x, v[1] * rs * g.y); w.y = pk2(v[2] * rs * g.z, v[3] * rs * g.w); *(u32x2*)(mx + 4 * lane) = w; }
    { const u32x2 of = *(const u32x2*)(dr + 512 + 4 * lane), ob = *(const u32x2*)(dr + 768 + 4 * lane), hg = *(const u32x2*)(pr + C_HG + 4 * lane);
      float v[4];
      v[0] = __uint_as_float(of.x << 16) + __uint_as_float(ob.x << 16); v[1] = __uint_as_float(of.x & 0xffff0000u) + __uint_as_float(ob.x & 0xffff0000u);
      v[2] = __uint_as_float(of.y << 16) + __uint_as_float(ob.y << 16); v[3] = __uint_as_float(of.y & 0xffff0000u) + __uint_as_float(ob.y & 0xffff0000u);
      float ss = v[0] * v[0] + v[1] * v[1] + v[2] * v[2] + v[3] * v[3];
      ss += xor_shfl<1>(ss); ss += xor_shfl<2>(ss); ss += xor_shfl<4>(ss); ss += xor_shfl<8>(ss);
      const float rs = rsqrtf(ss * (1.0f / 64.0f) + EPS);
      const f32x4 g = *(const f32x4*)(g_n + 4 * (lane & 15));
      u32x2 w; w.x = pk2(v[0] * rs * g.x * siluf_(__uint_as_float(hg.x << 16)), v[1] * rs * g.y * siluf_(__uint_as_float(hg.x & 0xffff0000u)));
      w.y = pk2(v[2] * rs * g.z * siluf_(__uint_as_float(hg.y << 16)), v[3] * rs * g.w * siluf_(__uint_as_float(hg.y & 0xffff0000u)));
      *(u32x2*)(mx + 256 + 4 * lane) = w; }
    { const u32x4 y = *(const u32x4*)yc;
      float v[8] = {__uint_as_float(y.x << 16), __uint_as_float(y.x & 0xffff0000u), __uint_as_float(y.y << 16), __uint_as_float(y.y & 0xffff0000u),
                    __uint_as_float(y.z << 16), __uint_as_float(y.z & 0xffff0000u), __uint_as_float(y.w << 16), __uint_as_float(y.w & 0xffff0000u)};
      float ss = 0.f;
#pragma unroll
      for (int i = 0; i < 8; ++i) ss += v[i] * v[i];
      const float rs = rsqrtf(wave_sum(ss) * (1.0f / 512.0f) + EPS);
      const f32x4 g0 = *(const f32x4*)(g_c + 8 * lane), g1 = *(const f32x4*)(g_c + 8 * lane + 4);
      u32x4 w; w.x = pk2(v[0] * rs * g0.x, v[1] * rs * g0.y); w.y = pk2(v[2] * rs * g0.z, v[3] * rs * g0.w); w.z = pk2(v[4] * rs * g1.x, v[5] * rs * g1.y); w.w = pk2(v[6] * rs * g1.z, v[7] * rs * g1.w);
      *(u32x4*)(mx + 512 + 8 * lane) = w; }
}
__device__ __forceinline__ pg8::MoeMap moe_map_setup(Frame& F, int rank, int& ntiles) {
    volatile LAS int* tp = (volatile LAS int*)(F.MISC + 16);
    __syncthreads();
    if (F.tid < 8) tp[9 + F.tid] = (int)__hip_atomic_load(F.ctl + CW_CNT + 64 * (rank * 8 + F.tid), RLX_AGENT);
    __syncthreads();
    if (F.tid == 0) { int acc = 0; for (int e = 0; e < 8; ++e) { tp[e] = acc; acc += (tp[9 + e] + 255) >> 8; } tp[8] = acc; }
    __syncthreads();
    ntiles = tp[8];
    pg8::MoeMap mm; mm.tp = (const LAS int*)(F.lds + MISC_OFF + 64); return mm;
}

namespace att {
constexpr int DQK = 96, DV = 64, NW = 8, QBLK = 32, KVBLK = 64, LDQ = 96, LDK = 96, LDV = 64;
constexpr float SCALE = 0.10206207261596575f;
constexpr float QSCALE = SCALE * 1.4426950408889634f;
constexpr size_t SHM_V = 16384, SHM_K = 16384, SHM_ATTN = 2 * SHM_V + 2 * SHM_K + NW * 64 * 4;
using s16x4 = __attribute__((ext_vector_type(4))) short;
#define KSWZ(row, colB) ((row) * 256 + ((colB) ^ (((row) & 7) << 4)))
#define SBAR() __builtin_amdgcn_sched_barrier(0)
__device__ __forceinline__ int crow(int r, int hi) { return (r & 3) + 8 * (r >> 2) + 4 * hi; }
__device__ __forceinline__ unsigned cvtpk(float lo, float hi) { unsigned r; asm volatile("v_cvt_pk_bf16_f32 %0, %1, %2" : "=v"(r) : "v"(lo), "v"(hi)); return r; }
template <bool SHIFT> __device__ __forceinline__ void expsum(f32x16& p0, f32x16& p1, float& l_reg, float negM) {
  float ps = 0;
#pragma unroll
  for (int r = 0; r < 16; ++r) { p0[r] = __builtin_amdgcn_exp2f(SHIFT ? p0[r] + negM : p0[r]); ps += p0[r]; }
#pragma unroll
  for (int r = 0; r < 16; ++r) { p1[r] = __builtin_amdgcn_exp2f(SHIFT ? p1[r] + negM : p1[r]); ps += p1[r]; }
  l_reg += ps;
}
__device__ __forceinline__ void packP(const f32x16& p0, const f32x16& p1, bf16x8& pa0, bf16x8& pa1, bf16x8& pa2, bf16x8& pa3) {
#define PK4(P, BASE, OUT) do { unsigned a0 = cvtpk(P[BASE + 0], P[BASE + 1]), a1 = cvtpk(P[BASE + 2], P[BASE + 3]);   \
    unsigned b0 = cvtpk(P[BASE + 4], P[BASE + 5]), b1 = cvtpk(P[BASE + 6], P[BASE + 7]);                              \
    auto r0 = __builtin_amdgcn_permlane32_swap(a0, b0, false, false); auto r1 = __builtin_amdgcn_permlane32_swap(a1, b1, false, false); \
    u32x4 w = {r0[0], r1[0], r0[1], r1[1]}; OUT = *reinterpret_cast<bf16x8*>(&w); } while (0)
  PK4(p0, 0, pa0); PK4(p0, 8, pa1); PK4(p1, 0, pa2); PK4(p1, 8, pa3);
#undef PK4
}
__device__ __forceinline__ void qkt(f32x16& p0, f32x16& p1, const char* Ks, const bf16x8* qr, int r32, int hi) {
  p0 = f32x16{}; p1 = f32x16{};
#pragma unroll
  for (int d0 = 0; d0 < 6; ++d0) { int cb = (d0 * 16 + hi * 8) * 2;
    bf16x8 b0 = *reinterpret_cast<const bf16x8*>(Ks + KSWZ(r32, cb));
    bf16x8 b1 = *reinterpret_cast<const bf16x8*>(Ks + KSWZ(32 + r32, cb));
    p0 = __builtin_amdgcn_mfma_f32_32x32x16_bf16(b0, qr[d0], p0, 0, 0, 0);
    p1 = __builtin_amdgcn_mfma_f32_32x32x16_bf16(b1, qr[d0], p1, 0, 0, 0); }
}
__device__ __forceinline__ int v_st(int k, int c) { const int kk = (k & ~0xC) | ((k & 4) << 1) | ((k & 8) >> 1); return ((kk >> 3) * 4 + (c >> 5)) * 512 + ((kk & 7) * 32 + (c & 31)) * 2; }
__device__ __forceinline__ int v_rd_base(int lane) { return ((lane & 3) << 3) | (((lane >> 2) & 3) << 6) | (((lane >> 4) & 1) << 5) | (((lane >> 5) & 1) << 8); }
constexpr int v_rd_off(int d0, int ks, int half) { return d0 * 512 + ks * 4096 + half * 2048; }
template <int OFF> __device__ __forceinline__ s16x4 tr_read(int vb) {
  s16x4 r; asm volatile("ds_read_b64_tr_b16 %0, %1 offset:%2" : "=&v"(r) : "v"(vb), "i"(OFF) : "memory"); return r;
}
template <int D0> __device__ __forceinline__ void pv_one(f32x16& od, int vb, bf16x8 pa0, bf16x8 pa1, bf16x8 pa2, bf16x8 pa3) {
  const s16x4 l0 = tr_read<v_rd_off(D0, 0, 0)>(vb), h0 = tr_read<v_rd_off(D0, 0, 1)>(vb), l1 = tr_read<v_rd_off(D0, 1, 0)>(vb), h1 = tr_read<v_rd_off(D0, 1, 1)>(vb);
  const s16x4 l2 = tr_read<v_rd_off(D0, 2, 0)>(vb), h2 = tr_read<v_rd_off(D0, 2, 1)>(vb), l3 = tr_read<v_rd_off(D0, 3, 0)>(vb), h3 = tr_read<v_rd_off(D0, 3, 1)>(vb);
  asm volatile("s_waitcnt lgkmcnt(0)" ::: "memory"); SBAR();
#define PK(L, H) (bf16x8){L[0], L[1], L[2], L[3], H[0], H[1], H[2], H[3]}
  od = __builtin_amdgcn_mfma_f32_32x32x16_bf16(pa0, PK(l0, h0), od, 0, 0, 0);
  od = __builtin_amdgcn_mfma_f32_32x32x16_bf16(pa1, PK(l1, h1), od, 0, 0, 0);
  od = __builtin_amdgcn_mfma_f32_32x32x16_bf16(pa2, PK(l2, h2), od, 0, 0, 0);
  od = __builtin_amdgcn_mfma_f32_32x32x16_bf16(pa3, PK(l3, h3), od, 0, 0, 0);
#undef PK
}
__device__ __forceinline__ void pv_d0(f32x16* o, int vb, bf16x8 pa0, bf16x8 pa1, bf16x8 pa2, bf16x8 pa3) {
  pv_one<0>(o[0], vb, pa0, pa1, pa2, pa3); pv_one<1>(o[1], vb, pa0, pa1, pa2, pa3);
}
__device__ __forceinline__ unsigned cvtpk_s(float lo, float hi) { unsigned r; asm("v_cvt_pk_bf16_f32 %0, %1, %2" : "=v"(r) : "v"(lo), "v"(hi)); return r; }
template <bool SHIFT> __device__ __forceinline__ void exp_chunk(f32x16& p, int lo, int hi, float& ps, float negM) {
#pragma unroll
  for (int r = 0; r < 16; ++r) if (r >= lo && r < hi) { p[r] = __builtin_amdgcn_exp2f(SHIFT ? p[r] + negM : p[r]); ps += p[r]; }
}
__device__ __forceinline__ bf16x8 pack8(const f32x16& P, int base) {
  const unsigned a0 = cvtpk_s(P[base + 0], P[base + 1]), a1 = cvtpk_s(P[base + 2], P[base + 3]), b0 = cvtpk_s(P[base + 4], P[base + 5]), b1 = cvtpk_s(P[base + 6], P[base + 7]);
  auto r0 = __builtin_amdgcn_permlane32_swap(a0, b0, false, false); auto r1 = __builtin_amdgcn_permlane32_swap(a1, b1, false, false);
  u32x4 w = {r0[0], r1[0], r0[1], r1[1]}; return *reinterpret_cast<bf16x8*>(&w);
}
template <bool SHIFT, bool QK, bool PV> __device__ __forceinline__ void pipe_iter(f32x16 (&sn)[2], f32x16 (&sc)[2], const bf16x8 (&pp)[4], bf16x8 (&pn)[4], f32x16* o, const char* Kn, int vbp,
                                                                                   const bf16x8* qr, int r32, int hi, float& l_reg, float negM) {
  float ps = 0.f;
  if constexpr (QK) {
    sn[0] = f32x16{}; sn[1] = f32x16{};
#pragma unroll
    for (int d0 = 0; d0 < 6; ++d0) { const int cb = (d0 * 16 + hi * 8) * 2;
      const bf16x8 kb0 = *reinterpret_cast<const bf16x8*>(Kn + KSWZ(r32, cb)), kb1 = *reinterpret_cast<const bf16x8*>(Kn + KSWZ(32 + r32, cb));
      sn[0] = __builtin_amdgcn_mfma_f32_32x32x16_bf16(kb0, qr[d0], sn[0], 0, 0, 0);
      sn[1] = __builtin_amdgcn_mfma_f32_32x32x16_bf16(kb1, qr[d0], sn[1], 0, 0, 0);
      if (d0 < 3) exp_chunk<SHIFT>(sc[0], d0 == 0 ? 0 : (d0 == 1 ? 6 : 11), d0 == 0 ? 6 : (d0 == 1 ? 11 : 16), ps, negM);
      else        exp_chunk<SHIFT>(sc[1], d0 == 3 ? 0 : (d0 == 4 ? 6 : 11), d0 == 3 ? 6 : (d0 == 4 ? 11 : 16), ps, negM);
      SBAR();
    }
  } else { exp_chunk<SHIFT>(sc[0], 0, 16, ps, negM); exp_chunk<SHIFT>(sc[1], 0, 16, ps, negM); }
  l_reg += ps;
  if constexpr (PV) {
#define PK(L, H) (bf16x8){L[0], L[1], L[2], L[3], H[0], H[1], H[2], H[3]}
    { const s16x4 l0 = tr_read<v_rd_off(0, 0, 0)>(vbp), h0 = tr_read<v_rd_off(0, 0, 1)>(vbp), l1 = tr_read<v_rd_off(0, 1, 0)>(vbp), h1 = tr_read<v_rd_off(0, 1, 1)>(vbp);
      const s16x4 l2 = tr_read<v_rd_off(0, 2, 0)>(vbp), h2 = tr_read<v_rd_off(0, 2, 1)>(vbp), l3 = tr_read<v_rd_off(0, 3, 0)>(vbp), h3 = tr_read<v_rd_off(0, 3, 1)>(vbp);
      asm volatile("s_waitcnt lgkmcnt(0)" ::: "memory"); SBAR();
      o[0] = __builtin_amdgcn_mfma_f32_32x32x16_bf16(pp[0], PK(l0, h0), o[0], 0, 0, 0);
      o[0] = __builtin_amdgcn_mfma_f32_32x32x16_bf16(pp[1], PK(l1, h1), o[0], 0, 0, 0);
      pn[0] = pack8(sc[0], 0); SBAR();
      o[0] = __builtin_amdgcn_mfma_f32_32x32x16_bf16(pp[2], PK(l2, h2), o[0], 0, 0, 0);
      o[0] = __builtin_amdgcn_mfma_f32_32x32x16_bf16(pp[3], PK(l3, h3), o[0], 0, 0, 0);
      pn[1] = pack8(sc[0], 8); SBAR(); }
    { const s16x4 l0 = tr_read<v_rd_off(1, 0, 0)>(vbp), h0 = tr_read<v_rd_off(1, 0, 1)>(vbp), l1 = tr_read<v_rd_off(1, 1, 0)>(vbp), h1 = tr_read<v_rd_off(1, 1, 1)>(vbp);
      const s16x4 l2 = tr_read<v_rd_off(1, 2, 0)>(vbp), h2 = tr_read<v_rd_off(1, 2, 1)>(vbp), l3 = tr_read<v_rd_off(1, 3, 0)>(vbp), h3 = tr_read<v_rd_off(1, 3, 1)>(vbp);
      asm volatile("s_waitcnt lgkmcnt(0)" ::: "memory"); SBAR();
      o[1] = __builtin_amdgcn_mfma_f32_32x32x16_bf16(pp[0], PK(l0, h0), o[1], 0, 0, 0);
      o[1] = __builtin_amdgcn_mfma_f32_32x32x16_bf16(pp[1], PK(l1, h1), o[1], 0, 0, 0);
      pn[2] = pack8(sc[1], 0); SBAR();
      o[1] = __builtin_amdgcn_mfma_f32_32x32x16_bf16(pp[2], PK(l2, h2), o[1], 0, 0, 0);
      o[1] = __builtin_amdgcn_mfma_f32_32x32x16_bf16(pp[3], PK(l3, h3), o[1], 0, 0, 0);
      pn[3] = pack8(sc[1], 8); SBAR(); }
#undef PK
  } else { pn[0] = pack8(sc[0], 0); pn[1] = pack8(sc[0], 8); pn[2] = pack8(sc[1], 0); pn[3] = pack8(sc[1], 8); }
}
template <bool SHIFT> __device__ __forceinline__ void attn_unit(const bf16_t* __restrict__ Qb, const bf16_t* __restrict__ Kh, const bf16_t* __restrict__ Vh, bf16_t* __restrict__ Ob, int ldo, int seq, float negM, char* lds, int wv) {
  const int tid = launder(tid_of(wv)), wid = tid >> 6, lane = tid & 63, r32 = lane & 31, hi = lane >> 5;
  if (__builtin_amdgcn_readfirstlane(wid) >= 4) __builtin_amdgcn_s_setprio(1);
  char* V_lds = lds; char* K_lds = lds + 2 * SHM_V;
  float* ws = (float*)(lds + 2 * SHM_V + 2 * SHM_K) + wid * 64; float* li_l = ws;
  float l_reg = 0; f32x16 o[2] = {}; bf16x8 qr[6];
  const bf16_t* Qw = Qb + (long)(wid * QBLK + r32) * LDQ + hi * 8;
#pragma unroll
  for (int d0 = 0; d0 < 6; ++d0) qr[d0] = *reinterpret_cast<const bf16x8*>(Qw + d0 * 16);
  const int sr = tid >> 4, sc = (tid & 15) * 8, vst0 = v_st(sr, sc & 63), vst1 = v_st(32 + sr, sc & 63);
  const bool kact = sc < DQK, vact = sc < DV;
  const int vb0 = (int)(uintptr_t)V_lds + v_rd_base(lane);
  const int NT = seq / KVBLK;
  struct { bf16x8 vs0, vs1, ks0, ks1; } sr_[1];
#define SLOAD(i, kt, vt) do { const int _k0 = ((kt) < NT ? (kt) : NT - 1) * KVBLK, _v0 = ((vt) < NT ? (vt) : NT - 1) * KVBLK; \
    if (vact) { sr_[i].vs0 = *reinterpret_cast<const bf16x8*>(&Vh[(long)(_v0 + sr) * LDV + sc]); sr_[i].vs1 = *reinterpret_cast<const bf16x8*>(&Vh[(long)(_v0 + 32 + sr) * LDV + sc]); } \
    if (kact) { sr_[i].ks0 = *reinterpret_cast<const bf16x8*>(&Kh[(long)(_k0 + sr) * LDK + sc]); sr_[i].ks1 = *reinterpret_cast<const bf16x8*>(&Kh[(long)(_k0 + 32 + sr) * LDK + sc]); } } while (0)
#define SWRITE_K(b, i) do { if (kact) { int kc = sc * 2; *(bf16x8*)(K_lds + (b) * SHM_K + KSWZ(sr, kc)) = sr_[i].ks0; *(bf16x8*)(K_lds + (b) * SHM_K + KSWZ(32 + sr, kc)) = sr_[i].ks1; } } while (0)
#define SWRITE_V(b, i) do { if (vact) { *(bf16x8*)(V_lds + (b) * SHM_V + vst0) = sr_[i].vs0; *(bf16x8*)(V_lds + (b) * SHM_V + vst1) = sr_[i].vs1; } } while (0)
#define SWAIT() asm volatile("s_waitcnt vmcnt(0)" ::: "memory")
  f32x16 sA[2], sB[2]; bf16x8 pX[4], pY[4];
  SLOAD(0, 0, 0); asm volatile("s_waitcnt vmcnt(0)" ::: "memory"); SWRITE_K(0, 0); SWRITE_V(0, 0);
  SLOAD(0, 1, 1); asm volatile("s_waitcnt vmcnt(0)" ::: "memory"); SWRITE_K(1, 0);
  __syncthreads();
  { sA[0] = f32x16{}; sA[1] = f32x16{};
#pragma unroll
    for (int d0 = 0; d0 < 6; ++d0) { const int cb = (d0 * 16 + hi * 8) * 2;
      const bf16x8 b0 = *reinterpret_cast<const bf16x8*>(K_lds + KSWZ(r32, cb)), b1 = *reinterpret_cast<const bf16x8*>(K_lds + KSWZ(32 + r32, cb));
      sA[0] = __builtin_amdgcn_mfma_f32_32x32x16_bf16(b0, qr[d0], sA[0], 0, 0, 0); sA[1] = __builtin_amdgcn_mfma_f32_32x32x16_bf16(b1, qr[d0], sA[1], 0, 0, 0); } }
  SLOAD(0, 2, 1); SBAR(); pipe_iter<SHIFT, true, false>(sB, sA, pY, pX, o, K_lds + SHM_K, 0, qr, r32, hi, l_reg, negM); SBAR();
  __syncthreads(); SWAIT(); SWRITE_K(0, 0); SWRITE_V(1, 0); __syncthreads();
  for (int t = 1; t + 1 < NT; t += 2) {
    SLOAD(0, t + 2, t + 1); SBAR(); pipe_iter<SHIFT, true, true>(sA, sB, pX, pY, o, K_lds, vb0, qr, r32, hi, l_reg, negM); SBAR();
    __syncthreads(); SWAIT(); SWRITE_K(1, 0); SWRITE_V(0, 0); __syncthreads();
    SLOAD(0, t + 3, t + 2); SBAR(); pipe_iter<SHIFT, true, true>(sB, sA, pY, pX, o, K_lds + SHM_K, vb0 + (int)SHM_V, qr, r32, hi, l_reg, negM); SBAR();
    __syncthreads(); SWAIT(); SWRITE_K(0, 0); SWRITE_V(1, 0); __syncthreads();
  }
  SBAR(); pipe_iter<SHIFT, false, true>(sA, sB, pX, pY, o, K_lds, vb0, qr, r32, hi, l_reg, negM);
  pv_d0(o, vb0 + (int)SHM_V, pY[0], pY[1], pY[2], pY[3]);
  { auto rr = __builtin_amdgcn_permlane32_swap(__float_as_uint(l_reg), __float_as_uint(l_reg), false, false); l_reg = __uint_as_float(rr[0]) + __uint_as_float(rr[1]); }
  if (hi == 0) li_l[r32] = l_reg; asm volatile("s_waitcnt lgkmcnt(0)" ::: "memory");
  float rli[16];
#pragma unroll
  for (int r = 0; r < 16; ++r) rli[r] = __builtin_amdgcn_rcpf(li_l[crow(r, hi)]);
  bf16_t* Ow = Ob + (long)(wid * QBLK) * ldo;
#pragma unroll
  for (int r = 0; r < 16; ++r) { int orow = crow(r, hi);
#pragma unroll
    for (int d0 = 0; d0 < 2; ++d0) Ow[(long)orow * ldo + d0 * 32 + r32] = (bf16_t)f2bf(o[d0][r] * rli[r]); }
  __builtin_amdgcn_s_setprio(0);
  __syncthreads();
#undef SLOAD
#undef SWRITE_K
#undef SWRITE_V
#undef SWAIT
}
#undef KSWZ
#undef SBAR
}
namespace mla {
__device__ __forceinline__ int crow(int r, int hi) { return (r & 3) + 8 * (r >> 2) + 4 * hi; }
__device__ __forceinline__ float half_swap_sum(float v) { auto rr = __builtin_amdgcn_permlane32_swap(__float_as_uint(v), __float_as_uint(v), false, false); return __uint_as_float(rr[0]) + __uint_as_float(rr[1]); }
__device__ __forceinline__ float sumsq8(bf16x8 v) { float s = 0.f;
#pragma unroll
    for (int j = 0; j < 8; ++j) { const float f = bf2f((bf16_t)v[j]); s += f * f; } return s; }
__device__ __forceinline__ unsigned pk2rne(float lo, float hi) { unsigned r; asm volatile("v_cvt_pk_bf16_f32 %0, %1, %2" : "=v"(r) : "v"(lo), "v"(hi)); return r; }
__device__ __forceinline__ void store_blk(bf16_t* p  , const float (&v)[16]) {
#pragma unroll
    for (int q4 = 0; q4 < 4; ++q4) { u32x2 w; w.x = pk2rne(v[4 * q4], v[4 * q4 + 1]); w.y = pk2rne(v[4 * q4 + 2], v[4 * q4 + 3]); *(u32x2*)(p + 8 * q4) = w; }
}
__device__ __forceinline__ void rope_regs(float (&v)[16], const float (&cs)[8], const float (&sn)[8]) {
#pragma unroll
    for (int r = 0; r < 8; ++r) { const float x1 = v[r], x2 = v[r + 8]; v[r] = x1 * cs[r] - x2 * sn[r]; v[r + 8] = x2 * cs[r] + x1 * sn[r]; }
}
constexpr int QP = 528, KP = 272, L_WQ = 0, L_WKV = 96 * QP, L_END = L_WKV + 128 * KP, L_CS = L_END;
__device__ __forceinline__ void stage_load(int hd, int tid, const bf16_t* Wuq_t, const bf16_t* Wukv_t, u32x4 (&pq)[6], u32x4 (&pk)[4]) {
#pragma unroll
    for (int i = 0; i < 6; ++i) { const int id = tid + 512 * i; pq[i] = *(const u32x4*)(Wuq_t + (size_t)(hd * 96 + (id >> 5)) * 256 + (id & 31) * 8); }
#pragma unroll
    for (int i = 0; i < 4; ++i) { const int id = tid + 512 * i; pk[i] = *(const u32x4*)(Wukv_t + (size_t)(hd * 128 + (id >> 4)) * 128 + (id & 15) * 8); }
}
__device__ __forceinline__ void stage_store(int tid, const u32x4 (&pq)[6], const u32x4 (&pk)[4], char* lds) {
#pragma unroll
    for (int i = 0; i < 6; ++i) { const int id = tid + 512 * i; *(u32x4*)(lds + L_WQ + (id >> 5) * QP + (id & 31) * 16) = pq[i]; }
#pragma unroll
    for (int i = 0; i < 4; ++i) { const int id = tid + 512 * i; *(u32x4*)(lds + L_WKV + (id >> 4) * KP + (id & 15) * 16) = pk[i]; }
}
__device__ __forceinline__ void q_path(int tid, int tok, int r32, int hi, const bf16_t* pr, const bf16_t* Wuq_t, const bf16_t* Wukv_t, const float* gq, bf16_t* Qo, char* lds) {
    bf16x8 xt[16]; float ss = 0.f;
#pragma unroll
    for (int s = 0; s < 16; ++s) { xt[s] = *(const bf16x8*)(pr + C_CQ + 16 * s + 8 * hi); ss += sumsq8(xt[s]); }
    const float rs_in = rsqrtf(half_swap_sum(ss) * (1.0f / 256.0f) + EPS);
    u32x4 pq[6], pk[4]; stage_load(0, tid, Wuq_t, Wukv_t, pq, pk);
#pragma unroll 1
    for (int hd = 0; hd < 8; ++hd) {
        lds_barrier(); stage_store(tid, pq, pk, lds); lds_barrier(); if (hd < 7) stage_load(hd + 1, tid, Wuq_t, Wukv_t, pq, pk);
        f32x16 acc[3];
#pragma unroll
        for (int cb = 0; cb < 3; ++cb) { acc[cb] = f32x16{};
            const char* wrow = lds + L_WQ + (cb * 32 + r32) * QP + 16 * hi;
#pragma unroll
            for (int s = 0; s < 16; ++s) { const bf16x8 wf = *(const bf16x8*)(wrow + 32 * s); acc[cb] = __builtin_amdgcn_mfma_f32_32x32x16_bf16(wf, xt[s], acc[cb], 0, 0, 0); } }
        float ss2 = 0.f;
#pragma unroll
        for (int cb = 0; cb < 3; ++cb)
#pragma unroll
            for (int r = 0; r < 16; ++r) { acc[cb][r] *= rs_in; ss2 += acc[cb][r] * acc[cb][r]; }
        const float r2 = rsqrtf(half_swap_sum(ss2) * (1.0f / 96.0f) + EPS) * att::QSCALE;
        bf16_t* qrow = Qo + ((size_t)((tok >> 11) * 8 + hd) * SEQ + (tok & (SEQ - 1))) * 96 + 4 * hi;
#pragma unroll
        for (int cb = 0; cb < 3; ++cb) { float v[16];
#pragma unroll
            for (int q4 = 0; q4 < 4; ++q4) { const f32x4 g = *(const f32x4*)(gq + cb * 32 + 8 * q4 + 4 * hi);
                v[4 * q4] = acc[cb][4 * q4] * r2 * g.x; v[4 * q4 + 1] = acc[cb][4 * q4 + 1] * r2 * g.y; v[4 * q4 + 2] = acc[cb][4 * q4 + 2] * r2 * g.z; v[4 * q4 + 3] = acc[cb][4 * q4 + 3] * r2 * g.w; }
            if (cb == 2) { float cs[8], sn[8]; { const f32x4* cp = (const f32x4*)(lds + L_CS + tid * 64); const f32x4 c0 = cp[0], c1 = cp[1], s0 = cp[2], s1 = cp[3];
                cs[0] = c0.x; cs[1] = c0.y; cs[2] = c0.z; cs[3] = c0.w; cs[4] = c1.x; cs[5] = c1.y; cs[6] = c1.z; cs[7] = c1.w; sn[0] = s0.x; sn[1] = s0.y; sn[2] = s0.z; sn[3] = s0.w; sn[4] = s1.x; sn[5] = s1.y; sn[6] = s1.z; sn[7] = s1.w; }
                rope_regs(v, cs, sn); }
            store_blk(qrow + cb * 32, v); }
    }
}
__device__ __forceinline__ void kv_path(int tid, int tok, int r32, int hi, const bf16_t* pr, const bf16_t* Wuq_t, const bf16_t* Wukv_t, const float* gk, bf16_t* Ko, bf16_t* Vo, char* lds) {
    bf16x8 xt[8]; float ss = 0.f;
#pragma unroll
    for (int s = 0; s < 8; ++s) { xt[s] = *(const bf16x8*)(pr + C_CKV + 16 * s + 8 * hi); ss += sumsq8(xt[s]); }
    const float rs_in = rsqrtf(half_swap_sum(ss) * (1.0f / 128.0f) + EPS);
    float kr[16], sskr = 0.f;
#pragma unroll
    for (int q4 = 0; q4 < 4; ++q4) { const u32x2 w = *(const u32x2*)(pr + C_KR + 8 * q4 + 4 * hi);
        kr[4 * q4] = __uint_as_float(w.x << 16); kr[4 * q4 + 1] = __uint_as_float(w.x & 0xffff0000u); kr[4 * q4 + 2] = __uint_as_float(w.y << 16); kr[4 * q4 + 3] = __uint_as_float(w.y & 0xffff0000u); }
#pragma unroll
    for (int r = 0; r < 16; ++r) sskr += kr[r] * kr[r];
    u32x4 pq[6], pk[4]; stage_load(0, tid, Wuq_t, Wukv_t, pq, pk);
#pragma unroll 1
    for (int hd = 0; hd < 8; ++hd) {
        lds_barrier(); stage_store(tid, pq, pk, lds); lds_barrier(); if (hd < 7) stage_load(hd + 1, tid, Wuq_t, Wukv_t, pq, pk);
        f32x16 acc[4];
#pragma unroll
        for (int cb = 0; cb < 4; ++cb) { acc[cb] = f32x16{};
            const char* wrow = lds + L_WKV + (cb * 32 + r32) * KP + 16 * hi;
#pragma unroll
            for (int s = 0; s < 8; ++s) { const bf16x8 wf = *(const bf16x8*)(wrow + 32 * s); acc[cb] = __builtin_amdgcn_mfma_f32_32x32x16_bf16(wf, xt[s], acc[cb], 0, 0, 0); } }
        float ssk = sskr;
#pragma unroll
        for (int cb = 0; cb < 4; ++cb)
#pragma unroll
            for (int r = 0; r < 16; ++r) { acc[cb][r] *= rs_in; if (cb < 2) ssk += acc[cb][r] * acc[cb][r]; }
        const float rk = rsqrtf(half_swap_sum(ssk) * (1.0f / 96.0f) + EPS);
        bf16_t* krow = Ko + ((size_t)((tok >> 11) * 8 + hd) * SEQ + (tok & (SEQ - 1))) * 96 + 4 * hi; bf16_t* vrow = Vo + ((size_t)((tok >> 11) * 8 + hd) * SEQ + (tok & (SEQ - 1))) * 64 + 4 * hi;
#pragma unroll
        for (int cb = 0; cb < 3; ++cb) { float v[16];
#pragma unroll
            for (int q4 = 0; q4 < 4; ++q4) { const f32x4 g = *(const f32x4*)(gk + cb * 32 + 8 * q4 + 4 * hi);
#pragma unroll
                for (int c = 0; c < 4; ++c) { const float x = (cb < 2) ? acc[cb < 2 ? cb : 0][4 * q4 + c] : kr[4 * q4 + c]; v[4 * q4 + c] = x * rk * g[c]; } }
            if (cb == 2) { float cs[8], sn[8]; { const f32x4* cp = (const f32x4*)(lds + L_CS + tid * 64); const f32x4 c0 = cp[0], c1 = cp[1], s0 = cp[2], s1 = cp[3];
                cs[0] = c0.x; cs[1] = c0.y; cs[2] = c0.z; cs[3] = c0.w; cs[4] = c1.x; cs[5] = c1.y; cs[6] = c1.z; cs[7] = c1.w; sn[0] = s0.x; sn[1] = s0.y; sn[2] = s0.z; sn[3] = s0.w; sn[4] = s1.x; sn[5] = s1.y; sn[6] = s1.z; sn[7] = s1.w; }
                rope_regs(v, cs, sn); }
            store_blk(krow + cb * 32, v); }
#pragma unroll
        for (int cb = 2; cb < 4; ++cb) { float v[16];
#pragma unroll
            for (int r = 0; r < 16; ++r) v[r] = acc[cb][r];
            store_blk(vrow + (cb - 2) * 32, v); }
    }
}
__device__ __forceinline__ void block_item(int blk, const bf16_t* PROJ, const int* positions, const bf16_t* Wuq_t, const bf16_t* Wukv_t, const float* gq, const float* gk, bf16_t* Qo, bf16_t* Ko, bf16_t* Vo, char* lds, int wv) {
    const int tid = launder(tid_of(wv)), wave = tid >> 6, lane = tid & 63, r32 = lane & 31, hi = lane >> 5;
    const int tile = blk * 4 + (wave & 3), tok = tile * 32 + r32;
    const bf16_t* pr = PROJ + (size_t)tok * DINP;
    { float cs[8], sn[8]; const int pos = positions[tok];
#pragma unroll
      for (int r = 0; r < 8; ++r) rope_cs(pos, crow(r, hi), cs[r], sn[r]);
      f32x4* cp = (f32x4*)(lds + L_CS + tid * 64);
      cp[0] = (f32x4){cs[0], cs[1], cs[2], cs[3]}; cp[1] = (f32x4){cs[4], cs[5], cs[6], cs[7]}; cp[2] = (f32x4){sn[0], sn[1], sn[2], sn[3]}; cp[3] = (f32x4){sn[4], sn[5], sn[6], sn[7]}; }
    if (wave < 4) q_path(tid, tok, r32, hi, pr, Wuq_t, Wukv_t, gq, Qo, lds);
    else kv_path(tid, tok, r32, hi, pr, Wuq_t, Wukv_t, gk, Ko, Vo, lds);
    __syncthreads();
}
}
namespace lru {
constexpr int XA_PITCH = 144, XA_BYTES = 5120;
constexpr int LDS_XA = 0, LDS_CW = 8 * XA_BYTES, LDS_TS = LDS_CW + 5 * 64 * 4, LDS_END = LDS_TS + 2 * 8 * 2 * 64 * 4;
__device__ __forceinline__ int crow(int r, int hi) { return (r & 3) + 8 * (r >> 2) + 4 * hi; }
__device__ __forceinline__ float bcast_half(float v, int src_lane) { return lane_bcast(v, src_lane); }
__device__ __forceinline__ void unit(int un, int l, const bf16_t* PROJ, const float* conv_w, const float* conv_b, const float* lru_wa, const float* lru_ba, const float* lru_wx, const float* lru_bx,
                                     const float* lru_lam, bf16_t* DIRS, char* lds, int wv) {
    const int tid = launder(tid_of(wv)), wave = tid >> 6, lane = tid & 63, r32 = lane & 31, hi = lane >> 5;
    const int dir = un & 1, n = (un >> 1) & 3, b = un >> 3;
    char* xa = lds + LDS_XA + wave * XA_BYTES; float* CW = (float*)(lds + LDS_CW); float* TS = (float*)(lds + LDS_TS);
    __syncthreads();
    if (tid < 320) { const int k = tid >> 6, c = tid & 63; CW[k * 64 + c] = (k < 4) ? conv_w[(l * 4 + k) * 256 + n * 64 + c] : conv_b[l * 256 + n * 64 + c]; }
    bf16x8 wf[2][2][4];
    { const size_t wbase = (size_t)((l * 2 + dir) * 4 + n) * 4096;
#pragma unroll
      for (int g = 0; g < 2; ++g) { const float* W = (g == 0 ? lru_wa : lru_wx) + wbase;
#pragma unroll
        for (int ob = 0; ob < 2; ++ob)
#pragma unroll
          for (int s4 = 0; s4 < 4; ++s4) { u32x4 pk;
#pragma unroll
            for (int jj = 0; jj < 4; ++jj) { const int c0 = 16 * s4 + 8 * hi + 2 * jj; pk[jj] = pk2(W[(size_t)c0 * 64 + 32 * ob + r32], W[(size_t)(c0 + 1) * 64 + 32 * ob + r32]); }
            wf[g][ob][s4] = *reinterpret_cast<bf16x8*>(&pk); } } }
    float ba[2], bx[2], sp8[2], RC[2];
#pragma unroll
    for (int ob = 0; ob < 2; ++ob) { const int ch = (l * 2 + dir) * 256 + n * 64 + 32 * ob + r32; ba[ob] = lru_ba[ch]; bx[ob] = lru_bx[ch]; sp8[ob] = -8.0f * log1pf(__expf(-lru_lam[ch])); RC[ob] = 0.f; }
    __syncthreads();
    const size_t rowb = (size_t)b * SEQ;
    for (int rho = 0; rho < 8; ++rho) {
        const int s0 = rho * 256 + wave * 32;
        const int tmin = dir ? (SEQ - 1 - s0 - 31) : s0;
#pragma unroll
        for (int i = 0; i < 5; ++i) { const int cidx = lane + 64 * i; if (cidx < 280) { const int j = cidx >> 3, ck = cidx & 7, t = tmin - 2 + j;
            u32x4 v = (u32x4){0u, 0u, 0u, 0u}; if (t >= 0 && t < SEQ) v = *(const u32x4*)(PROJ + (rowb + t) * DINP + C_XA + n * 64 + ck * 8);
            *(u32x4*)(xa + j * XA_PITCH + ck * 16) = v; } }
        asm volatile("s_waitcnt vmcnt(0) lgkmcnt(0)" ::: "memory");
        bf16x8 xcA[4];
        { const int jb = dir ? 31 - r32 : r32;
#pragma unroll
          for (int s4 = 0; s4 < 4; ++s4) { const int c0 = 16 * s4 + 8 * hi; float acc8[8];
            { const f32x4 b0 = *(const f32x4*)(CW + 4 * 64 + c0), b1 = *(const f32x4*)(CW + 4 * 64 + c0 + 4); acc8[0] = b0.x; acc8[1] = b0.y; acc8[2] = b0.z; acc8[3] = b0.w; acc8[4] = b1.x; acc8[5] = b1.y; acc8[6] = b1.z; acc8[7] = b1.w; }
#pragma unroll
            for (int k = 0; k < 4; ++k) { const u32x4 xv = *(const u32x4*)(xa + (jb + k) * XA_PITCH + c0 * 2);
                const f32x4 w0 = *(const f32x4*)(CW + k * 64 + c0), w1 = *(const f32x4*)(CW + k * 64 + c0 + 4);
                acc8[0] += w0.x * __uint_as_float(xv.x << 16); acc8[1] += w0.y * __uint_as_float(xv.x & 0xffff0000u); acc8[2] += w0.z * __uint_as_float(xv.y << 16); acc8[3] += w0.w * __uint_as_float(xv.y & 0xffff0000u);
                acc8[4] += w1.x * __uint_as_float(xv.z << 16); acc8[5] += w1.y * __uint_as_float(xv.z & 0xffff0000u); acc8[6] += w1.z * __uint_as_float(xv.w << 16); acc8[7] += w1.w * __uint_as_float(xv.w & 0xffff0000u); }
            u32x4 pk; pk.x = pk2(acc8[0], acc8[1]); pk.y = pk2(acc8[2], acc8[3]); pk.z = pk2(acc8[4], acc8[5]); pk.w = pk2(acc8[6], acc8[7]);
            xcA[s4] = *reinterpret_cast<bf16x8*>(&pk); } }
        float P[2][16], Q[2][16];
        float Atile[2], Utile[2];
#pragma unroll
        for (int ob = 0; ob < 2; ++ob) {
            f32x16 ga = f32x16{}, gx = f32x16{};
#pragma unroll
            for (int s4 = 0; s4 < 4; ++s4) { ga = __builtin_amdgcn_mfma_f32_32x32x16_bf16(xcA[s4], wf[0][ob][s4], ga, 0, 0, 0); gx = __builtin_amdgcn_mfma_f32_32x32x16_bf16(xcA[s4], wf[1][ob][s4], gx, 0, 0, 0); }
            const int ch = 32 * ob + r32;
            const float cw0 = CW[ch], cw1 = CW[64 + ch], cw2 = CW[128 + ch], cw3 = CW[192 + ch], cbias = CW[256 + ch];
            float A4[4], U4[4];
#pragma unroll
            for (int q = 0; q < 4; ++q) {
                const int wb = dir ? 28 - (8 * q + 4 * hi) : (8 * q + 4 * hi);
                float win[7];
#pragma unroll
                for (int i = 0; i < 7; ++i) win[i] = bf2f(*(const bf16_t*)(xa + (wb + i) * XA_PITCH + ch * 2));
                float hrun = 0.f, arun = 1.f;
#pragma unroll
                for (int jj = 0; jj < 4; ++jj) { const int r = 4 * q + jj;
                    float xc;
                    if (dir) xc = cbias + cw0 * win[3 - jj] + cw1 * win[4 - jj] + cw2 * win[5 - jj] + cw3 * win[6 - jj];
                    else     xc = cbias + cw0 * win[jj] + cw1 * win[jj + 1] + cw2 * win[jj + 2] + cw3 * win[jj + 3];
                    const float rg = sigmoidf_(ga[r] + ba[ob]), ig = sigmoidf_(gx[r] + bx[ob]);
                    const float log_a = rg * sp8[ob], a = __expf(log_a), mult = sqrtf(fmaxf(1.0f - a * a, 0.f));
                    const float u = mult * (ig * xc);
                    hrun = a * hrun + u; arun = arun * a;
                    P[ob][r] = arun; Q[ob][r] = hrun; }
                A4[q] = arun; U4[q] = hrun; }
            float c = 0.f, Ac = 1.f, cin[4], Acin[4];
#pragma unroll
            for (int st = 0; st < 8; ++st) { const int q = st >> 1, own = st & 1;
                if (hi == own) { cin[q] = c; Acin[q] = Ac; }
                const float cn = A4[q] * c + U4[q], An = Ac * A4[q];
                c = bcast_half(cn, r32 + 32 * own); Ac = bcast_half(An, r32 + 32 * own); }
#pragma unroll
            for (int r = 0; r < 16; ++r) { const int q = r >> 2; const float pa = P[ob][r]; Q[ob][r] = pa * cin[q] + Q[ob][r]; P[ob][r] = pa * Acin[q]; }
            Atile[ob] = Ac; Utile[ob] = c;
        }
        float* ts = TS + (rho & 1) * (8 * 2 * 64);
        if (hi == 0) {
#pragma unroll
            for (int ob = 0; ob < 2; ++ob) { ts[(wave * 2 + 0) * 64 + 32 * ob + r32] = Atile[ob]; ts[(wave * 2 + 1) * 64 + 32 * ob + r32] = Utile[ob]; } }
        __syncthreads();
        float CIN[2];
#pragma unroll
        for (int ob = 0; ob < 2; ++ob) { float c = RC[ob]; CIN[ob] = c;
#pragma unroll
            for (int w2 = 0; w2 < 8; ++w2) { if (w2 == wave) CIN[ob] = c; c = ts[(w2 * 2 + 0) * 64 + 32 * ob + r32] * c + ts[(w2 * 2 + 1) * 64 + 32 * ob + r32]; }
            RC[ob] = c; }
#pragma unroll
        for (int ob = 0; ob < 2; ++ob)
#pragma unroll
            for (int r = 0; r < 16; ++r) { const int tokidx = crow(r, hi); const int t = dir ? (SEQ - 1 - s0 - tokidx) : (s0 + tokidx);
                DIRS[(rowb + t) * D + dir * 256 + n * 64 + 32 * ob + r32] = (bf16_t)f2bf(P[ob][r] * CIN[ob] + Q[ob][r]); }
    }
    __syncthreads();
}
}
namespace hgrn {
constexpr int QP = 136, TP = 144;
constexpr int L_QT = 0, L_KT = 64 * QP, L_KTT = 2 * 64 * QP, L_VT = L_KTT + 64 * TP, L_SC2 = L_VT + 64 * TP, L_SC2_END = L_SC2 + 1024;
__device__ __forceinline__ int crow(int r, int hi) { return (r & 3) + 8 * (r >> 2) + 4 * hi; }
__device__ __forceinline__ unsigned pkr(float lo, float hi) { unsigned r; asm volatile("v_cvt_pk_bf16_f32 %0, %1, %2" : "=v"(r) : "v"(lo), "v"(hi)); return r; }
__device__ __forceinline__ bf16x8 ld2x8(const char* p) { const u32x2 a = *(const u32x2*)p, b = *(const u32x2*)(p + 16); u32x4 w = {a.x, a.y, b.x, b.y}; return *reinterpret_cast<bf16x8*>(&w); }
__device__ __forceinline__ bf16x8 pack8(const f32x16& x, int s) { u32x4 w; w.x = pkr(x[8 * s], x[8 * s + 1]); w.y = pkr(x[8 * s + 2], x[8 * s + 3]); w.z = pkr(x[8 * s + 4], x[8 * s + 5]); w.w = pkr(x[8 * s + 6], x[8 * s + 7]); return *reinterpret_cast<bf16x8*>(&w); }
constexpr int L_BUF = L_SC2_END;
constexpr int QQP = 272, L_QQ = 2 * L_BUF, L_QQBUF = 64 * QQP;
__device__ __forceinline__ void qq_chunk(int ci, int dir, int colQ, size_t rowb, const bf16_t* PROJ, char* qqbuf, int c, int tg) {
    float q[16];
    { const int s0 = ci * 64 + tg * 16; const int t0 = dir ? SEQ - 1 - s0 : s0; unsigned o = (unsigned)(rowb + t0) * (unsigned)(DINP * 2) + (unsigned)colQ * 2u; const int tstep = dir ? -(DINP * 2) : (DINP * 2);
#pragma unroll
      for (int j = 0; j < 16; ++j) { q[j] = siluf_(bf2f(*(const bf16_t*)((const char*)PROJ + o))) * 0.125f; o += (unsigned)tstep; } }
#pragma unroll
    for (int j4 = 0; j4 < 4; ++j4) *(f32x4*)(qqbuf + c * QQP + (tg * 16 + 4 * j4) * 4) = (f32x4){q[4 * j4], q[4 * j4 + 1], q[4 * j4 + 2], q[4 * j4 + 3]};
}
__device__ __forceinline__ void unit(int un, int l, const bf16_t* PROJ, const float* lb_logits, bf16_t* DIRS, char* lds, int wv) {
    const int tid = launder(tid_of(wv)), wave = tid >> 6, lane = tid & 63, r32 = lane & 31, hi = lane >> 5;
    const int dir = un & 1, head = (un >> 1) & 3, b = un >> 3;
    const size_t rowb = (size_t)b * SEQ;
    __syncthreads();
    if (wave < 4) qq_chunk(0, dir, C_HQ + head * 64 + 16 * wave + (lane & 15), rowb, PROJ, lds + L_QQ, 16 * wave + (lane & 15), lane >> 4);
    __syncthreads();
    if (wave >= 4) {
        const int c = 16 * (wave - 4) + (lane & 15), tg = lane >> 4;
        float lb = 0.f;
        if (l == 1) { const int col = head * 64 + c; lb = 1.0f / (1.0f + __expf(lb_logits[(0 * 2 + dir) * 256 + col] - lb_logits[(1 * 2 + dir) * 256 + col])); }
        const int colF = (dir ? C_HFB : C_HFF) + head * 64 + c, colV = C_HI + head * 64 + c;
        bf16_t zr[16], vr[16];
        const char* pbase = (const char*)PROJ;
        const unsigned offF = (unsigned)colF * 2u, dV = (unsigned)(colV - colF) * 2u; const int tstep = dir ? -(DINP * 2) : (DINP * 2);
#define HG_LOAD(ci) do { const int s0 = (ci) * 64 + tg * 16; const int t0 = dir ? SEQ - 1 - s0 : s0; unsigned o = (unsigned)(rowb + t0) * (unsigned)(DINP * 2) + offF; \
        _Pragma("unroll") for (int j = 0; j < 16; ++j) { zr[j] = *(const bf16_t*)(pbase + o); vr[j] = *(const bf16_t*)(pbase + (o + dV)); o += (unsigned)tstep; } } while (0)
        HG_LOAD(0);
#pragma unroll 1
        for (int ci = 0; ci < 33; ++ci) {
            if (ci < 32) {
                char* buf = lds + (ci & 1) * L_BUF;
                char* QT = buf + L_QT; char* KT = buf + L_KT; char* KTT = buf + L_KTT; char* VT = buf + L_VT; float* SC = (float*)(buf + L_SC2);
                float bl[16], kk[16], qq[16]; unsigned vpk[8];
                { float run = 0.f;
#pragma unroll
                  for (int j = 0; j < 16; ++j) { const float f = lb + (1.0f - lb) * sigmoidf_(bf2f(zr[j])); run += 0.6931471805599453f * __builtin_amdgcn_logf(f); bl[j] = run; kk[j] = 1.0f - f; }
                  { const char* qb = lds + L_QQ + (ci & 1) * L_QQBUF + c * QQP + tg * 64;
#pragma unroll
                    for (int j4 = 0; j4 < 4; ++j4) { const f32x4 v = *(const f32x4*)(qb + 16 * j4); qq[4 * j4] = v.x; qq[4 * j4 + 1] = v.y; qq[4 * j4 + 2] = v.z; qq[4 * j4 + 3] = v.w; } }
#pragma unroll
                  for (int j = 0; j < 8; ++j) vpk[j] = (unsigned)vr[2 * j] | ((unsigned)vr[2 * j + 1] << 16); }
                if (ci + 1 < 32) HG_LOAD(ci + 1);
                const float t0 = lane_bcast(bl[15], lane & 15), t1 = lane_bcast(bl[15], (lane & 15) + 16), t2 = lane_bcast(bl[15], (lane & 15) + 32), t3 = lane_bcast(bl[15], (lane & 15) + 48);
                const float off = (tg > 0 ? t0 : 0.f) + (tg > 1 ? t1 : 0.f) + (tg > 2 ? t2 : 0.f), bref = t0 + t1, blast = (t0 + t1) + (t2 + t3);
                unsigned kpk[8]; float ktp = 0.f;
#pragma unroll
                for (int j = 0; j < 16; ++j) { const float bc = bl[j] + off; const float dq = fminf(fmaxf(bc - bref, -80.f), 80.f);
                    const float e2 = __builtin_amdgcn_exp2f(1.4426950408889634f * dq); const float qt = qq[j] * e2, kt = kk[j] * __builtin_amdgcn_rcpf(e2);
                    const int t = tg * 16 + j; const unsigned qk = pkr(qt, kt); *(bf16_t*)(QT + t * QP + c * 2) = (bf16_t)(qk & 0xffffu); *(bf16_t*)(KT + t * QP + c * 2) = (bf16_t)(qk >> 16);
                    if (j & 1) kpk[j >> 1] = pkr(ktp, kt); else ktp = kt; }
                *(u32x4*)(KTT + c * TP + tg * 32) = (u32x4){kpk[0], kpk[1], kpk[2], kpk[3]}; *(u32x4*)(KTT + c * TP + tg * 32 + 16) = (u32x4){kpk[4], kpk[5], kpk[6], kpk[7]};
                *(u32x4*)(VT + c * TP + tg * 32) = (u32x4){vpk[0], vpk[1], vpk[2], vpk[3]}; *(u32x4*)(VT + c * TP + tg * 32 + 16) = (u32x4){vpk[4], vpk[5], vpk[6], vpk[7]};
                if (tg == 0) { SC[c] = __expf(bref); SC[64 + c] = __expf(blast); SC[128 + c] = __expf(blast - bref); }
            }
            lds_barrier();
        }
#undef HG_LOAD
    } else {
        const int tb = (wave >> 1) & 1, eb = wave & 1;
        f32x16 S0 = f32x16{}, S1 = f32x16{};
#pragma unroll 1
        for (int ci = -1; ci < 32; ++ci) {
            if (ci + 2 < 32) qq_chunk(ci + 2, dir, C_HQ + head * 64 + 16 * wave + (lane & 15), rowb, PROJ, lds + L_QQ + ((ci + 2) & 1) * L_QQBUF, 16 * wave + (lane & 15), lane >> 4);
            if (ci >= 0) {
                const char* buf = lds + (ci & 1) * L_BUF;
                const char* QT = buf + L_QT; const char* KT = buf + L_KT; const char* KTT = buf + L_KTT; const char* VT = buf + L_VT; const float* SC = (const float*)(buf + L_SC2);
                bf16x8 qf[4];
#pragma unroll
                for (int k4 = 0; k4 < 4; ++k4) qf[k4] = ld2x8(QT + (32 * tb + r32) * QP + (16 * k4 + 4 * hi) * 2);
                f32x16 o = f32x16{};
#pragma unroll
                for (int sb = 0; sb < 2; ++sb) { if (sb <= tb) {
                    f32x16 pt = f32x16{};
#pragma unroll
                    for (int k4 = 0; k4 < 4; ++k4) { const bf16x8 kf = ld2x8(KT + (32 * sb + r32) * QP + (16 * k4 + 4 * hi) * 2); pt = __builtin_amdgcn_mfma_f32_32x32x16_bf16(kf, qf[k4], pt, 0, 0, 0); }
                    if (sb == tb) {
#pragma unroll
                        for (int r = 0; r < 16; ++r) pt[r] = (crow(r, hi) <= r32) ? pt[r] : 0.f; }
#pragma unroll
                    for (int s2 = 0; s2 < 2; ++s2) { const bf16x8 vf = ld2x8(VT + (32 * eb + r32) * TP + (32 * sb + 16 * s2 + 4 * hi) * 2); o = __builtin_amdgcn_mfma_f32_32x32x16_bf16(pack8(pt, s2), vf, o, 0, 0, 0); } } }
#pragma unroll
                for (int cb = 0; cb < 2; ++cb) { f32x16 sp;
#pragma unroll
                    for (int r = 0; r < 16; ++r) sp[r] = (cb == 0 ? S0[r] : S1[r]) * SC[32 * cb + crow(r, hi)];
#pragma unroll
                    for (int s2 = 0; s2 < 2; ++s2) o = __builtin_amdgcn_mfma_f32_32x32x16_bf16(qf[2 * cb + s2], pack8(sp, s2), o, 0, 0, 0); }
#pragma unroll
                for (int cb = 0; cb < 2; ++cb) { f32x16 ds = f32x16{};
#pragma unroll
                    for (int ks = 0; ks < 4; ++ks) { const bf16x8 af = *(const bf16x8*)(KTT + (32 * cb + r32) * TP + (16 * ks + 8 * hi) * 2), bfr = *(const bf16x8*)(VT + (32 * eb + r32) * TP + (16 * ks + 8 * hi) * 2);
                        ds = __builtin_amdgcn_mfma_f32_32x32x16_bf16(af, bfr, ds, 0, 0, 0); }
#pragma unroll
                    for (int r = 0; r < 16; ++r) { const int c = 32 * cb + crow(r, hi); const float el = SC[64 + c], en = SC[128 + c];
                        if (cb == 0) S0[r] = el * S0[r] + en * ds[r]; else S1[r] = el * S1[r] + en * ds[r]; } }
#pragma unroll
                for (int r = 0; r < 16; r += 2) { const int s = ci * 64 + 32 * tb + crow(r, hi); const int t = dir ? SEQ - 1 - s : s;
                    const unsigned ob = ((unsigned)(rowb + t) * (unsigned)D + (unsigned)(512 + dir * 256 + head * 64 + 32 * eb + r32)) * 2u; const unsigned pk = pkr(o[r], o[r + 1]);
                    *(bf16_t*)((char*)DIRS + ob) = (bf16_t)(pk & 0xffffu); *(bf16_t*)((char*)DIRS + (dir ? ob - (unsigned)(D * 2) : ob + (unsigned)(D * 2))) = (bf16_t)(pk >> 16); }
            }
            lds_barrier();
        }
    }
}
}
#ifndef DUP_GEMM
#define DUP_GEMM 1
#endif
#ifndef WIN_WGM
#define WIN_WGM 8
#endif
#ifndef DUP_WGM
#define DUP_WGM 4
#endif
#ifndef UP_WGM
#define UP_WGM 4
#endif
#ifndef DUP_WOUT
#define DUP_WOUT 1
#endif
#ifndef DUP_DDOWN
#define DUP_DDOWN 1
#endif
#ifndef DUP_MDOWN
#define DUP_MDOWN 1
#endif
#ifndef DUP_PM
#define DUP_PM 1
#endif
#ifndef DUP_PREP
#define DUP_PREP 1
#endif
#ifndef DUP_HG
#define DUP_HG 1
#endif
#ifndef DUP_LRU
#define DUP_LRU 1
#endif
#ifndef DUP_ATT
#define DUP_ATT 1
#endif
#ifndef DUP_SEQ
#define DUP_SEQ 1
#endif
#ifndef DUP_MLA
#define DUP_MLA 1
#endif
#ifndef DUP_NORM
#define DUP_NORM 1
#endif
#ifndef DUP_CVT
#define DUP_CVT 1
#endif
__global__ void __launch_bounds__(NWAVES * 64, 2) mk_fwd(MkArgs args) {
    extern __shared__ __attribute__((aligned(16))) unsigned char lds_raw[];
    Frame F;
    F.lds = (LAS unsigned char*)lds_raw; F.MISC = (volatile LAS unsigned*)(F.lds + MISC_OFF);
    F.wv = __builtin_amdgcn_readfirstlane((int)threadIdx.x >> 6); relaunder(F);
    F.G = gridDim.x; { const int bx = blockIdx.x; F.vcu = (F.G % 8 == 0) ? (bx % 8) * (F.G / 8) + bx / 8 : bx; }
    unsigned char* ws = args.ws; F.ctl = (unsigned*)(ws + WS_CTL);
    for (int u = F.tid; u < (LDS_BYTES - LDSCTL_OFF) / 4; u += NWAVES * 64) ((LAS unsigned*)(F.lds + LDSCTL_OFF))[u] = 0u;
    __syncthreads();
    XcdBarrier bar = xcd_barrier_post(F.ctl + CW_BAR + args.li * 4096, F.MISC + 8, F.wv);
    const int lo = args.ph_lo, hi = args.ph_hi;
#define IN(k) (lo <= (k) && (k) < hi && (relaunder(F), true))
#ifndef DUP_BAR
#define DUP_BAR 1
#endif
#define END_PHASE(k) do { if ((k) + 1 < hi) { for (int rb = 0; rb < DUP_BAR; ++rb) xcd_barrier(bar); } } while (0)
#define gw (F.vcu * NWAVES + F.wave)
    const int NGW = F.G * NWAVES;
    const float* x = (const float*)args.in[0]; float* out = args.out;
    bf16_t* HB = (bf16_t*)(ws + WS_HB); bf16_t* PROJ = (bf16_t*)(ws + WS_PROJ); bf16_t* DIRS = (bf16_t*)((unsigned char*)out + OUT_DIRS); bf16_t* YC = (bf16_t*)((unsigned char*)out + OUT_YC); bf16_t* XS = (bf16_t*)(ws + WS_XS);
    int* list = (int*)(ws + WS_LIST); float* wl = (float*)(ws + WS_LIST + 2 * MiB);

    if (IN(P_PREP)) {
        float* scr = (float*)(lds_raw + RING_OFF + F.wave * 8448);
#pragma unroll 1
        for (int rep = 0; rep < DUP_PREP; ++rep)
        for (int it = gw; it < N_SMALL_FIRST; it += NGW) { TrJob J; int local; if (small_job(it, args, J, local)) tr_item(J, local, scr, F.lane); }
        for (int l = 0; l < 2; ++l) zero_rows(F, (bf16_t*)(ws + WS_WIN) + (size_t)l * DINP * D + (size_t)DIN * D, DINP - DIN, D, D);
        zero_rows(F, (bf16_t*)(ws + WS_WGU + (size_t)(21 * 256 + 64) * D), 64, D / 2, D / 2);
        zero_rows(F, (bf16_t*)(ws + WS_WGU + (size_t)(21 * 256 + 192) * D), 64, D / 2, D / 2);
        zero_rows(F, (bf16_t*)(ws + WS_WDN) + DFF, D, DFFP - DFF, DFFP);
#pragma unroll 1
        for (int rep = 0; rep < DUP_NORM; ++rep) stream_in_phase(F, x, XS, (float*)(ws + WS_SS) + 8 * T);
        END_PHASE(P_PREP);
    }
    for (int l = 0; l < 2; ++l) {
        if (IN(PH(l, PL_WIN))) {
            pg8::ProbDense pb{XS, (const bf16_t*)(ws + WS_WIN) + (size_t)l * DINP * D, D, D}; pg8::StaticOrder S;
            S.init(T / 256, DINP / 256, F.G, (int)blockIdx.x, WIN_WGM);
            pg8::EpiStoreBf16 E{PROJ, DINP, (const float*)(ws + WS_SS) + (l == 1 ? 4 * T : 8 * T)};
#pragma unroll 1
            for (int rep = 0; rep < DUP_GEMM; ++rep) pg8::gemm_phase(F.lds + RING_OFF, F.lds + ROWTAB_OFF, pb, S, E, F.wv);
            if ((int)blockIdx.x >= 128) {
                relaunder(F);
                const int fw = ((int)blockIdx.x - 128) * NWAVES + F.wave, FW = 128 * NWAVES;
                if (l == 0) { for (int it = N_SMALL_FIRST + fw; it < N_SMALL_ITEMS; it += FW) { TrJob J; int local; if (small_job(it, args, J, local)) tr_item(J, local, nullptr, F.lane); } }
                else { for (int it = fw; it < N_MOE_EARLY; it += FW) { TrJob J; int local; moe_job_early(it, args, J, local); tr_item(J, local, nullptr, F.lane); } }
            }
            END_PHASE(PH(l, PL_WIN));
        }
        if (IN(PH(l, PL_MLA))) {
            const bf16_t* Wuq_t = (const bf16_t*)(ws + WS_WUQ) + (size_t)l * 768 * 256; const bf16_t* Wukv_t = (const bf16_t*)(ws + WS_WUKV) + (size_t)l * 1024 * 128;
#pragma unroll 1
            for (int rep = 0; rep < DUP_MLA; ++rep)
            for (int blk = F.vcu; blk < T / 128; blk += F.G)
                mla::block_item(blk, PROJ, (const int*)args.in[1], Wuq_t, Wukv_t, (const float*)args.in[18] + l * 96, (const float*)args.in[19] + l * 96, (bf16_t*)(ws + WS_Q), (bf16_t*)(ws + WS_K), (bf16_t*)(ws + WS_V), (char*)lds_raw + RING_OFF, F.wv);
            END_PHASE(PH(l, PL_MLA));
        }
        if (IN(PH(l, PL_MIXERS))) {
            const bf16_t* Qg = (const bf16_t*)(ws + WS_Q); const bf16_t* Kg = (const bf16_t*)(ws + WS_K); const bf16_t* Vg = (const bf16_t*)(ws + WS_V);
            unsigned* qctr = F.ctl + CW_QUEUE + 64 * l;
            float negM;
            { const float* gq = (const float*)args.in[18] + l * 96; const float* gk = (const float*)args.in[19] + l * 96; float mq = 0.f, mk = 0.f;
              for (int j = F.lane; j < 96; j += 64) { mq = fmaxf(mq, fabsf(gq[j])); mk = fmaxf(mk, fabsf(gk[j])); }
#pragma unroll
              for (int o2 = 0; o2 < 1; ++o2) { mq = fmaxf(mq, xor_shfl<1>(mq)); mq = fmaxf(mq, xor_shfl<2>(mq)); mq = fmaxf(mq, xor_shfl<4>(mq)); mq = fmaxf(mq, xor_shfl<8>(mq)); mq = fmaxf(mq, xor_shfl<16>(mq)); mq = half_max(mq);
                  mk = fmaxf(mk, xor_shfl<1>(mk)); mk = fmaxf(mk, xor_shfl<2>(mk)); mk = fmaxf(mk, xor_shfl<4>(mk)); mk = fmaxf(mk, xor_shfl<8>(mk)); mk = fmaxf(mk, xor_shfl<16>(mk)); mk = half_max(mk); }
              negM = -9.797958971132712f * mq * mk * 1.4426950408889634f; }
#pragma unroll 1
            for (int rep = 0; rep < DUP_ATT; ++rep) {
            volatile LAS int* qslot = (volatile LAS int*)(F.MISC + 12);
            __syncthreads();
            if (F.tid == 0) qslot[0] = (int)__hip_atomic_fetch_add(qctr, 1u, RLX_AGENT);
            __syncthreads();
            int u = qslot[0];
#pragma unroll 1
            while (u < 1280 * (rep + 1)) {
                int nxt = 0;
                if (F.tid == 0) nxt = (int)__hip_atomic_fetch_add(qctr, 1u, RLX_AGENT);
                const int uu = u - 1280 * rep;
                if (uu < 128) { for (int r2 = 0; r2 < DUP_HG; ++r2) hgrn::unit(uu, l, PROJ, (const float*)args.in[12], DIRS, (char*)lds_raw + RING_OFF, F.wv); }
                else if (uu < 256) { for (int r2 = 0; r2 < DUP_LRU; ++r2) lru::unit(uu - 128, l, PROJ, (const float*)args.in[4], (const float*)args.in[5], (const float*)args.in[6], (const float*)args.in[7], (const float*)args.in[8], (const float*)args.in[9],
                                             (const float*)args.in[10], DIRS, (char*)lds_raw + RING_OFF, F.wv); }
                else { const int unit = uu - 256; const int bh = unit >> 3, qb = unit & 7, b = bh >> 3, h = bh & 7; const size_t row0 = (size_t)b * SEQ;
                    if (negM < -40.f) att::attn_unit<true>(Qg + ((size_t)bh * SEQ + qb * 256) * 96, Kg + (size_t)bh * SEQ * 96, Vg + (size_t)bh * SEQ * 64, YC + ((size_t)bh * SEQ + qb * 256) * 64, 64, SEQ, negM, (char*)lds_raw + RING_OFF, F.wv);
                    else att::attn_unit<false>(Qg + ((size_t)bh * SEQ + qb * 256) * 96, Kg + (size_t)bh * SEQ * 96, Vg + (size_t)bh * SEQ * 64, YC + ((size_t)bh * SEQ + qb * 256) * 64, 64, SEQ, negM, (char*)lds_raw + RING_OFF, F.wv); }
                relaunder(F);
                if (F.tid == 0) qslot[0] = nxt;
                __syncthreads();
                u = qslot[0];
                __syncthreads();
            }
            }
            END_PHASE(PH(l, PL_MIXERS));
        }
        if (IN(PH(l, PL_PREPMIX))) {
            const float* g_a = (const float*)args.in[11] + l * 256; const float* g_n = (const float*)args.in[13] + l * 64; const float* g_c = (const float*)args.in[20] + l * 512;
#pragma unroll 1
            for (int rep = 0; rep < DUP_PM; ++rep)
            for (int m = gw; m < T; m += NGW) prepmix_token(PROJ + (size_t)m * DINP, DIRS + (size_t)m * D, (const bf16_t*)YC + ((size_t)((m >> 11) * 8 + (F.lane >> 3)) * SEQ + (m & (SEQ - 1))) * 64 + (F.lane & 7) * 8, HB + (size_t)m * D, g_a, g_n, g_c, F.lane);
            END_PHASE(PH(l, PL_PREPMIX));
        }
        if (IN(PH(l, PL_WOUT))) {
            pg8::ProbDense pb{HB, (const bf16_t*)(ws + WS_WOUT) + (size_t)l * D * D, D, D}; pg8::StaticOrder S; S.init(T / 256, D / 256, F.G, (int)blockIdx.x);
            if (l == 0) { pg8::EpiResid<false> E{XS, XS, D, (float*)(ws + WS_SS), ws + WS_XS8};
                pg8::gemm_phase(F.lds + RING_OFF, F.lds + ROWTAB_OFF, pb, S, E, F.wv); }
            else { pg8::EpiResid<false> E{XS, XS, D, (float*)nullptr, (unsigned char*)nullptr};
                pg8::gemm_phase(F.lds + RING_OFF, F.lds + ROWTAB_OFF, pb, S, E, F.wv); }
            END_PHASE(PH(l, PL_WOUT));
        }
        if (l == 1 && IN(PH(l, PL_NORM2))) {
            {
                float* scr = (float*)(lds_raw + RING_OFF + 16384 + F.wave * 8448);
                norm_router_phase(F, XS, (const float*)args.in[22] + D, HB, (const float*)args.in[25], (int*)(ws + WS_ROUTE), (float*)(ws + WS_ROUTE + 256 * 1024));
#pragma unroll 1
                for (int rep = 0; rep < DUP_CVT; ++rep)
                for (int it = gw; it < N_MOE_LATE; it += NGW) { TrJob J; int local; moe_job_late(it, args, J, local); tr_item(J, local, scr, F.lane); }
            }
            END_PHASE(PH(l, PL_NORM2));
        }
        if (l == 0) {
            if (IN(PH(0, PL_UP0))) {
                pg8::ProbDense8 pb{(const bf16_t*)(ws + WS_XS8), (const bf16_t*)(ws + WS_WGU), D, D}; pg8::StaticOrder S; S.init(T / 256, NGU / 256, F.G, (int)blockIdx.x, DUP_WGM);
                pg8::EpiSwiglu E{(bf16_t*)(ws + WS_ACT), DFFP, (const float*)(ws + WS_SS), 1.0f / (F8_WSCALE * F8_ASCALE)};
#pragma unroll 1
                for (int rep = 0; rep < DUP_GEMM; ++rep) pg8::gemm_phase(F.lds + RING_OFF, F.lds + ROWTAB_OFF, pb, S, E, F.wv);
                END_PHASE(PH(0, PL_UP0));
            }
            if (IN(PH(0, PL_DOWN0))) {
                pg8::ProbDense pb{(const bf16_t*)(ws + WS_ACT), (const bf16_t*)(ws + WS_WDN), DFFP, DFFP}; pg8::StaticOrder S; S.init(T / 256, D / 256, F.G, (int)blockIdx.x);
                { pg8::EpiResid<false> E{XS, XS, D, (float*)(ws + WS_SS) + 4 * T, (unsigned char*)nullptr};
                pg8::gemm_phase(F.lds + RING_OFF, F.lds + ROWTAB_OFF, pb, S, E, F.wv); }
                END_PHASE(PH(0, PL_DOWN0));
            }
        } else {
            if (IN(PH(1, PL_NORMN))) { route_assign_phase(F, (const int*)(ws + WS_ROUTE), (const float*)(ws + WS_ROUTE + 256 * 1024), list, wl); xcd_barrier(bar); }
#pragma unroll 1
            for (int r = 0; r < 2; ++r) {
                if (IN(PH(1, PL_UP0 + 2 * r))) {
                    int ntiles; pg8::MoeMap mm = moe_map_setup(F, r, ntiles);
                    pg8::ProbMoeUp pb{HB, (const bf16_t*)(ws + WS_W13), D, D, mm, list + (size_t)r * 8 * T, wl + (size_t)r * 8 * T}; pg8::StaticOrder S; S.init(ntiles, 2 * DEX / 256, F.G, (int)blockIdx.x, UP_WGM);
                    pg8::EpiSwigluMoe E{ws + WS_ACTM, DEX, mm};
#pragma unroll 1
                    for (int rep = 0; rep < DUP_GEMM; ++rep) pg8::gemm_phase(F.lds + RING_OFF, F.lds + ROWTAB_OFF, pb, S, E, F.wv);
                    END_PHASE(PH(1, PL_UP0 + 2 * r));
                }
                if (IN(PH(1, PL_DOWN0 + 2 * r))) {
                    int ntiles; pg8::MoeMap mm = moe_map_setup(F, r, ntiles);
                    const int nfull = ntiles < 128 ? ntiles : 128, nleft = ntiles - nfull;
                    { pg8::ProbMoeDown pb{(const bf16_t*)(ws + WS_ACTM), (const bf16_t*)(ws + WS_W2), DEX, DEX, mm}; pg8::StaticOrder S; S.init(nfull, D / 256, F.G, (int)blockIdx.x);
                      if (r == 0) { pg8::EpiScatterMoe<false> E{XS, XS, D, mm, list + (size_t)r * 8 * T, 1.0f / (F8_WSCALE * F8_ASCALE)}; pg8::gemm_phase(F.lds + RING_OFF, F.lds + ROWTAB_OFF, pb, S, E, F.wv); }
                      else { pg8::EpiScatterMoe<true> E{XS, out, D, mm, list + (size_t)r * 8 * T, 1.0f / (F8_WSCALE * F8_ASCALE)}; pg8::gemm_phase(F.lds + RING_OFF, F.lds + ROWTAB_OFF, pb, S, E, F.wv); } }
                    if (nleft > 0) {
                        bf16_t* Pscr = (bf16_t*)(ws + WS_PART);
                        { pg8::ProbMoeDownSlice pb{(const bf16_t*)(ws + WS_ACTM), (const bf16_t*)(ws + WS_W2), DEX, DEX / 7, DEX, nfull, mm}; pg8::StaticOrder S; S.init(nleft, 28, F.G, (int)blockIdx.x);
                          pg8::EpiPartialBf16 E{Pscr, 1.0f / (F8_WSCALE * F8_ASCALE)};
                          pg8::gemm_phase(F.lds + RING_OFF, F.lds + ROWTAB_OFF, pb, S, E, F.wv); }
                        xcd_barrier(bar);
                        relaunder(F);
                        for (int rw = gw; rw < nleft * 4 * 256; rw += NGW) { const int it = rw >> 8, rr = rw & 255, lt = it >> 2, n = it & 3, c4 = F.lane * 4; int e, ltl, cnt; mm.locate(nfull + lt, e, ltl, cnt);
                            const int lr = ltl * 256 + rr;
                            if (lr < cnt) { const int tok = list[(size_t)r * 8 * T + (size_t)e * T + lr]; const size_t oo = (size_t)tok * D + n * 256 + c4; const u32x2 xw = *(const u32x2*)(XS + oo); u32x2 w[7];
                                f32x4 v = (f32x4){__uint_as_float(xw.x << 16), __uint_as_float(xw.x & 0xffff0000u), __uint_as_float(xw.y << 16), __uint_as_float(xw.y & 0xffff0000u)};
#pragma unroll
                                for (int sl = 0; sl < 7; ++sl) w[sl] = *(const u32x2*)(Pscr + (size_t)(lt * 28 + sl * 4 + n) * 65536 + (size_t)rr * 256 + c4);
#pragma unroll
                                for (int sl = 0; sl < 7; ++sl) { v.x += __uint_as_float(w[sl].x << 16); v.y += __uint_as_float(w[sl].x & 0xffff0000u); v.z += __uint_as_float(w[sl].y << 16); v.w += __uint_as_float(w[sl].y & 0xffff0000u); }
                                if (r == 1) *(f32x4*)(out + oo) = v; else { u32x2 z; z.x = pk2(v.x, v.y); z.y = pk2(v.z, v.w); *(u32x2*)(XS + oo) = z; } } } }
                    if (r == 0) END_PHASE(PH(1, PL_DOWN0 + 2 * r));
                }
            }
        }
    }
#undef IN
#undef END_PHASE
#undef gw
}
static int g_grid = 0;
static void launch_mk(hipStream_t st, MkArgs a, int lo, int hi, int li) {
    a.ph_lo = lo; a.ph_hi = hi; a.li = li; a.pad = 0;
    hipLaunchKernelGGL(mk_fwd, dim3(g_grid), dim3(NWAVES * 64), LDS_BYTES, st, a);
    const hipError_t le = hipPeekAtLastError();
    if (le != hipSuccess) fprintf(stderr, "kernel_launch: mk_fwd launch [%d,%d) failed: %s\n", lo, hi, hipGetErrorName(le));
}
extern "C" void kernel_launch(void* const* d_in, const int* in_sizes, int n_in, void* d_out, int out_size, void* d_ws, size_t ws_size, hipStream_t stream) {
    if (n_in != 29 || in_sizes[0] != T * D || out_size != T * D || ws_size < WS_END) { fprintf(stderr, "kernel_launch: unexpected shapes (n_in %d, in0 %d, out %d, ws %zu)\n", n_in, n_in > 0 ? in_sizes[0] : -1, out_size, ws_size); return; }
    if (g_grid == 0) {
        int dev = 0, cus = 0;
        if (hipGetDevice(&dev) != hipSuccess || hipDeviceGetAttribute(&cus, hipDeviceAttributeMultiprocessorCount, dev) != hipSuccess) { fprintf(stderr, "kernel_launch: device query failed\n"); g_grid = -1; return; }
        if (hipFuncSetAttribute((const void*)mk_fwd, hipFuncAttributeMaxDynamicSharedMemorySize, LDS_BYTES) != hipSuccess) { fprintf(stderr, "kernel_launch: hipFuncSetAttribute failed\n"); g_grid = -1; return; }
        int per_cu = 0;
        if (hipOccupancyMaxActiveBlocksPerMultiprocessor(&per_cu, (const void*)mk_fwd, NWAVES * 64, LDS_BYTES) != hipSuccess || per_cu < 1) fprintf(stderr, "kernel_launch: occupancy query reports %d blocks per CU\n", per_cu);
        (void)hipGetLastError();
        g_grid = cus;
        if (g_grid != 256) { fprintf(stderr, "kernel_launch: built for 256 CUs, found %d\n", cus); g_grid = -1; return; }
    }
    if (g_grid < 0) return;
    unsigned char* ws = (unsigned char*)d_ws;
    (void)hipMemsetAsync(ws + WS_CTL, 0, MiB, stream);
    MkArgs a{};
    for (int i = 0; i < 29; ++i) a.in[i] = d_in[i];
    a.out = (float*)d_out; a.ws = ws;
    launch_mk(stream, a, 0, P_TOTAL, 0);
}
```

```cpp
#include <hip/hip_runtime.h>
#include <cstdio>
#include <cstdint>

typedef unsigned short bf16_t;
typedef float f32x4 __attribute__((ext_vector_type(4)));
typedef unsigned u32x4 __attribute__((ext_vector_type(4)));
typedef unsigned u32x2 __attribute__((ext_vector_type(2)));
#define LAS __attribute__((address_space(3)))

constexpr int NB = 16, SEQ = 2048, T = NB * SEQ, D = 1024;
constexpr int DIN = 2208, DINP = 2304;
constexpr int C_XA = 0, C_GA = 256, C_HQ = 512, C_HFF = 768, C_HFB = 1024, C_HI = 1280, C_HG = 1536, C_CQ = 1792, C_CKV = 2048, C_KR = 2176;
constexpr int DFF = 2752, DFFP = 2816, NGU = 5632;
constexpr int DEX = 3584, NE = 8;
constexpr float EPS = 1e-6f;

constexpr size_t MiB = 1u << 20;
constexpr size_t WS_CTL = 0;
constexpr size_t WS_WIN = 1 * MiB;
constexpr size_t WS_WOUT = 10 * MiB;
constexpr size_t WS_WGU = 14 * MiB;
constexpr size_t WS_WDN = 25 * MiB;
constexpr size_t WS_WUQ = 31 * MiB;
constexpr size_t WS_WUKV = 32 * MiB;
constexpr size_t WS_LIST = 33 * MiB;
constexpr size_t WS_HB = 38 * MiB;
constexpr size_t WS_PROJ = 102 * MiB;
constexpr size_t WS_Q = 246 * MiB, WS_K = 294 * MiB;
constexpr size_t WS_XS8 = 294 * MiB;
constexpr size_t WS_V = 342 * MiB;
constexpr size_t WS_XS = 440 * MiB;
constexpr size_t OUT_DIRS = 0, OUT_YC = 64 * MiB;
constexpr size_t WS_SS = 504 * MiB;
constexpr size_t WS_ACT = 102 * MiB;
constexpr size_t WS_W13 = 374 * MiB;
constexpr size_t WS_W2 = 214 * MiB;
constexpr size_t WS_ACTM = 246 * MiB;
constexpr size_t WS_PART = 102 * MiB;
constexpr size_t WS_END = 508 * MiB;
constexpr int CW_CNT = 8192;

__device__ __forceinline__ unsigned pk4_fp8(float a, float b, float c, float d) {
    a = __builtin_amdgcn_fmed3f(a, -448.f, 448.f); b = __builtin_amdgcn_fmed3f(b, -448.f, 448.f); c = __builtin_amdgcn_fmed3f(c, -448.f, 448.f); d = __builtin_amdgcn_fmed3f(d, -448.f, 448.f);
    int pk = __builtin_amdgcn_cvt_pk_fp8_f32(a, b, 0, false); pk = __builtin_amdgcn_cvt_pk_fp8_f32(c, d, pk, true); return (unsigned)pk; }
__device__ __forceinline__ float bf2f(bf16_t b) { return __uint_as_float(((unsigned)b) << 16); }
__device__ __forceinline__ unsigned f2bf(float f) { unsigned u = __float_as_uint(f); return (u + 0x7fffu + ((u >> 16) & 1u)) >> 16; }
__device__ __forceinline__ unsigned pk2(float lo, float hi) { return f2bf(lo) | (f2bf(hi) << 16); }
__device__ __forceinline__ int lane_id_v() { int r; asm volatile("v_mbcnt_lo_u32_b32 %0, -1, 0\n\tv_mbcnt_hi_u32_b32 %0, -1, %0" : "=v"(r)); return r; }
__device__ __forceinline__ int launder_s(int v) { asm volatile("" : "+s"(v)); return v; }
__device__ __forceinline__ int tid_of(int wv) { return launder_s(wv) * 64 + lane_id_v(); }
template <int M> __device__ __forceinline__ float xor_shfl(float v) { static_assert(M > 0 && M < 32, "swizzle range"); return __int_as_float(__builtin_amdgcn_ds_swizzle(__float_as_int(v), (M << 10) | 0x1F)); }
__device__ __forceinline__ float half_sum(float v) { auto rr = __builtin_amdgcn_permlane32_swap(__float_as_uint(v), __float_as_uint(v), false, false); return __uint_as_float(rr[0]) + __uint_as_float(rr[1]); }
__device__ __forceinline__ float half_max(float v) { auto rr = __builtin_amdgcn_permlane32_swap(__float_as_uint(v), __float_as_uint(v), false, false); return fmaxf(__uint_as_float(rr[0]), __uint_as_float(rr[1])); }
__device__ __forceinline__ float lane_bcast(float v, int src_lane) { return __int_as_float(__builtin_amdgcn_ds_bpermute(src_lane << 2, __float_as_int(v))); }
__device__ __forceinline__ void lds_barrier() { asm volatile("s_waitcnt lgkmcnt(0)" ::: "memory"); __builtin_amdgcn_s_barrier(); asm volatile("" ::: "memory"); }
__device__ __forceinline__ float wave_sum(float v) {
    v += xor_shfl<1>(v); v += xor_shfl<2>(v); v += xor_shfl<4>(v); v += xor_shfl<8>(v); v += xor_shfl<16>(v);
    return half_sum(v);
}
__device__ __forceinline__ float sigmoidf_(float x) { return __builtin_amdgcn_rcpf(1.0f + __builtin_amdgcn_exp2f(-1.4426950408889634f * x)); }
__device__ __forceinline__ float siluf_(float x) { return x * __builtin_amdgcn_rcpf(1.0f + __builtin_amdgcn_exp2f(-1.4426950408889634f * x)); }
__device__ __forceinline__ float gelu_tanh(float x) { const float u = 0.7978845608028654f * (x + 0.044715f * x * x * x); const float t = 1.0f - 2.0f * __builtin_amdgcn_rcpf(1.0f + __builtin_amdgcn_exp2f(2.885390081777927f * u)); return 0.5f * x * (1.0f + t); }

__constant__ float c_invfreq[16] = {1.0f, 0.5623413251903491f, 0.31622776601683794f, 0.1778279410038923f, 0.1f, 0.05623413251903491f, 0.031622776601683794f, 0.01778279410038923f,
                                    0.01f, 0.005623413251903491f, 0.0031622776601683794f, 0.001778279410038923f, 0.001f, 0.0005623413251903491f, 0.00031622776601683794f, 0.0001778279410038923f};
__device__ __forceinline__ void rope_cs(int pos, int i, float& c, float& s) {
    const float ang = (float)pos * c_invfreq[i];
    const double rev = (double)ang * 0.15915494309189535; const float fr = (float)(rev - floor(rev));
    s = __builtin_amdgcn_sinf(fr); c = __builtin_amdgcn_cosf(fr);
}

constexpr float F8_WSCALE = 64.f;
constexpr float F8_ASCALE = 8.f;
struct TrJob { const float* src; bf16_t* dst; const float* kscale; int K, N, lds, ldd, mode, radd; };
__device__ __forceinline__ void tr_item(const TrJob& J, int item, float*  , int lane) {
    const int nblk = J.N / 32, kb = item / nblk, nb = item % nblk, k0 = 64 * kb, n0 = 32 * nb, c = lane & 7, r = lane >> 3;
    const float* sp = J.src + (size_t)(k0 + 8 * r) * J.lds + n0 + 4 * c;
    f32x4 v[8];
#pragma unroll
    for (int i = 0; i < 8; ++i) v[i] = *(const f32x4*)(sp + (size_t)i * J.lds);
    if (J.kscale) {
#pragma unroll
        for (int i = 0; i < 8; ++i) v[i] *= J.kscale[k0 + 8 * r + i]; }
#pragma unroll
    for (int j = 0; j < 4; ++j) { const int sn = n0 + 4 * c + j; const int dn = (J.mode & 1) ? ((sn >> 7) * 256 + J.radd + (sn & 127)) : sn;
        if (J.mode & 2) { u32x2 o; o.x = pk4_fp8(v[0][j] * F8_WSCALE, v[1][j] * F8_WSCALE, v[2][j] * F8_WSCALE, v[3][j] * F8_WSCALE); o.y = pk4_fp8(v[4][j] * F8_WSCALE, v[5][j] * F8_WSCALE, v[6][j] * F8_WSCALE, v[7][j] * F8_WSCALE);
            *(u32x2*)((unsigned char*)J.dst + (size_t)dn * J.ldd + k0 + 8 * r) = o; }
        else { u32x4 o; o.x = pk2(v[0][j], v[1][j]); o.y = pk2(v[2][j], v[3][j]); o.z = pk2(v[4][j], v[5][j]); o.w = pk2(v[6][j], v[7][j]);
            *(u32x4*)(J.dst + (size_t)dn * J.ldd + k0 + 8 * r) = o; } }
}
typedef short bf16x8 __attribute__((ext_vector_type(8)));
typedef float f32x16 __attribute__((ext_vector_type(16)));
#define GAS __attribute__((address_space(1)))
typedef GAS unsigned gu32;
#define RLX_AGENT __ATOMIC_RELAXED, __HIP_MEMORY_SCOPE_AGENT

constexpr int NWAVES = 8;
__device__ __forceinline__ int launder(int v) { asm volatile("" : "+v"(v)); return v; }
constexpr int RING_OFF = 0, RING_BYTES = 131072;
constexpr int LDSCTL_OFF = RING_BYTES, MISC_OFF = LDSCTL_OFF + 320;
constexpr int ROWTAB_OFF = RING_BYTES + 1024;
constexpr int LDS_BYTES = 147456;
constexpr int CW_QUEUE = 16384;
constexpr int CW_BAR = 65536;

#define XB_TMO      128
#define XB_XCNT(j)  (256  + 64 * (j))
#define XB_XSUB(j)  (1280 + 64 * (j))
#define XB_XGEN(j)  (2304 + 64 * (j))
#define XB_TOP      3328
#define XB_TOPGEN   3392
#define XCD_BAR_WORDS 3456
#define XB_SPIN_CAP (1u << 18)
__device__ __forceinline__ unsigned xb_ld(unsigned* p)              { return __hip_atomic_load(p, __ATOMIC_RELAXED, __HIP_MEMORY_SCOPE_AGENT); }
__device__ __forceinline__ unsigned xb_add(unsigned* p, unsigned v) { return __hip_atomic_fetch_add(p, v, __ATOMIC_RELAXED, __HIP_MEMORY_SCOPE_AGENT); }
__device__ __forceinline__ unsigned xb_xcc_id() { return (unsigned)__builtin_amdgcn_s_getreg((3 << 11) | 20) & 0xFu; }
#define XB_SPIN(cond, bar) do { unsigned _sp = 0; while (cond) { __builtin_amdgcn_s_sleep(1); \
    if ((++_sp & 255u) == 0u) { if (xb_ld(&(bar)[XB_TMO])) break; if (_sp > XB_SPIN_CAP) { atomicAdd(&(bar)[XB_TMO], 1u); break; } } } } while (0)
struct XcdBarrier { unsigned* bar; unsigned x; volatile LAS unsigned* st; int wv; };
__device__ __forceinline__ XcdBarrier xcd_barrier_post(unsigned* bar, volatile LAS unsigned* st, int wv) {
    XcdBarrier b; b.bar = bar; b.x = xb_xcc_id(); b.st = st; b.wv = wv;
    if (tid_of(wv) == 0) (void)xb_add(&bar[XB_XCNT(b.x)], 1u);
    return b;
}
__device__ __forceinline__ void xcd_barrier_complete(unsigned* bar, unsigned x, unsigned& nloc, unsigned& nx) {
    const unsigned G = gridDim.x * gridDim.y * gridDim.z;
    unsigned sum, cnt, mine, sp = 0u;
    for (;;) {
        sum = 0u; cnt = 0u; mine = 0u;
#pragma unroll
        for (unsigned j = 0; j < 16; ++j) { const unsigned c = xb_ld(&bar[XB_XCNT(j)]); sum += c; cnt += (c > 0u) ? 1u : 0u; mine = (j == x) ? c : mine; }
        if (sum == G) break;
        __builtin_amdgcn_s_sleep(1);
        if ((++sp & 255u) == 0u) { if (xb_ld(&bar[XB_TMO])) break; if (sp > XB_SPIN_CAP) { atomicAdd(&bar[XB_TMO], 1u); break; } }
    }
    nloc = mine > 0u ? mine : 1u; nx = cnt > 0u ? cnt : 1u;
}
__device__ __forceinline__ void xcd_barrier(const XcdBarrier& b) {
    asm volatile("s_waitcnt vmcnt(0)" ::: "memory");
    __syncthreads();
    if (tid_of(b.wv) == 0) {
        unsigned* bar = b.bar;
        __builtin_amdgcn_s_waitcnt(0);
        unsigned nloc = b.st[0], nx = b.st[1];
        if (nloc == 0u) { xcd_barrier_complete(bar, b.x, nloc, nx); b.st[0] = nloc; b.st[1] = nx; }
        const unsigned old = xb_add(&bar[XB_XSUB(b.x)], 1u);
        const unsigned gen = old / nloc;
        if (old + 1u == (gen + 1u) * nloc) {
            __builtin_amdgcn_fence(__ATOMIC_RELEASE, "agent");
            asm volatile("s_waitcnt vmcnt(0)" ::: "memory");
            const unsigned og = xb_add(&bar[XB_TOP], 1u);
            const unsigned tg = og / nx;
            if (og + 1u == (tg + 1u) * nx) xb_add(&bar[XB_TOPGEN], 1u);
            else XB_SPIN(xb_ld(&bar[XB_TOPGEN]) == tg, bar);
            __builtin_amdgcn_fence(__ATOMIC_ACQUIRE, "agent");
            xb_add(&bar[XB_XGEN(b.x)], 1u);
            asm volatile("s_waitcnt vmcnt(0)" ::: "memory");
        } else {
            XB_SPIN(xb_ld(&bar[XB_XGEN(b.x)]) == gen, bar);
            __builtin_amdgcn_fence(__ATOMIC_ACQUIRE, "agent");
            asm volatile("s_waitcnt vmcnt(0)" ::: "memory");
        }
    }
    __syncthreads();
}

namespace pg8 {
typedef int i32x4v __attribute__((ext_vector_type(4)));
typedef int i32x8v __attribute__((ext_vector_type(8)));
constexpr int BM = 256, BK = 64, HALF = 128, HTB = HALF * BK * 2, STAGE_BYTES = 8 * HTB, NXCD = 8, WGM = 8;
__host__ __device__ __forceinline__ int lds_byte(int r, int c) { const int st = (r >> 4) * 2 + (c >> 5), rr = r & 15, cc = c & 31, ob = rr * 64 + cc * 2; return st * 1024 + (ob ^ (((ob >> 9) & 1) << 5)); }
__host__ __device__ __forceinline__ void stage_rc(int b, int& R, int& C) { const int st = b / 1024, sb = b % 1024, swz = sb ^ (((sb >> 9) & 1) << 5); R = (st >> 1) * 16 + swz / 64; C = (st & 1) * 32 + (swz % 64) / 2; }
__host__ __device__ __forceinline__ int perm32(int rho) { const int n = rho >> 4, i = rho & 15; return 8 * (i >> 2) + 4 * n + (i & 3); }
struct Unit { int pm, pn; };
constexpr int RST_OFF = 4096, RST_UNITS = 11;
struct StaticOrder {
    int nM, nN, nwg, G, c, wgm;
    __device__ __forceinline__ void init(int nM_, int nN_, int G_, int c_, int wgm_ = WGM) { nM = nM_; nN = nN_; nwg = nM * nN; G = G_; c = c_; wgm = wgm_; }
    __device__ __forceinline__ bool next(int i, Unit& u) const {
        const long L = (long)i * G + c; if (L >= nwg) return false;
        int wgid = (int)L; { const int q = nwg / NXCD, r = nwg % NXCD, xcd = wgid % NXCD, off = wgid / NXCD; wgid = (xcd < r ? xcd * (q + 1) : r * (q + 1) + (xcd - r) * q) + off; }
        const int nig = wgm * nN, gid = wgid / nig, fm = gid * wgm, gsz = (nM - fm) < wgm ? (nM - fm) : wgm;
        u.pm = fm + ((wgid % nig) % gsz); u.pn = (wgid % nig) / gsz; return true;
    }
};
__device__ __forceinline__ f32x4 mma_f8(bf16x8 b0, bf16x8 b1, bf16x8 a0, bf16x8 a1, f32x4 c) {
    const i32x8v B = __builtin_shufflevector(__builtin_bit_cast(i32x4v, b0), __builtin_bit_cast(i32x4v, b1), 0, 1, 2, 3, 4, 5, 6, 7);
    const i32x8v A = __builtin_shufflevector(__builtin_bit_cast(i32x4v, a0), __builtin_bit_cast(i32x4v, a1), 0, 1, 2, 3, 4, 5, 6, 7);
    return __builtin_amdgcn_mfma_scale_f32_16x16x128_f8f6f4(B, A, c, 0, 0, 0, 0, 0, 0);
}
__device__ __forceinline__ const char* sgpr_ptr(const char* p) { asm volatile("" : "+s"(p)); return p; }
__device__ __forceinline__ unsigned cvt_pk_bf16(float lo, float hi) { unsigned r; asm volatile("v_cvt_pk_bf16_f32 %0, %1, %2" : "=v"(r) : "v"(lo), "v"(hi)); return r; }


template <int ESZ_>
struct ProbDenseT {
    static constexpr bool GATHER = false; static constexpr int ESZ = ESZ_;
    const bf16_t* A; const bf16_t* Bt; int lda, K;
    __device__ __forceinline__ int ldb_() const { return K; }
    __device__ __forceinline__ size_t a_base(const Unit& u) const { return (size_t)(u.pm * BM) * lda * ESZ; }
    __device__ __forceinline__ const char* b_base(const Unit& u) const { return (const char*)Bt + (size_t)u.pn * BM * K * ESZ; }
};
using ProbDense = ProbDenseT<2>; using ProbDense8 = ProbDenseT<1>;
struct MoeMap {
    const LAS int* tp;
    __device__ __forceinline__ void locate(int pm, int& e, int& lt, int& cnt) const {
        const i32x4v a = *(const LAS i32x4v*)tp, b = *(const LAS i32x4v*)(tp + 4);
        e = (pm >= a.y) + (pm >= a.z) + (pm >= a.w) + (pm >= b.x) + (pm >= b.y) + (pm >= b.z) + (pm >= b.w);
        e = __builtin_amdgcn_readfirstlane(e); lt = __builtin_amdgcn_readfirstlane(pm - tp[e]); cnt = __builtin_amdgcn_readfirstlane(tp[9 + e]);
    }
};
struct ProbMoeUp {
    static constexpr bool GATHER = true; static constexpr int ESZ = 1;
    const bf16_t* A; const bf16_t* Bt; int lda, K; MoeMap mm; const int* list; const float* wl;
    __device__ __forceinline__ int ldb_() const { return K; }
    __device__ __forceinline__ size_t row_idx(const Unit& u, int row) const { int e, lt, cnt; mm.locate(u.pm, e, lt, cnt); const int r = lt * BM + row; return (size_t)e * T + (r < cnt ? r : cnt - 1); }
    __device__ __forceinline__ size_t a_base(const Unit&) const { return 0; }
    __device__ __forceinline__ const char* b_base(const Unit& u) const { int e, lt, cnt; mm.locate(u.pm, e, lt, cnt); return (const char*)Bt + ((size_t)e * (2 * DEX) + (size_t)u.pn * BM) * K * ESZ; }
};
struct ProbMoeDown {
    static constexpr bool GATHER = false; static constexpr int ESZ = 1;
    const bf16_t* A; const bf16_t* Bt; int lda, K; MoeMap mm;
    __device__ __forceinline__ int ldb_() const { return K; }
    __device__ __forceinline__ size_t a_base(const Unit& u) const { return (size_t)(u.pm * BM) * lda * ESZ; }
    __device__ __forceinline__ const char* b_base(const Unit& u) const { int e, lt, cnt; mm.locate(u.pm, e, lt, cnt); return (const char*)Bt + ((size_t)e * D + (size_t)u.pn * BM) * K * ESZ; }
};

struct ProbMoeDownSlice {
    static constexpr bool GATHER = false; static constexpr int ESZ = 1;
    const bf16_t* A; const bf16_t* Bt; int lda, K, kfull, tile0; MoeMap mm;
    __device__ __forceinline__ int ldb_() const { return kfull; }
    __device__ __forceinline__ size_t a_base(const Unit& u) const { return ((size_t)((tile0 + u.pm) * BM) * lda + (size_t)(u.pn >> 2) * K) * ESZ; }
    __device__ __forceinline__ const char* b_base(const Unit& u) const { int e, lt, cnt; mm.locate(tile0 + u.pm, e, lt, cnt); return (const char*)Bt + (((size_t)e * D + (size_t)(u.pn & 3) * BM) * kfull + (size_t)(u.pn >> 2) * K) * ESZ; }
};
struct EpiPartialBf16 {
    static constexpr bool TOKTAB = false; static constexpr bool TAB = false; static constexpr int NVM = 32; static constexpr bool PERM = false;
    bf16_t* P; float scale;
    __device__ __forceinline__ void operator()(const f32x4 (&acc)[2][2][4][2], const Unit& u, int wr, int wc, int fr, int fq, LAS unsigned char* rt, int slot) const {
        bf16_t* tile = P + (size_t)(u.pm * 28 + u.pn) * (BM * BM) + (size_t)(wr * 64 + fr) * BM + wc * 32 + 4 * fq;
#pragma unroll
        for (int ai = 0; ai < 2; ++ai)
#pragma unroll
            for (int m = 0; m < 4; ++m)
#pragma unroll
                for (int bj = 0; bj < 2; ++bj)
#pragma unroll
                    for (int n = 0; n < 2; ++n) { const f32x4 v = acc[ai][bj][m][n] * scale; u32x2 w; w.x = cvt_pk_bf16(v.x, v.y); w.y = cvt_pk_bf16(v.z, v.w);
                        *(u32x2*)(tile + (size_t)(ai * HALF + m * 16) * BM + bj * HALF + n * 16) = w; }
    }
};
__device__ __forceinline__ float row_rs(const float* ss, int row) {
    const f32x4* p = (const f32x4*)(ss + (size_t)row * 16); const f32x4 a = p[0], b = p[1], c = p[2], d = p[3];
    return rsqrtf((((a.x + a.y) + (a.z + a.w)) + ((b.x + b.y) + (b.z + b.w)) + ((c.x + c.y) + (c.z + c.w)) + ((d.x + d.y) + (d.z + d.w))) * (1.0f / D) + EPS);
}
struct EpiStoreBf16 {
    static constexpr bool TOKTAB = false; static constexpr bool TAB = true; static constexpr int NVM = 16; static constexpr bool PERM = true;
    bf16_t* O; int ldc; const float* ss;
    __device__ __forceinline__ void operator()(const f32x4 (&acc)[2][2][4][2], const Unit& u, int wr, int wc, int fr, int fq, LAS unsigned char* rt, int slot) const {
        const int row0 = u.pm * BM + wr * 64 + fr, col0 = u.pn * BM + wc * 32 + 8 * fq;
        float rsv[2][4];
#pragma unroll
        for (int ai = 0; ai < 2; ++ai)
#pragma unroll
            for (int m = 0; m < 4; ++m) rsv[ai][m] = ss ? ((const LAS float*)(rt + RST_OFF))[slot * 256 + wr * 64 + fr + ai * HALF + m * 16] : 1.0f;
#pragma unroll
        for (int ai = 0; ai < 2; ++ai)
#pragma unroll
            for (int m = 0; m < 4; ++m) { bf16_t* rowp = O + (size_t)(row0 + ai * HALF + m * 16) * ldc + col0; const float rs = rsv[ai][m];
#pragma unroll
                for (int bj = 0; bj < 2; ++bj) { const f32x4 v0 = acc[ai][bj][m][0] * rs, v1 = acc[ai][bj][m][1] * rs;
                    u32x4 w; w.x = cvt_pk_bf16(v0[0], v0[1]); w.y = cvt_pk_bf16(v0[2], v0[3]); w.z = cvt_pk_bf16(v1[0], v1[1]); w.w = cvt_pk_bf16(v1[2], v1[3]);
                    *(u32x4*)(rowp + bj * HALF) = w; } }
    }
};
__device__ __forceinline__ void bf16x8_to_f32(const u32x4& w, f32x4& lo, f32x4& hi) {
    lo = (f32x4){__uint_as_float(w.x << 16), __uint_as_float(w.x & 0xffff0000u), __uint_as_float(w.y << 16), __uint_as_float(w.y & 0xffff0000u)};
    hi = (f32x4){__uint_as_float(w.z << 16), __uint_as_float(w.z & 0xffff0000u), __uint_as_float(w.w << 16), __uint_as_float(w.w & 0xffff0000u)};
}
template <bool IN_F32, bool ACC8 = false>
struct EpiResid {
    static constexpr bool TOKTAB = false; static constexpr bool TAB = false; static constexpr int NVM = ACC8 ? 0 : 16; static constexpr bool PERM = true;
    const void* resid; bf16_t* out; int ldc; float* ss; unsigned char* x8;
    static constexpr int RB = (IN_F32 || ACC8) ? 2 : 4;
    __device__ __forceinline__ void operator()(const f32x4 (&acc)[2][2][4][2], const Unit& u, int wr, int wc, int fr, int fq, LAS unsigned char* rt, int slot) const {
        const int row0 = u.pm * BM + wr * 64 + fr, col0 = u.pn * BM + wc * 32 + 8 * fq;
#pragma unroll
        for (int ai = 0; ai < 2; ++ai)
#pragma unroll
            for (int mb = 0; mb < 4; mb += RB) {
                f32x4 rf[RB][2][2]; u32x4 rb[RB][2];
#pragma unroll
                for (int m2 = 0; m2 < RB; ++m2) { const size_t off = (size_t)(row0 + ai * HALF + (mb + m2) * 16) * ldc + col0;
#pragma unroll
                    for (int bj = 0; bj < 2; ++bj) {
                        if constexpr (IN_F32) { rf[m2][bj][0] = *(const f32x4*)((const float*)resid + off + bj * HALF); rf[m2][bj][1] = *(const f32x4*)((const float*)resid + off + bj * HALF + 4); }
                        else rb[m2][bj] = *(const u32x4*)((ACC8 ? (const bf16_t*)out : (const bf16_t*)resid) + off + bj * HALF); } }
#pragma unroll
                for (int m2 = 0; m2 < RB; ++m2) { const int m = mb + m2, row = row0 + ai * HALF + m * 16; const size_t off = (size_t)row * ldc + col0; float s = 0.f;
#pragma unroll
                    for (int bj = 0; bj < 2; ++bj) { f32x4 v0, v1;
                        if constexpr (IN_F32) { v0 = rf[m2][bj][0]; v1 = rf[m2][bj][1]; } else bf16x8_to_f32(rb[m2][bj], v0, v1);
                        if constexpr (ACC8) { v0 += acc[ai][bj][m][0] * (1.0f / (F8_WSCALE * F8_ASCALE)); v1 += acc[ai][bj][m][1] * (1.0f / (F8_WSCALE * F8_ASCALE)); }
                        else { v0 += acc[ai][bj][m][0]; v1 += acc[ai][bj][m][1]; }
                        u32x4 w; w.x = cvt_pk_bf16(v0.x, v0.y); w.y = cvt_pk_bf16(v0.z, v0.w); w.z = cvt_pk_bf16(v1.x, v1.y); w.w = cvt_pk_bf16(v1.z, v1.w);
                        *(u32x4*)(out + off + bj * HALF) = w;
                        if (!ACC8 && x8) { u32x2 w8; w8.x = pk4_fp8(v0.x * F8_ASCALE, v0.y * F8_ASCALE, v0.z * F8_ASCALE, v0.w * F8_ASCALE); w8.y = pk4_fp8(v1.x * F8_ASCALE, v1.y * F8_ASCALE, v1.z * F8_ASCALE, v1.w * F8_ASCALE); *(u32x2*)(x8 + off + bj * HALF) = w8; }
                        if (ss) s += ((v0.x * v0.x + v0.y * v0.y) + (v0.z * v0.z + v0.w * v0.w)) + ((v1.x * v1.x + v1.y * v1.y) + (v1.z * v1.z + v1.w * v1.w)); }
                    if (ss) { s += xor_shfl<16>(s); s = half_sum(s); if (fq == 0) ((LAS float*)rt)[wc * 256 + (row - u.pm * BM)] = s; } }
                asm volatile("" ::: "memory"); }
        if (ss) {
            __syncthreads();
            const int t = wr * 256 + wc * 64 + fq * 16 + fr;
            if (t < 256) { const LAS float* q = (const LAS float*)rt + t; ss[((size_t)u.pm * BM + t) * 4 + u.pn] = (q[0] + q[256]) + (q[512] + q[768]); }
        }
    }
};
__device__ __forceinline__ float silu_fast(float x) { return x * __builtin_amdgcn_rcpf(1.0f + __builtin_amdgcn_exp2f(-1.4426950408889634f * x)); }
typedef float f32x2v __attribute__((ext_vector_type(2)));
__device__ __forceinline__ f32x4 swiglu4(const f32x4& g, const f32x4& u, float c1, float k) {
    const f32x2v c1v = {c1, c1}, kv = {k, k};
    const f32x2v ga = {g.x, g.y}, gb = {g.z, g.w}, ua = {u.x, u.y}, ub = {u.z, u.w};
    const f32x2v aa = ga * c1v, ab = gb * c1v;
    f32x2v ta = {__builtin_amdgcn_exp2f(aa.x), __builtin_amdgcn_exp2f(aa.y)}, tb = {__builtin_amdgcn_exp2f(ab.x), __builtin_amdgcn_exp2f(ab.y)};
    const f32x2v da = __builtin_elementwise_fma(ta, kv, kv), db = __builtin_elementwise_fma(tb, kv, kv);
    const f32x2v ra = {__builtin_amdgcn_rcpf(da.x), __builtin_amdgcn_rcpf(da.y)}, rb = {__builtin_amdgcn_rcpf(db.x), __builtin_amdgcn_rcpf(db.y)};
    const f32x2v oa = (ga * ua) * ra, ob = (gb * ub) * rb;
    return (f32x4){oa.x, oa.y, ob.x, ob.y};
}
struct EpiSwiglu {
    static constexpr bool TOKTAB = false; static constexpr bool TAB = true; static constexpr int NVM = 8; static constexpr bool PERM = true;
    bf16_t* O; int ldc; const float* ss; float wsc;
    __device__ __forceinline__ void operator()(const f32x4 (&acc)[2][2][4][2], const Unit& u, int wr, int wc, int fr, int fq, LAS unsigned char* rt, int slot) const {
        const int row0 = u.pm * BM + wr * 64 + fr, col0 = u.pn * HALF + wc * 32 + 8 * fq;
        float rsv[2][4];
#pragma unroll
        for (int ai = 0; ai < 2; ++ai)
#pragma unroll
            for (int m = 0; m < 4; ++m) rsv[ai][m] = ss ? ((const LAS float*)(rt + RST_OFF))[slot * 256 + wr * 64 + fr + ai * HALF + m * 16] : 1.0f;
#pragma unroll
        for (int ai = 0; ai < 2; ++ai)
#pragma unroll
            for (int m = 0; m < 4; ++m) { bf16_t* rowp = O + (size_t)(row0 + ai * HALF + m * 16) * ldc + col0; const float rs = rsv[ai][m] * wsc;
                const float c1 = -1.4426950408889634f * rs, k = __builtin_amdgcn_rcpf(rs * rs);
                const f32x4 o0 = swiglu4(acc[ai][0][m][0], acc[ai][1][m][0], c1, k), o1 = swiglu4(acc[ai][0][m][1], acc[ai][1][m][1], c1, k);
                u32x4 w; w.x = cvt_pk_bf16(o0[0], o0[1]); w.y = cvt_pk_bf16(o0[2], o0[3]); w.z = cvt_pk_bf16(o1[0], o1[1]); w.w = cvt_pk_bf16(o1[2], o1[3]);
                *(u32x4*)rowp = w; }
    }
};
struct EpiSwiglu8 {
    static constexpr bool TOKTAB = false; static constexpr bool TAB = true; static constexpr int NVM = 8; static constexpr bool PERM = true;
    unsigned char* O; int ldc; const float* ss; float wsc;
    __device__ __forceinline__ void operator()(const f32x4 (&acc)[2][2][4][2], const Unit& u, int wr, int wc, int fr, int fq, LAS unsigned char* rt, int slot) const {
        const int row0 = u.pm * BM + wr * 64 + fr, col0 = u.pn * HALF + wc * 32 + 8 * fq;
        float rsv[2][4];
#pragma unroll
        for (int ai = 0; ai < 2; ++ai)
#pragma unroll
            for (int m = 0; m < 4; ++m) rsv[ai][m] = ss ? ((const LAS float*)(rt + RST_OFF))[slot * 256 + wr * 64 + fr + ai * HALF + m * 16] : 1.0f;
#pragma unroll
        for (int ai = 0; ai < 2; ++ai)
#pragma unroll
            for (int m = 0; m < 4; ++m) { unsigned char* rowp = O + (size_t)(row0 + ai * HALF + m * 16) * ldc + col0; const float rs = rsv[ai][m] * wsc;
                const float c1 = -1.4426950408889634f * rs, k = __builtin_amdgcn_rcpf(rs * rs * F8_ASCALE);
                const f32x4 o0 = swiglu4(acc[ai][0][m][0], acc[ai][1][m][0], c1, k), o1 = swiglu4(acc[ai][0][m][1], acc[ai][1][m][1], c1, k);
                u32x2 w; w.x = pk4_fp8(o0[0], o0[1], o0[2], o0[3]); w.y = pk4_fp8(o1[0], o1[1], o1[2], o1[3]);
                *(u32x2*)rowp = w; }
    }
};
struct EpiSwigluMoe {
    static constexpr bool TOKTAB = false; static constexpr bool TAB = false; static constexpr int NVM = 8; static constexpr bool PERM = true;
    unsigned char* O; int ldc; MoeMap mm;
    __device__ __forceinline__ void operator()(const f32x4 (&acc)[2][2][4][2], const Unit& u, int wr, int wc, int fr, int fq, LAS unsigned char* rt, int slot) const {
        int e, lt, cnt; mm.locate(u.pm, e, lt, cnt);
        const int trow0 = wr * 64 + fr, col0 = u.pn * HALF + wc * 32 + 8 * fq;
        float w8[2][4];
#pragma unroll
        for (int ai = 0; ai < 2; ++ai)
#pragma unroll
            for (int m = 0; m < 4; ++m) { const int tr = trow0 + ai * HALF + m * 16; const float w = ((const LAS float*)(rt + 2048 + slot))[tr]; w8[ai][m] = (lt * BM + tr < cnt) ? w : 0.f; }
#pragma unroll
        for (int ai = 0; ai < 2; ++ai)
#pragma unroll
            for (int m = 0; m < 4; ++m) { const int tr = trow0 + ai * HALF + m * 16;
                unsigned char* rowp = O + (size_t)(u.pm * BM + tr) * ldc + col0;
                const float wgt = w8[ai][m], c1 = -1.4426950408889634f / F8_WSCALE, k = wgt > 0.f ? __builtin_amdgcn_rcpf(wgt * (F8_ASCALE / (F8_WSCALE * F8_WSCALE))) : 1.0e30f;
                const f32x4 o0 = swiglu4(acc[ai][0][m][0], acc[ai][1][m][0], c1, k), o1 = swiglu4(acc[ai][0][m][1], acc[ai][1][m][1], c1, k);
                u32x2 w; w.x = pk4_fp8(o0[0], o0[1], o0[2], o0[3]); w.y = pk4_fp8(o1[0], o1[1], o1[2], o1[3]);
                *(u32x2*)rowp = w; }
    }
};
template <bool OUT_F32>
struct EpiScatterMoe {
    static constexpr bool TAB = false; static constexpr bool TOKTAB = true; static constexpr int NVM = 0; static constexpr bool PERM = true;
    const bf16_t* xs; void* out; int ldc; MoeMap mm; const int* list; float scale;
    __device__ __forceinline__ int tok_of(const Unit& u, int row) const { int e, lt, cnt; mm.locate(u.pm, e, lt, cnt); const int lr = lt * BM + row; return lr < cnt ? list[(size_t)e * T + lr] : -1; }
    __device__ __forceinline__ void operator()(const f32x4 (&acc)[2][2][4][2], const Unit& u, int wr, int wc, int fr, int fq, LAS unsigned char* rt, int slot) const {
        const int trow0 = wr * 64 + fr, col0 = u.pn * BM + wc * 32 + 8 * fq;
        int tok[2][4];
#pragma unroll
        for (int ai = 0; ai < 2; ++ai)
#pragma unroll
            for (int m = 0; m < 4; ++m) tok[ai][m] = ((const LAS int*)(rt + RST_OFF))[slot * 256 + trow0 + ai * HALF + m * 16];
#pragma unroll
        for (int ai = 0; ai < 2; ++ai) {
            u32x4 rb[4][2];
#pragma unroll
            for (int m = 0; m < 4; ++m) { const bf16_t* rowp = xs + (size_t)(tok[ai][m] >= 0 ? tok[ai][m] : 0) * ldc + col0;
#pragma unroll
                for (int bj = 0; bj < 2; ++bj) rb[m][bj] = *(const u32x4*)(rowp + bj * HALF); }
#pragma unroll
            for (int m = 0; m < 4; ++m) { if (tok[ai][m] >= 0) { const size_t off = (size_t)tok[ai][m] * ldc + col0;
#pragma unroll
                for (int bj = 0; bj < 2; ++bj) { f32x4 v0, v1; bf16x8_to_f32(rb[m][bj], v0, v1); v0 += acc[ai][bj][m][0] * scale; v1 += acc[ai][bj][m][1] * scale;
                    if constexpr (OUT_F32) { *(f32x4*)((float*)out + off + bj * HALF) = v0; *(f32x4*)((float*)out + off + bj * HALF + 4) = v1; }
                    else { u32x4 w; w.x = cvt_pk_bf16(v0.x, v0.y); w.y = cvt_pk_bf16(v0.z, v0.w); w.z = cvt_pk_bf16(v1.x, v1.y); w.w = cvt_pk_bf16(v1.z, v1.w); *(u32x4*)((bf16_t*)out + off + bj * HALF) = w; } } } }
            asm volatile("" ::: "memory"); }
    }
};

template <class Prob, class Epi>
__device__ __forceinline__ void gemm_phase(LAS unsigned char* lds, LAS unsigned char* rowtab, const Prob& pb, const StaticOrder& S, const Epi& E, int wv) {
    const int tid = launder(tid_of(wv)), wid = __builtin_amdgcn_readfirstlane(tid >> 6), lane = tid & 63, wr = wid >> 2, wc = wid & 3, fr = lane & 15, fq = lane >> 4;
    const int K = pb.K, nt = K * Prob::ESZ / (2 * BK);
    int R0, C0; stage_rc(tid * 16, R0, C0);
    const unsigned c2 = (unsigned)C0 * 2u;
    const unsigned voffB = (unsigned)((Epi::PERM ? ((R0 & ~31) + perm32(R0 & 31)) : R0) * pb.ldb_()) * (unsigned)Prob::ESZ + c2;
    const unsigned voffA = Prob::GATHER ? 0u : (unsigned)(R0 * pb.lda) * (unsigned)Prob::ESZ + c2;
    const size_t step64B = (size_t)64 * pb.ldb_() * Prob::ESZ, step64A = (size_t)64 * pb.lda * Prob::ESZ, hstepA = (size_t)HALF * pb.lda * Prob::ESZ;
    const size_t hstepB = (size_t)HALF * pb.ldb_() * Prob::ESZ;
    const unsigned ldsw = (unsigned)wid * 1024u;
    const int aoff = lds_byte(wr * 64 + fr, fq * 8), boff = lds_byte(wc * 32 + fr, fq * 8);
    const char* Ab = (const char*)pb.A;
    LAS unsigned char* tabl = rowtab + R0 * 4;
    int slotC = 0, slotN = 1024;
    const unsigned rowbytes = (unsigned)(pb.lda * Prob::ESZ);
#define PG8_TABLES(un, slot) do { if constexpr (Prob::GATHER) { if (wid < 4) { const size_t _ix = pb.row_idx(un, tid); \
        __builtin_amdgcn_global_load_lds((const unsigned*)(pb.list + _ix), (LAS unsigned*)(rowtab + (slot) + wid * 256), 4, 0, 0); \
        __builtin_amdgcn_global_load_lds((const unsigned*)(pb.wl + _ix), (LAS unsigned*)(rowtab + 2048 + (slot) + wid * 256), 4, 0, 0); } } } while (0)
#define PG8_SA(b, h) (((b) * 2 + (h)) * HTB)
#define PG8_SB(b, h) ((4 + (b) * 2 + (h)) * HTB)
#define PG8_STAGE2(bufoff, g0, v0, g1, v1) do { const char* _p0 = sgpr_ptr((const char*)(g0)); const char* _p1 = sgpr_ptr((const char*)(g1)); const unsigned _v0 = (unsigned)launder((int)(v0)), _v1 = (unsigned)launder((int)(v1)); \
        __builtin_amdgcn_global_load_lds((const unsigned*)(_p0 + _v0), (LAS unsigned*)(lds + (bufoff) + ldsw), 16, 0, 0); \
        __builtin_amdgcn_global_load_lds((const unsigned*)(_p1 + _v1), (LAS unsigned*)(lds + (bufoff) + ldsw + 8192), 16, 0, 0); } while (0)
#define PG8_STAGE_B(bufoff, gbase) PG8_STAGE2(bufoff, gbase, voffB, (gbase) + step64B, voffB)
#define PG8_STAGE_A(bufoff, gbase) do { if constexpr (Prob::GATHER) PG8_STAGE2(bufoff, gbase, q0, gbase, q1); else PG8_STAGE2(bufoff, (gbase) + aofs, voffA, (gbase) + aofs + step64A, voffA); } while (0)
#define PG8_AOFF(nx, h, q0, q1) do { if constexpr (Prob::GATHER) { const LAS unsigned* _t = (const LAS unsigned*)(tabl + ((nx) ? slotN : slotC) + (h) * 512); q0 = _t[0] * rowbytes + c2; q1 = _t[64] * rowbytes + c2; } \
        else { aofs = ((nx) ? aN : aC) + (h) * hstepA; } } while (0)
#define PG8_LDA(dst, b, h) do { _Pragma("unroll") for (int m = 0; m < 4; ++m) _Pragma("unroll") for (int k = 0; k < 2; ++k) dst[m][k] = *(const LAS bf16x8*)(lds + PG8_SA(b, h) + aoff + m * 2048 + k * 1024); } while (0)
#define PG8_LDB(dst, b, h) do { _Pragma("unroll") for (int n = 0; n < 2; ++n) _Pragma("unroll") for (int k = 0; k < 2; ++k) dst[n][k] = *(const LAS bf16x8*)(lds + PG8_SB(b, h) + boff + n * 2048 + k * 1024); } while (0)
#define PG8_MMA(ai, bj, At, Bt) do { __builtin_amdgcn_s_setprio(1); _Pragma("unroll") for (int m = 0; m < 4; ++m) _Pragma("unroll") for (int n = 0; n < 2; ++n) { \
        if constexpr (Prob::ESZ == 1) acc[ai][bj][m][n] = mma_f8(Bt[n][0], Bt[n][1], At[m][0], At[m][1], acc[ai][bj][m][n]); \
        else { _Pragma("unroll") for (int k = 0; k < 2; ++k) acc[ai][bj][m][n] = __builtin_amdgcn_mfma_f32_16x16x32_bf16(Bt[n][k], At[m][k], acc[ai][bj][m][n], 0, 0, 0); } } __builtin_amdgcn_s_setprio(0); } while (0)
#define PG8_WAIT_V(n) asm volatile("s_waitcnt vmcnt(" #n ")" ::: "memory")
#define PG8_WAIT_V8F(first) do { if (first) asm volatile("s_waitcnt vmcnt(%0)" :: "n"(8 + Epi::NVM) : "memory"); else asm volatile("s_waitcnt vmcnt(8)" ::: "memory"); } while (0)
#define PG8_WAIT_L(n) asm volatile("s_waitcnt lgkmcnt(" #n ")" ::: "memory")
#define PG8_BAR __builtin_amdgcn_s_barrier()
#define PG8_SCHED __builtin_amdgcn_sched_barrier(0)
    Unit cur, nxt; int ui = 0;
    if (!S.next(0, cur)) return;
    f32x4 acc[2][2][4][2];
#pragma unroll
    for (int a = 0; a < 2; ++a)
#pragma unroll
        for (int b = 0; b < 2; ++b)
#pragma unroll
            for (int m = 0; m < 4; ++m)
#pragma unroll
                for (int n = 0; n < 2; ++n) acc[a][b][m][n] = (f32x4){0.f, 0.f, 0.f, 0.f};
    bf16x8 At[4][2], B0[2][2], B1[2][2];
    size_t aC = 0, aN = 0, aofs = 0;
    unsigned q0 = 0, q1 = 0;
    if constexpr (Prob::GATHER) { PG8_TABLES(cur, 0); PG8_WAIT_V(0); PG8_BAR; }
    else aC = pb.a_base(cur);
    const char* cB = pb.b_base(cur);
    PG8_STAGE_B(PG8_SB(0, 0), cB); PG8_STAGE_B(PG8_SB(0, 1), cB + hstepB);
    PG8_AOFF(false, 0, q0, q1); PG8_STAGE_A(PG8_SA(0, 0), Ab); PG8_AOFF(false, 1, q0, q1); PG8_STAGE_A(PG8_SA(0, 1), Ab);
    if (wr == 1) PG8_BAR;
    PG8_WAIT_V(2); PG8_BAR;
    PG8_STAGE_B(PG8_SB(1, 0), cB + 128); PG8_AOFF(false, 0, q0, q1); PG8_STAGE_A(PG8_SA(1, 0), Ab + 128); PG8_STAGE_B(PG8_SB(1, 1), cB + hstepB + 128);
    if constexpr (Epi::TOKTAB) {
        LAS int* tkT = (LAS int*)(rowtab + RST_OFF);
        for (int i0 = 0; i0 < RST_UNITS + 1; i0 += 2) { Unit um; const int iu = i0 + __builtin_amdgcn_readfirstlane(tid >> 8);
            if (iu < RST_UNITS && S.next(iu, um)) tkT[iu * 256 + (tid & 255)] = E.tok_of(um, tid & 255); }
        __syncthreads();
    }
    if constexpr (Epi::TAB) {
        if (E.ss != nullptr) {
            LAS float* rsT = (LAS float*)(rowtab + RST_OFF);
            for (int i0 = 0; i0 < RST_UNITS + 1; i0 += 2) { Unit um; const int iu = i0 + __builtin_amdgcn_readfirstlane(tid >> 8);
                if (iu < RST_UNITS && S.next(iu, um)) { const f32x4 q4 = *(const f32x4*)(E.ss + ((size_t)um.pm * BM + (tid & 255)) * 4);
                    rsT[iu * 256 + (tid & 255)] = rsqrtf(((q4.x + q4.y) + (q4.z + q4.w)) * (1.0f / D) + EPS); } }
            __syncthreads();
        }
    }
    PG8_WAIT_V(6); PG8_BAR;
    for (;;) {
        const bool has_next = S.next(ui + 1, nxt);
        const char* nB = has_next ? pb.b_base(nxt) : cB;
        if constexpr (Prob::GATHER) { if (has_next) PG8_TABLES(nxt, slotN); }
        else aN = has_next ? pb.a_base(nxt) : aC;
        for (int t = 0; t < nt; t += 2) {
            const bool last = (t == nt - 2);
            const char* a1 = Ab + (size_t)(t + 1) * 128;
            const char* a2 = last ? Ab : Ab + (size_t)(t + 2) * 128; const char* b2 = last ? nB : cB + (size_t)(t + 2) * 128;
            const char* a3 = a2 + 128; const char* b3 = b2 + 128;
            PG8_AOFF(false, 1, q0, q1); PG8_LDB(B0, 0, 0); PG8_LDB(B1, 0, 1); PG8_SCHED; PG8_LDA(At, 0, 0); PG8_STAGE_A(PG8_SA(1, 1), a1);
            PG8_WAIT_V8F(t == 0); PG8_WAIT_L(0); PG8_BAR; PG8_MMA(0, 0, At, B0); PG8_MMA(0, 1, At, B1); PG8_BAR; PG8_SCHED;
            PG8_AOFF(last, 0, q0, q1); PG8_LDA(At, 0, 1); PG8_STAGE_B(PG8_SB(0, 0), b2); PG8_STAGE_B(PG8_SB(0, 1), b2 + hstepB); PG8_STAGE_A(PG8_SA(0, 0), a2);
            PG8_WAIT_V8F(t == 0); PG8_WAIT_L(0); PG8_BAR; PG8_MMA(1, 0, At, B0); PG8_MMA(1, 1, At, B1); PG8_BAR; PG8_SCHED;
            PG8_AOFF(last, 1, q0, q1); PG8_LDB(B0, 1, 0); PG8_LDB(B1, 1, 1); PG8_SCHED; PG8_LDA(At, 1, 0); PG8_STAGE_A(PG8_SA(0, 1), a2);
            PG8_WAIT_V(8); PG8_WAIT_L(0); PG8_BAR; PG8_MMA(0, 0, At, B0); PG8_MMA(0, 1, At, B1); PG8_BAR; PG8_SCHED;
            PG8_AOFF(last, 0, q0, q1); PG8_LDA(At, 1, 1); PG8_STAGE_B(PG8_SB(1, 0), b3); PG8_STAGE_B(PG8_SB(1, 1), b3 + hstepB); PG8_STAGE_A(PG8_SA(1, 0), a3);
            PG8_WAIT_V(8); PG8_WAIT_L(0); PG8_BAR; PG8_MMA(1, 0, At, B0); PG8_MMA(1, 1, At, B1); PG8_BAR; PG8_SCHED;
        }
        if (wr == 0) PG8_BAR;
        { const int le = lane_id_v(); E(acc, cur, wr, wc, le & 15, le >> 4, rowtab, (Epi::TAB || Epi::TOKTAB) ? ui : slotC); }
        if (!has_next) break;
#pragma unroll
        for (int a = 0; a < 2; ++a)
#pragma unroll
            for (int b = 0; b < 2; ++b)
#pragma unroll
                for (int m = 0; m < 4; ++m)
#pragma unroll
                    for (int n = 0; n < 2; ++n) acc[a][b][m][n] = (f32x4){0.f, 0.f, 0.f, 0.f};
        cur = nxt; cB = nB; ++ui;
        if constexpr (Prob::GATHER) { slotC ^= 1024; slotN ^= 1024; }
        else {
            aC = aN;
        }
        if (wr == 1) PG8_BAR;
    }
    PG8_WAIT_V(0);
    PG8_BAR;
#undef PG8_SA
#undef PG8_SB
#undef PG8_STAGE2
#undef PG8_TABLES
#undef PG8_STAGE_A
#undef PG8_STAGE_B
#undef PG8_AOFF
#undef PG8_LDA
#undef PG8_LDB
#undef PG8_MMA
#undef PG8_WAIT_V
#undef PG8_WAIT_V8F
#undef PG8_WAIT_L
#undef PG8_BAR
#undef PG8_SCHED
}
}

struct MkArgs { const void* in[29]; float* out; unsigned char* ws; int ph_lo, ph_hi, li, pad; };
struct Frame {
    LAS unsigned char* lds; volatile LAS unsigned* MISC; unsigned* ctl;
    int tid, lane, wave, vcu, G, wv;
};
__device__ __forceinline__ void relaunder(Frame& F) { F.tid = launder(tid_of(F.wv)); F.lane = F.tid & 63; F.wave = __builtin_amdgcn_readfirstlane(F.tid >> 6); }
enum { P_PREP = 0, PL_WIN = 0, PL_MLA = 1, PL_MIXERS = 2, PL_PREPMIX = 3, PL_WOUT = 4, PL_NORM2 = 5, PL_UP0 = 6, PL_DOWN0 = 7, PL_UP1 = 8, PL_DOWN1 = 9, PL_NORMN = 10, PL_COUNT = 11, P_TOTAL = 1 + 2 * PL_COUNT };
__host__ __device__ constexpr int PH(int l, int k) { return 1 + l * PL_COUNT + k; }

__device__ __forceinline__ bool small_job(int item, const MkArgs& a, TrJob& J, int& local) {
    unsigned char* ws = a.ws;
    const float* w_in = (const float*)a.in[3]; const float* w_out = (const float*)a.in[21]; const float* uq = (const float*)a.in[15]; const float* ukv = (const float*)a.in[17];
    const float* qn = (const float*)a.in[14]; const float* kvn = (const float*)a.in[16]; const float* gu = (const float*)a.in[23]; const float* dn = (const float*)a.in[24];
    int r = item;
    for (int l = 0; l < 2; ++l) {
        if (r < 1104) { J = TrJob{w_in + (size_t)l * D * DIN, (bf16_t*)(ws + WS_WIN) + (size_t)l * DINP * D, (const float*)a.in[2] + l * D, D, DIN, DIN, D, 0, 0}; local = r; return true; } r -= 1104;
        if (r < 512) { J = TrJob{w_out + (size_t)l * D * D, (bf16_t*)(ws + WS_WOUT) + (size_t)l * D * D, nullptr, D, D, D, D, 0, 0}; local = r; return true; } r -= 512;
        if (r < 96) { J = TrJob{uq + (size_t)l * 256 * 768, (bf16_t*)(ws + WS_WUQ) + (size_t)l * 768 * 256, qn + l * 256, 256, 768, 768, 256, 0, 0}; local = r; return true; } r -= 96;
        if (r < 64) { J = TrJob{ukv + (size_t)l * 128 * 1024, (bf16_t*)(ws + WS_WUKV) + (size_t)l * 1024 * 128, kvn + l * 128, 128, 1024, 1024, 128, 0, 0}; local = r; return true; } r -= 64;
    }
    if (r < 1376) { J = TrJob{gu, (bf16_t*)(ws + WS_WGU), (const float*)a.in[22], D, DFF, 2 * DFF, D, 3, 0}; local = r; return true; } r -= 1376;
    if (r < 1376) { J = TrJob{gu + DFF, (bf16_t*)(ws + WS_WGU), (const float*)a.in[22], D, DFF, 2 * DFF, D, 3, 128}; local = r; return true; } r -= 1376;
    if (r < 1376) { J = TrJob{dn, (bf16_t*)(ws + WS_WDN), nullptr, DFF, D, D, DFFP, 2, 0}; local = r; return true; }
    return false;
}
constexpr int N_SMALL_ITEMS = 2 * (1104 + 512 + 96 + 64) + 3 * 1376;
constexpr int N_SMALL_FIRST = 1104;
__device__ __forceinline__ void moe_job_of(int e, int ty, const MkArgs& a, TrJob& J) {
    const float* w1 = (const float*)a.in[26]; const float* w3 = (const float*)a.in[27]; const float* w2 = (const float*)a.in[28];
    if (ty == 0) J = TrJob{w1 + (size_t)e * D * DEX, (bf16_t*)(a.ws + WS_W13 + (size_t)e * 2 * DEX * D), nullptr, D, DEX, DEX, D, 3, 0};
    else if (ty == 1) J = TrJob{w3 + (size_t)e * D * DEX, (bf16_t*)(a.ws + WS_W13 + (size_t)e * 2 * DEX * D), nullptr, D, DEX, DEX, D, 3, 128};
    else J = TrJob{w2 + (size_t)e * DEX * D, (bf16_t*)(a.ws + WS_W2 + (size_t)e * D * DEX), nullptr, DEX, D, D, DEX, 2, 0};
}
constexpr int N_MOE_EARLY = 8 * 1792, N_MOE_LATE = 16 * 1792;
__device__ __forceinline__ void moe_job_early(int item, const MkArgs& a, TrJob& J, int& local) { const int e = item / 1792; local = item - e * 1792; moe_job_of(e, 0, a, J); }
__device__ __forceinline__ void moe_job_late(int item, const MkArgs& a, TrJob& J, int& local) { const int job = item / 1792; local = item - job * 1792; moe_job_of(job >> 1, 1 + (job & 1), a, J); }
__device__ __forceinline__ void zero_rows(Frame& F, bf16_t* p, int rows, int cols, int ld) {
    const int per = cols / 8, n = rows * per;
    for (int i = F.vcu * (NWAVES * 64) + F.tid; i < n; i += F.G * NWAVES * 64) *(u32x4*)(p + (size_t)(i / per) * ld + (i % per) * 8) = (u32x4){0u, 0u, 0u, 0u};
}
template <bool F8, bool IN_BF16>
__device__ __forceinline__ void norm_row(const void* xrow, const u32x2 (&raw)[4], const float* g, bf16_t* orow, int lane, f32x4 (&v)[4]) {
    const f32x4* gr = (const f32x4*)g + lane; float ss = 0.f;
#pragma unroll
    for (int j = 0; j < 4; ++j) {
        if constexpr (IN_BF16) { const u32x2 w = raw[j]; v[j] = (f32x4){__uint_as_float(w.x << 16), __uint_as_float(w.x & 0xffff0000u), __uint_as_float(w.y << 16), __uint_as_float(w.y & 0xffff0000u)}; }
        else v[j] = *((const f32x4*)xrow + lane + 64 * j);
        ss += (v[j].x * v[j].x + v[j].y * v[j].y) + (v[j].z * v[j].z + v[j].w * v[j].w); }
    const float rs = rsqrtf(wave_sum(ss) * (1.0f / D) + EPS);
#pragma unroll
    for (int j = 0; j < 4; ++j) { const f32x4 gg = gr[64 * j]; v[j] = v[j] * rs * gg;
        if constexpr (F8) *(unsigned*)((unsigned char*)orow + 4 * (lane + 64 * j)) = pk4_fp8(v[j].x, v[j].y, v[j].z, v[j].w);
        else { u32x2 w; w.x = pk2(v[j].x, v[j].y); w.y = pk2(v[j].z, v[j].w); *(u32x2*)(orow + 4 * (lane + 64 * j)) = w; } }
}
__device__ __forceinline__ void stream_in_phase(Frame& F, const float* x, bf16_t* xs, float* ss) {
    const int gw = F.vcu * NWAVES + F.wave, NGW = F.G * NWAVES;
    for (int m = gw; m < T; m += NGW) { const f32x4* xr = (const f32x4*)(x + (size_t)m * D) + F.lane; f32x4 v[4]; float s = 0.f;
#pragma unroll
        for (int j = 0; j < 4; ++j) { v[j] = xr[64 * j]; s += (v[j].x * v[j].x + v[j].y * v[j].y) + (v[j].z * v[j].z + v[j].w * v[j].w); }
#pragma unroll
        for (int j = 0; j < 4; ++j) { u32x2 w; w.x = pk2(v[j].x, v[j].y); w.y = pk2(v[j].z, v[j].w); *(u32x2*)(xs + (size_t)m * D + 4 * (F.lane + 64 * j)) = w; }
        s = wave_sum(s);
        if (F.lane < 4) ss[(size_t)m * 4 + F.lane] = F.lane == 0 ? s : 0.f; }
}
constexpr int CW_PAIR = 12288, CW_TK = 20480;
constexpr size_t WS_ROUTE = WS_LIST + 4 * MiB;
__device__ __forceinline__ void norm_router_phase(Frame& F, const bf16_t* x, const float* g, bf16_t* out, const float* router, int* route_e, float* route_w) {
    const int RPB = T / F.G;
    volatile LAS int* lpair = (volatile LAS int*)(F.lds + RING_OFF);
    if (F.tid < 64) lpair[F.tid] = 0;
    __syncthreads();
    const int rpw = RPB / NWAVES;
    u32x2 nraw[4];
    { const u32x2* xr0 = (const u32x2*)(x + (size_t)(F.vcu * RPB + F.wave * rpw) * D) + F.lane;
#pragma unroll
      for (int j = 0; j < 4; ++j) nraw[j] = xr0[64 * j]; }
    for (int k = 0; k < rpw; ++k) {
        const int lr = F.wave * rpw + k, row = F.vcu * RPB + lr; f32x4 v[4]; u32x2 raw[4];
#pragma unroll
        for (int j = 0; j < 4; ++j) raw[j] = nraw[j];
        if (k + 1 < rpw) { const u32x2* xr1 = (const u32x2*)(x + (size_t)(row + 1) * D) + F.lane;
#pragma unroll
          for (int j = 0; j < 4; ++j) nraw[j] = xr1[64 * j]; }
        norm_row<true, true>(nullptr, raw, g, (bf16_t*)((unsigned char*)out + (size_t)row * D), F.lane, v);
        float p[8];
#pragma unroll
        for (int e = 0; e < 8; ++e) p[e] = 0.f;
#pragma unroll
        for (int j = 0; j < 4; ++j) { const f32x4* rr = (const f32x4*)(router + (size_t)(4 * (F.lane + 64 * j)) * 8);
#pragma unroll
            for (int c = 0; c < 4; ++c) { const f32x4 r0 = rr[2 * c], r1 = rr[2 * c + 1]; const float y = v[j][c];
                p[0] += y * r0.x; p[1] += y * r0.y; p[2] += y * r0.z; p[3] += y * r0.w; p[4] += y * r1.x; p[5] += y * r1.y; p[6] += y * r1.z; p[7] += y * r1.w; } }
#pragma unroll
        for (int e = 0; e < 8; ++e) p[e] = wave_sum(p[e]);
        if (F.lane == 0) {
            int i0 = 0; float v0 = p[0];
#pragma unroll
            for (int e = 1; e < 8; ++e) if (p[e] > v0) { v0 = p[e]; i0 = e; }
            int i1 = -1; float v1 = -3.0e38f;
#pragma unroll
            for (int e = 0; e < 8; ++e) if (e != i0 && p[e] > v1) { v1 = p[e]; i1 = e; }
            route_e[row] = i0 | (i1 << 4); route_w[row] = 1.0f / (1.0f + __expf(v1 - v0));
            __hip_atomic_fetch_add((LAS int*)&lpair[i0 * 8 + i1], 1, __ATOMIC_RELAXED, __HIP_MEMORY_SCOPE_WORKGROUP);
        }
    }
    __syncthreads();
    if (F.tid < 64 && lpair[F.tid] > 0) __hip_atomic_fetch_add(F.ctl + CW_PAIR + 64 * F.tid, (unsigned)lpair[F.tid], RLX_AGENT);
    __syncthreads();
}
__device__ __forceinline__ void route_assign_phase(Frame& F, const int* route_e, const float* route_w, int* list, float* wl) {
    const int RPB = T / F.G;
    volatile LAS int* pn = (volatile LAS int*)(F.lds + RING_OFF);
    volatile LAS int* sq = pn + 64; volatile LAS int* lp = pn + 128; volatile LAS int* lb = pn + 192; volatile LAS int* lc = pn + 256; volatile LAS int* lcb = pn + 272;
    if (F.tid < 64) { pn[F.tid] = (int)__hip_atomic_load(F.ctl + CW_PAIR + 64 * F.tid, RLX_AGENT); sq[F.tid] = 0; lp[F.tid] = 0; }
    if (F.tid < 16) lc[F.tid] = 0;
    __syncthreads();
    if (F.tid == 0) {
        int d[8], r[8], R = 0;
        for (int e = 0; e < 8; ++e) { int c = 0; for (int f = 0; f < 8; ++f) c += pn[e * 8 + f]; r[e] = c & 255; d[e] = r[e]; R += r[e]; }
        for (int m = R >> 8; m > 0; --m) { int be = -1, br = -1; for (int e = 0; e < 8; ++e) if (d[e] >= 0 && r[e] > br) { br = r[e]; be = e; } if (be < 0 || br <= 0) break; d[be] = r[be] - 256; r[be] = -1; }
        for (int e = 0; e < 8; ++e) for (int f = 0; f < 8 && d[e] > 0; ++f) if (f != e && d[f] < 0) { int take = d[e]; if (-d[f] < take) take = -d[f]; if (pn[e * 8 + f] < take) take = pn[e * 8 + f]; sq[e * 8 + f] = take; d[e] -= take; d[f] += take; }
    }
    __syncthreads();
    int e0 = 0, e1 = 1, pi = 0, li = 0; float w0 = 0.f;
    if (F.tid < RPB) { const int tok = F.vcu * RPB + F.tid; const int pe = route_e[tok]; e0 = pe & 15; e1 = pe >> 4; w0 = route_w[tok]; pi = e0 * 8 + e1;
        li = __hip_atomic_fetch_add((LAS int*)&lp[pi], 1, __ATOMIC_RELAXED, __HIP_MEMORY_SCOPE_WORKGROUP); }
    __syncthreads();
    if (F.tid < 64) lb[F.tid] = (lp[F.tid] > 0 && sq[F.tid] > 0) ? (int)__hip_atomic_fetch_add(F.ctl + CW_TK + 64 * F.tid, (unsigned)lp[F.tid], RLX_AGENT) : 0x40000000;
    __syncthreads();
    int p0 = 0, p1 = 0;
    if (F.tid < RPB) { if (lb[pi] + li < sq[pi]) { const int t = e0; e0 = e1; e1 = t; w0 = 1.0f - w0; }
        p0 = __hip_atomic_fetch_add((LAS int*)&lc[e0], 1, __ATOMIC_RELAXED, __HIP_MEMORY_SCOPE_WORKGROUP);
        p1 = __hip_atomic_fetch_add((LAS int*)&lc[8 + e1], 1, __ATOMIC_RELAXED, __HIP_MEMORY_SCOPE_WORKGROUP); }
    __syncthreads();
    if (F.tid < 16) lcb[F.tid] = (int)__hip_atomic_fetch_add(F.ctl + CW_CNT + 64 * F.tid, (unsigned)lc[F.tid], RLX_AGENT);
    __syncthreads();
    if (F.tid < RPB) { const int tok = F.vcu * RPB + F.tid; const size_t a0 = (size_t)e0 * T + lcb[e0] + p0, a1 = (size_t)(8 + e1) * T + lcb[8 + e1] + p1;
        list[a0] = tok; wl[a0] = w0; list[a1] = tok; wl[a1] = 1.0f - w0; }
    __syncthreads();
}
__device__ __forceinline__ void prepmix_token(const bf16_t* pr, const bf16_t* dr, const bf16_t* yc, bf16_t* mx, const float* g_a, const float* g_n, const float* g_c, int lane) {
    { const u32x2 hf = *(const u32x2*)(dr + 4 * lane), hb = *(const u32x2*)(dr + 256 + 4 * lane), ga = *(const u32x2*)(pr + C_GA + 4 * lane);
      float v[4];
      v[0] = (__uint_as_float(hf.x << 16) + __uint_as_float(hb.x << 16)) * gelu_tanh(__uint_as_float(ga.x << 16));
      v[1] = (__uint_as_float(hf.x & 0xffff0000u) + __uint_as_float(hb.x & 0xffff0000u)) * gelu_tanh(__uint_as_float(ga.x & 0xffff0000u));
      v[2] = (__uint_as_float(hf.y << 16) + __uint_as_float(hb.y << 16)) * gelu_tanh(__uint_as_float(ga.y << 16));
      v[3] = (__uint_as_float(hf.y & 0xffff0000u) + __uint_as_float(hb.y & 0xffff0000u)) * gelu_tanh(__uint_as_float(ga.y & 0xffff0000u));
      const float rs = rsqrtf(wave_sum(v[0] * v[0] + v[1] * v[1] + v[2] * v[2] + v[3] * v[3]) * (1.0f / 256.0f) + EPS);
      const f32x4 g = *(const f32x4*)(g_a + 4 * lane);
      u32x2 w; w.x = pk2(v[0] * rs * g.x, v[1] * rs * g.y); w.y = pk2(v[2] * rs * g.z, v[3] * rs * g.w); *(u32x2*)(mx + 4 * lane) = w; }
    { const u32x2 of = *(const u32x2*)(dr + 512 + 4 * lane), ob = *(const u32x2*)(dr + 768 + 4 * lane), hg = *(const u32x2*)(pr + C_HG + 4 * lane);
      float v[4];
      v[0] = __uint_as_float(of.x << 16) + __uint_as_float(ob.x << 16); v[1] = __uint_as_float(of.x & 0xffff0000u) + __uint_as_float(ob.x & 0xffff0000u);
      v[2] = __uint_as_float(of.y << 16) + __uint_as_float(ob.y << 16); v[3] = __uint_as_float(of.y & 0xffff0000u) + __uint_as_float(ob.y & 0xffff0000u);
      float ss = v[0] * v[0] + v[1] * v[1] + v[2] * v[2] + v[3] * v[3];
      ss += xor_shfl<1>(ss); ss += xor_shfl<2>(ss); ss += xor_shfl<4>(ss); ss += xor_shfl<8>(ss);
      const float rs = rsqrtf(ss * (1.0f / 64.0f) + EPS);
      const f32x4 g = *(const f32x4*)(g_n + 4 * (lane & 15));
      u32x2 w; w.x = pk2(v[0] * rs * g.x * siluf_(__uint_as_float(hg.x << 16)), v[1] * rs * g.y * siluf_(__uint_as_float(hg.x & 0xffff0000u)));
      w.y = pk2(v[2] * rs * g.z * siluf_(__uint_as_float(hg.y << 16)), v[3] * rs * g.w * siluf_(__uint_as_float(hg.y & 0xffff0000u)));
      *(u32x2*)(mx + 256 + 4 * lane) = w; }
    { const u32x4 y = *(const u32x4*)yc;
      float v[8] = {__uint_as_float(y.x << 16), __uint_as_float(y.x & 0xffff0000u), __uint_as_float(y.y << 16), __uint_as_float(y.y & 0xffff0000u),
                    __uint_as_float(y.z << 16), __uint_as_float(y.z & 0xffff0000u), __uint_as_float(y.w << 16), __uint_as_float(y.w & 0xffff0000u)};
      float ss = 0.f;
#pragma unroll
      for (int i = 0; i < 8; ++i) ss += v[i] * v[i];
      const float rs = rsqrtf(wave_sum(ss) * (1.0f / 512.0f) + EPS);
      const f32x4 g0 = *(const f32x4*)(g_c + 8 * lane), g1 = *(const f32x4*)(g_c + 8 * lane + 4);
      u32x4 w; w.x = pk2(v[0] * rs * g0.x, v[1] * rs * g0.y); w.y = pk2(v[2] * rs * g0.z, v[3] * rs * g0.w); w.z = pk2(v[4] * rs * g1.x, v[5] * rs * g1.y); w.w = pk2(v[6] * rs * g1.z, v[7] * rs * g1.w);
      *(u32x4*)(mx + 512 + 8 * lane) = w; }
}
__device__ __forceinline__ pg8::MoeMap moe_map_setup(Frame& F, int rank, int& ntiles) {
    volatile LAS int* tp = (volatile LAS int*)(F.MISC + 16);
    __syncthreads();
    if (F.tid < 8) tp[9 + F.tid] = (int)__hip_atomic_load(F.ctl + CW_CNT + 64 * (rank * 8 + F.tid), RLX_AGENT);
    __syncthreads();
    if (F.tid == 0) { int acc = 0; for (int e = 0; e < 8; ++e) { tp[e] = acc; acc += (tp[9 + e] + 255) >> 8; } tp[8] = acc; }
    __syncthreads();
    ntiles = tp[8];
    pg8::MoeMap mm; mm.tp = (const LAS int*)(F.lds + MISC_OFF + 64); return mm;
}

namespace att {
constexpr int DQK = 96, DV = 64, NW = 8, QBLK = 32, KVBLK = 64, LDQ = 96, LDK = 96, LDV = 64;
constexpr float SCALE = 0.10206207261596575f;
constexpr float QSCALE = SCALE * 1.4426950408889634f;
constexpr size_t SHM_V = 16384, SHM_K = 16384, SHM_ATTN = 2 * SHM_V + 2 * SHM_K + NW * 64 * 4;
using s16x4 = __attribute__((ext_vector_type(4))) short;
#define KSWZ(row, colB) ((row) * 256 + ((colB) ^ (((row) & 7) << 4)))
#define SBAR() __builtin_amdgcn_sched_barrier(0)
__device__ __forceinline__ int crow(int r, int hi) { return (r & 3) + 8 * (r >> 2) + 4 * hi; }
__device__ __forceinline__ unsigned cvtpk(float lo, float hi) { unsigned r; asm volatile("v_cvt_pk_bf16_f32 %0, %1, %2" : "=v"(r) : "v"(lo), "v"(hi)); return r; }
template <bool SHIFT> __device__ __forceinline__ void expsum(f32x16& p0, f32x16& p1, float& l_reg, float negM) {
  float ps = 0;
#pragma unroll
  for (int r = 0; r < 16; ++r) { p0[r] = __builtin_amdgcn_exp2f(SHIFT ? p0[r] + negM : p0[r]); ps += p0[r]; }
#pragma unroll
  for (int r = 0; r < 16; ++r) { p1[r] = __builtin_amdgcn_exp2f(SHIFT ? p1[r] + negM : p1[r]); ps += p1[r]; }
  l_reg += ps;
}
__device__ __forceinline__ void packP(const f32x16& p0, const f32x16& p1, bf16x8& pa0, bf16x8& pa1, bf16x8& pa2, bf16x8& pa3) {
#define PK4(P, BASE, OUT) do { unsigned a0 = cvtpk(P[BASE + 0], P[BASE + 1]), a1 = cvtpk(P[BASE + 2], P[BASE + 3]);   \
    unsigned b0 = cvtpk(P[BASE + 4], P[BASE + 5]), b1 = cvtpk(P[BASE + 6], P[BASE + 7]);                              \
    auto r0 = __builtin_amdgcn_permlane32_swap(a0, b0, false, false); auto r1 = __builtin_amdgcn_permlane32_swap(a1, b1, false, false); \
    u32x4 w = {r0[0], r1[0], r0[1], r1[1]}; OUT = *reinterpret_cast<bf16x8*>(&w); } while (0)
  PK4(p0, 0, pa0); PK4(p0, 8, pa1); PK4(p1, 0, pa2); PK4(p1, 8, pa3);
#undef PK4
}
__device__ __forceinline__ void qkt(f32x16& p0, f32x16& p1, const char* Ks, const bf16x8* qr, int r32, int hi) {
  p0 = f32x16{}; p1 = f32x16{};
#pragma unroll
  for (int d0 = 0; d0 < 6; ++d0) { int cb = (d0 * 16 + hi * 8) * 2;
    bf16x8 b0 = *reinterpret_cast<const bf16x8*>(Ks + KSWZ(r32, cb));
    bf16x8 b1 = *reinterpret_cast<const bf16x8*>(Ks + KSWZ(32 + r32, cb));
    p0 = __builtin_amdgcn_mfma_f32_32x32x16_bf16(b0, qr[d0], p0, 0, 0, 0);
    p1 = __builtin_amdgcn_mfma_f32_32x32x16_bf16(b1, qr[d0], p1, 0, 0, 0); }
}
__device__ __forceinline__ int v_st(int k, int c) { const int kk = (k & ~0xC) | ((k & 4) << 1) | ((k & 8) >> 1); return ((kk >> 3) * 4 + (c >> 5)) * 512 + ((kk & 7) * 32 + (c & 31)) * 2; }
__device__ __forceinline__ int v_rd_base(int lane) { return ((lane & 3) << 3) | (((lane >> 2) & 3) << 6) | (((lane >> 4) & 1) << 5) | (((lane >> 5) & 1) << 8); }
constexpr int v_rd_off(int d0, int ks, int half) { return d0 * 512 + ks * 4096 + half * 2048; }
template <int OFF> __device__ __forceinline__ s16x4 tr_read(int vb) {
  s16x4 r; asm volatile("ds_read_b64_tr_b16 %0, %1 offset:%2" : "=&v"(r) : "v"(vb), "i"(OFF) : "memory"); return r;
}
template <int D0> __device__ __forceinline__ void pv_one(f32x16& od, int vb, bf16x8 pa0, bf16x8 pa1, bf16x8 pa2, bf16x8 pa3) {
  const s16x4 l0 = tr_read<v_rd_off(D0, 0, 0)>(vb), h0 = tr_read<v_rd_off(D0, 0, 1)>(vb), l1 = tr_read<v_rd_off(D0, 1, 0)>(vb), h1 = tr_read<v_rd_off(D0, 1, 1)>(vb);
  const s16x4 l2 = tr_read<v_rd_off(D0, 2, 0)>(vb), h2 = tr_read<v_rd_off(D0, 2, 1)>(vb), l3 = tr_read<v_rd_off(D0, 3, 0)>(vb), h3 = tr_read<v_rd_off(D0, 3, 1)>(vb);
  asm volatile("s_waitcnt lgkmcnt(0)" ::: "memory"); SBAR();
#define PK(L, H) (bf16x8){L[0], L[1], L[2], L[3], H[0], H[1], H[2], H[3]}
  od = __builtin_amdgcn_mfma_f32_32x32x16_bf16(pa0, PK(l0, h0), od, 0, 0, 0);
  od = __builtin_amdgcn_mfma_f32_32x32x16_bf16(pa1, PK(l1, h1), od, 0, 0, 0);
  od = __builtin_amdgcn_mfma_f32_32x32x16_bf16(pa2, PK(l2, h2), od, 0, 0, 0);
  od = __builtin_amdgcn_mfma_f32_32x32x16_bf16(pa3, PK(l3, h3), od, 0, 0, 0);
#undef PK
}
__device__ __forceinline__ void pv_d0(f32x16* o, int vb, bf16x8 pa0, bf16x8 pa1, bf16x8 pa2, bf16x8 pa3) {
  pv_one<0>(o[0], vb, pa0, pa1, pa2, pa3); pv_one<1>(o[1], vb, pa0, pa1, pa2, pa3);
}
__device__ __forceinline__ unsigned cvtpk_s(float lo, float hi) { unsigned r; asm("v_cvt_pk_bf16_f32 %0, %1, %2" : "=v"(r) : "v"(lo), "v"(hi)); return r; }
template <bool SHIFT> __device__ __forceinline__ void exp_chunk(f32x16& p, int lo, int hi, float& ps, float negM) {
#pragma unroll
  for (int r = 0; r < 16; ++r) if (r >= lo && r < hi) { p[r] = __builtin_amdgcn_exp2f(SHIFT ? p[r] + negM : p[r]); ps += p[r]; }
}
__device__ __forceinline__ bf16x8 pack8(const f32x16& P, int base) {
  const unsigned a0 = cvtpk_s(P[base + 0], P[base + 1]), a1 = cvtpk_s(P[base + 2], P[base + 3]), b0 = cvtpk_s(P[base + 4], P[base + 5]), b1 = cvtpk_s(P[base + 6], P[base + 7]);
  auto r0 = __builtin_amdgcn_permlane32_swap(a0, b0, false, false); auto r1 = __builtin_amdgcn_permlane32_swap(a1, b1, false, false);
  u32x4 w = {r0[0], r1[0], r0[1], r1[1]}; return *reinterpret_cast<bf16x8*>(&w);
}
template <bool SHIFT, bool QK, bool PV> __device__ __forceinline__ void pipe_iter(f32x16 (&sn)[2], f32x16 (&sc)[2], const bf16x8 (&pp)[4], bf16x8 (&pn)[4], f32x16* o, const char* Kn, int vbp,
                                                                                   const bf16x8* qr, int r32, int hi, float& l_reg, float negM) {
  float ps = 0.f;
  if constexpr (QK) {
    sn[0] = f32x16{}; sn[1] = f32x16{};
#pragma unroll
    for (int d0 = 0; d0 < 6; ++d0) { const int cb = (d0 * 16 + hi * 8) * 2;
      const bf16x8 kb0 = *reinterpret_cast<const bf16x8*>(Kn + KSWZ(r32, cb)), kb1 = *reinterpret_cast<const bf16x8*>(Kn + KSWZ(32 + r32, cb));
      sn[0] = __builtin_amdgcn_mfma_f32_32x32x16_bf16(kb0, qr[d0], sn[0], 0, 0, 0);
      sn[1] = __builtin_amdgcn_mfma_f32_32x32x16_bf16(kb1, qr[d0], sn[1], 0, 0, 0);
      if (d0 < 3) exp_chunk<SHIFT>(sc[0], d0 == 0 ? 0 : (d0 == 1 ? 6 : 11), d0 == 0 ? 6 : (d0 == 1 ? 11 : 16), ps, negM);
      else        exp_chunk<SHIFT>(sc[1], d0 == 3 ? 0 : (d0 == 4 ? 6 : 11), d0 == 3 ? 6 : (d0 == 4 ? 11 : 16), ps, negM);
      SBAR();
    }
  } else { exp_chunk<SHIFT>(sc[0], 0, 16, ps, negM); exp_chunk<SHIFT>(sc[1], 0, 16, ps, negM); }
  l_reg += ps;
  if constexpr (PV) {
#define PK(L, H) (bf16x8){L[0], L[1], L[2], L[3], H[0], H[1], H[2], H[3]}
    { const s16x4 l0 = tr_read<v_rd_off(0, 0, 0)>(vbp), h0 = tr_read<v_rd_off(0, 0, 1)>(vbp), l1 = tr_read<v_rd_off(0, 1, 0)>(vbp), h1 = tr_read<v_rd_off(0, 1, 1)>(vbp);
      const s16x4 l2 = tr_read<v_rd_off(0, 2, 0)>(vbp), h2 = tr_read<v_rd_off(0, 2, 1)>(vbp), l3 = tr_read<v_rd_off(0, 3, 0)>(vbp), h3 = tr_read<v_rd_off(0, 3, 1)>(vbp);
      asm volatile("s_waitcnt lgkmcnt(0)" ::: "memory"); SBAR();
      o[0] = __builtin_amdgcn_mfma_f32_32x32x16_bf16(pp[0], PK(l0, h0), o[0], 0, 0, 0);
      o[0] = __builtin_amdgcn_mfma_f32_32x32x16_bf16(pp[1], PK(l1, h1), o[0], 0, 0, 0);
      pn[0] = pack8(sc[0], 0); SBAR();
      o[0] = __builtin_amdgcn_mfma_f32_32x32x16_bf16(pp[2], PK(l2, h2), o[0], 0, 0, 0);
      o[0] = __builtin_amdgcn_mfma_f32_32x32x16_bf16(pp[3], PK(l3, h3), o[0], 0, 0, 0);
      pn[1] = pack8(sc[0], 8); SBAR(); }
    { const s16x4 l0 = tr_read<v_rd_off(1, 0, 0)>(vbp), h0 = tr_read<v_rd_off(1, 0, 1)>(vbp), l1 = tr_read<v_rd_off(1, 1, 0)>(vbp), h1 = tr_read<v_rd_off(1, 1, 1)>(vbp);
      const s16x4 l2 = tr_read<v_rd_off(1, 2, 0)>(vbp), h2 = tr_read<v_rd_off(1, 2, 1)>(vbp), l3 = tr_read<v_rd_off(1, 3, 0)>(vbp), h3 = tr_read<v_rd_off(1, 3, 1)>(vbp);
      asm volatile("s_waitcnt lgkmcnt(0)" ::: "memory"); SBAR();
      o[1] = __builtin_amdgcn_mfma_f32_32x32x16_bf16(pp[0], PK(l0, h0), o[1], 0, 0, 0);
      o[1] = __builtin_amdgcn_mfma_f32_32x32x16_bf16(pp[1], PK(l1, h1), o[1], 0, 0, 0);
      pn[2] = pack8(sc[1], 0); SBAR();
      o[1] = __builtin_amdgcn_mfma_f32_32x32x16_bf16(pp[2], PK(l2, h2), o[1], 0, 0, 0);
      o[1] = __builtin_amdgcn_mfma_f32_32x32x16_bf16(pp[3], PK(l3, h3), o[1], 0, 0, 0);
      pn[3] = pack8(sc[1], 8); SBAR(); }
#undef PK
  } else { pn[0] = pack8(sc[0], 0); pn[1] = pack8(sc[0], 8); pn[2] = pack8(sc[1], 0); pn[3] = pack8(sc[1], 8); }
}
template <bool SHIFT> __device__ __forceinline__ void attn_unit(const bf16_t* __restrict__ Qb, const bf16_t* __restrict__ Kh, const bf16_t* __restrict__ Vh, bf16_t* __restrict__ Ob, int ldo, int seq, float negM, char* lds, int wv) {
  const int tid = launder(tid_of(wv)), wid = tid >> 6, lane = tid & 63, r32 = lane & 31, hi = lane >> 5;
  if (__builtin_amdgcn_readfirstlane(wid) >= 4) __builtin_amdgcn_s_setprio(1);
  char* V_lds = lds; char* K_lds = lds + 2 * SHM_V;
  float l_reg = 0; f32x16 o[2] = {}; bf16x8 qr[6];
  const bf16_t* Qw = Qb + (long)(wid * QBLK + r32) * LDQ + hi * 8;
#pragma unroll
  for (int d0 = 0; d0 < 6; ++d0) qr[d0] = *reinterpret_cast<const bf16x8*>(Qw + d0 * 16);
  const int sr = tid >> 4, sc = (tid & 15) * 8, vst0 = v_st(sr, sc & 63), vst1 = v_st(32 + sr, sc & 63);
  const bool kact = sc < DQK, vact = sc < DV;
  const int vb0 = (int)(uintptr_t)V_lds + v_rd_base(lane);
  const int NT = seq / KVBLK;
  struct { bf16x8 vs0, vs1, ks0, ks1; } sr_[2];
#define SLOAD(i, kt, vt) do { const int _k0 = ((kt) < NT ? (kt) : NT - 1) * KVBLK, _v0 = ((vt) < NT ? (vt) : NT - 1) * KVBLK; \
    if (vact) { sr_[i].vs0 = *reinterpret_cast<const bf16x8*>(&Vh[(long)(_v0 + sr) * LDV + sc]); sr_[i].vs1 = *reinterpret_cast<const bf16x8*>(&Vh[(long)(_v0 + 32 + sr) * LDV + sc]); } \
    if (kact) { sr_[i].ks0 = *reinterpret_cast<const bf16x8*>(&Kh[(long)(_k0 + sr) * LDK + sc]); sr_[i].ks1 = *reinterpret_cast<const bf16x8*>(&Kh[(long)(_k0 + 32 + sr) * LDK + sc]); } } while (0)
#define SWRITE_K(b, i) do { if (kact) { int kc = sc * 2; *(bf16x8*)(K_lds + (b) * SHM_K + KSWZ(sr, kc)) = sr_[i].ks0; *(bf16x8*)(K_lds + (b) * SHM_K + KSWZ(32 + sr, kc)) = sr_[i].ks1; } } while (0)
#define SWRITE_V(b, i) do { if (vact) { *(bf16x8*)(V_lds + (b) * SHM_V + vst0) = sr_[i].vs0; *(bf16x8*)(V_lds + (b) * SHM_V + vst1) = sr_[i].vs1; } } while (0)
#define SWAIT() asm volatile("s_waitcnt vmcnt(0)" ::: "memory")
  f32x16 sA[2], sB[2]; bf16x8 pX[4], pY[4];
  SLOAD(0, 0, 0); SLOAD(1, 1, 1); asm volatile("s_waitcnt vmcnt(0)" ::: "memory"); SWRITE_K(0, 0); SWRITE_V(0, 0); SWRITE_K(1, 1);
  __syncthreads();
  { sA[0] = f32x16{}; sA[1] = f32x16{};
#pragma unroll
    for (int d0 = 0; d0 < 6; ++d0) { const int cb = (d0 * 16 + hi * 8) * 2;
      const bf16x8 b0 = *reinterpret_cast<const bf16x8*>(K_lds + KSWZ(r32, cb)), b1 = *reinterpret_cast<const bf16x8*>(K_lds + KSWZ(32 + r32, cb));
      sA[0] = __builtin_amdgcn_mfma_f32_32x32x16_bf16(b0, qr[d0], sA[0], 0, 0, 0); sA[1] = __builtin_amdgcn_mfma_f32_32x32x16_bf16(b1, qr[d0], sA[1], 0, 0, 0); } }
  SLOAD(0, 2, 1); SBAR(); pipe_iter<SHIFT, true, false>(sB, sA, pY, pX, o, K_lds + SHM_K, 0, qr, r32, hi, l_reg, negM); SBAR();
  __syncthreads(); SWAIT(); SWRITE_K(0, 0); SWRITE_V(1, 0); __syncthreads();
  for (int t = 1; t + 1 < NT; t += 2) {
    SLOAD(0, t + 2, t + 1); SBAR(); pipe_iter<SHIFT, true, true>(sA, sB, pX, pY, o, K_lds, vb0, qr, r32, hi, l_reg, negM); SBAR();
    SWAIT(); SWRITE_K(1, 0); __syncthreads(); SWRITE_V(0, 0);
    SLOAD(0, t + 3, t + 2); SBAR(); pipe_iter<SHIFT, true, true>(sB, sA, pY, pX, o, K_lds + SHM_K, vb0 + (int)SHM_V, qr, r32, hi, l_reg, negM); SBAR();
    SWAIT(); SWRITE_K(0, 0); __syncthreads(); SWRITE_V(1, 0);
  }
  __syncthreads();
  SBAR(); pipe_iter<SHIFT, false, true>(sA, sB, pX, pY, o, K_lds, vb0, qr, r32, hi, l_reg, negM);
  pv_d0(o, vb0 + (int)SHM_V, pY[0], pY[1], pY[2], pY[3]);
  { auto rr = __builtin_amdgcn_permlane32_swap(__float_as_uint(l_reg), __float_as_uint(l_reg), false, false); l_reg = __uint_as_float(rr[0]) + __uint_as_float(rr[1]); }
  float* li_l = (float*)(lds + 2 * SHM_V + 2 * SHM_K) + wv * 64;
  if (hi == 0) li_l[r32] = l_reg; asm volatile("s_waitcnt lgkmcnt(0)" ::: "memory");
  float rli[16];
#pragma unroll
  for (int r = 0; r < 16; ++r) rli[r] = __builtin_amdgcn_rcpf(li_l[crow(r, hi)]);
  bf16_t* Ow = Ob + (long)(wv * QBLK) * ldo;
#pragma unroll
  for (int r = 0; r < 16; ++r) { int orow = crow(r, hi);
#pragma unroll
    for (int d0 = 0; d0 < 2; ++d0) Ow[(long)orow * ldo + d0 * 32 + r32] = (bf16_t)f2bf(o[d0][r] * rli[r]); }
  __builtin_amdgcn_s_setprio(0);
  __syncthreads();
#undef SLOAD
#undef SWRITE_K
#undef SWRITE_V
#undef SWAIT
}
#undef KSWZ
#undef SBAR
}
namespace mla {
__device__ __forceinline__ int crow(int r, int hi) { return (r & 3) + 8 * (r >> 2) + 4 * hi; }
__device__ __forceinline__ float half_swap_sum(float v) { auto rr = __builtin_amdgcn_permlane32_swap(__float_as_uint(v), __float_as_uint(v), false, false); return __uint_as_float(rr[0]) + __uint_as_float(rr[1]); }
__device__ __forceinline__ float sumsq8(bf16x8 v) { float s = 0.f;
#pragma unroll
    for (int j = 0; j < 8; ++j) { const float f = bf2f((bf16_t)v[j]); s += f * f; } return s; }
__device__ __forceinline__ unsigned pk2rne(float lo, float hi) { unsigned r; asm volatile("v_cvt_pk_bf16_f32 %0, %1, %2" : "=v"(r) : "v"(lo), "v"(hi)); return r; }
__device__ __forceinline__ void store_blk(bf16_t* p  , const float (&v)[16]) {
#pragma unroll
    for (int q4 = 0; q4 < 4; ++q4) { u32x2 w; w.x = pk2rne(v[4 * q4], v[4 * q4 + 1]); w.y = pk2rne(v[4 * q4 + 2], v[4 * q4 + 3]); *(u32x2*)(p + 8 * q4) = w; }
}
__device__ __forceinline__ void rope_regs(float (&v)[16], const float (&cs)[8], const float (&sn)[8]) {
#pragma unroll
    for (int r = 0; r < 8; ++r) { const float x1 = v[r], x2 = v[r + 8]; v[r] = x1 * cs[r] - x2 * sn[r]; v[r + 8] = x2 * cs[r] + x1 * sn[r]; }
}
constexpr int QP = 528, KP = 272, L_WQ = 0, L_WKV = 96 * QP, L_END = L_WKV + 128 * KP, L_CS = L_END;
__device__ __forceinline__ void stage_load(int hd, int tid, const bf16_t* Wuq_t, const bf16_t* Wukv_t, u32x4 (&pq)[6], u32x4 (&pk)[4]) {
#pragma unroll
    for (int i = 0; i < 6; ++i) { const int id = tid + 512 * i; pq[i] = *(const u32x4*)(Wuq_t + (size_t)(hd * 96 + (id >> 5)) * 256 + (id & 31) * 8); }
#pragma unroll
    for (int i = 0; i < 4; ++i) { const int id = tid + 512 * i; pk[i] = *(const u32x4*)(Wukv_t + (size_t)(hd * 128 + (id >> 4)) * 128 + (id & 15) * 8); }
}
__device__ __forceinline__ void stage_store(int tid, const u32x4 (&pq)[6], const u32x4 (&pk)[4], char* lds) {
#pragma unroll
    for (int i = 0; i < 6; ++i) { const int id = tid + 512 * i; *(u32x4*)(lds + L_WQ + (id >> 5) * QP + (id & 31) * 16) = pq[i]; }
#pragma unroll
    for (int i = 0; i < 4; ++i) { const int id = tid + 512 * i; *(u32x4*)(lds + L_WKV + (id >> 4) * KP + (id & 15) * 16) = pk[i]; }
}
__device__ __forceinline__ void q_path(int tid, int tok, int r32, int hi, const bf16_t* pr, const bf16_t* Wuq_t, const bf16_t* Wukv_t, const float* gq, bf16_t* Qo, char* lds) {
    bf16x8 xt[16]; float ss = 0.f;
#pragma unroll
    for (int s = 0; s < 16; ++s) { xt[s] = *(const bf16x8*)(pr + C_CQ + 16 * s + 8 * hi); ss += sumsq8(xt[s]); }
    const float rs_in = rsqrtf(half_swap_sum(ss) * (1.0f / 256.0f) + EPS);
    u32x4 pq[6], pk[4]; stage_load(0, tid, Wuq_t, Wukv_t, pq, pk);
#pragma unroll 1
    for (int hd = 0; hd < 8; ++hd) {
        lds_barrier(); stage_store(tid, pq, pk, lds); lds_barrier(); if (hd < 7) stage_load(hd + 1, tid, Wuq_t, Wukv_t, pq, pk);
        f32x16 acc[3];
#pragma unroll
        for (int cb = 0; cb < 3; ++cb) { acc[cb] = f32x16{};
            const char* wrow = lds + L_WQ + (cb * 32 + r32) * QP + 16 * hi;
#pragma unroll
            for (int s = 0; s < 16; ++s) { const bf16x8 wf = *(const bf16x8*)(wrow + 32 * s); acc[cb] = __builtin_amdgcn_mfma_f32_32x32x16_bf16(wf, xt[s], acc[cb], 0, 0, 0); } }
        float ss2 = 0.f;
#pragma unroll
        for (int cb = 0; cb < 3; ++cb)
#pragma unroll
            for (int r = 0; r < 16; ++r) { acc[cb][r] *= rs_in; ss2 += acc[cb][r] * acc[cb][r]; }
        const float r2 = rsqrtf(half_swap_sum(ss2) * (1.0f / 96.0f) + EPS) * att::QSCALE;
        bf16_t* qrow = Qo + ((size_t)((tok >> 11) * 8 + hd) * SEQ + (tok & (SEQ - 1))) * 96 + 4 * hi;
#pragma unroll
        for (int cb = 0; cb < 3; ++cb) { float v[16];
#pragma unroll
            for (int q4 = 0; q4 < 4; ++q4) { const f32x4 g = *(const f32x4*)(gq + cb * 32 + 8 * q4 + 4 * hi);
                v[4 * q4] = acc[cb][4 * q4] * r2 * g.x; v[4 * q4 + 1] = acc[cb][4 * q4 + 1] * r2 * g.y; v[4 * q4 + 2] = acc[cb][4 * q4 + 2] * r2 * g.z; v[4 * q4 + 3] = acc[cb][4 * q4 + 3] * r2 * g.w; }
            if (cb == 2) { float cs[8], sn[8]; { const f32x4* cp = (const f32x4*)(lds + L_CS + tid * 64); const f32x4 c0 = cp[0], c1 = cp[1], s0 = cp[2], s1 = cp[3];
                cs[0] = c0.x; cs[1] = c0.y; cs[2] = c0.z; cs[3] = c0.w; cs[4] = c1.x; cs[5] = c1.y; cs[6] = c1.z; cs[7] = c1.w; sn[0] = s0.x; sn[1] = s0.y; sn[2] = s0.z; sn[3] = s0.w; sn[4] = s1.x; sn[5] = s1.y; sn[6] = s1.z; sn[7] = s1.w; }
                rope_regs(v, cs, sn); }
            store_blk(qrow + cb * 32, v); }
    }
}
__device__ __forceinline__ void kv_path(int tid, int tok, int r32, int hi, const bf16_t* pr, const bf16_t* Wuq_t, const bf16_t* Wukv_t, const float* gk, bf16_t* Ko, bf16_t* Vo, char* lds) {
    bf16x8 xt[8]; float ss = 0.f;
#pragma unroll
    for (int s = 0; s < 8; ++s) { xt[s] = *(const bf16x8*)(pr + C_CKV + 16 * s + 8 * hi); ss += sumsq8(xt[s]); }
    const float rs_in = rsqrtf(half_swap_sum(ss) * (1.0f / 128.0f) + EPS);
    float kr[16], sskr = 0.f;
#pragma unroll
    for (int q4 = 0; q4 < 4; ++q4) { const u32x2 w = *(const u32x2*)(pr + C_KR + 8 * q4 + 4 * hi);
        kr[4 * q4] = __uint_as_float(w.x << 16); kr[4 * q4 + 1] = __uint_as_float(w.x & 0xffff0000u); kr[4 * q4 + 2] = __uint_as_float(w.y << 16); kr[4 * q4 + 3] = __uint_as_float(w.y & 0xffff0000u); }
#pragma unroll
    for (int r = 0; r < 16; ++r) sskr += kr[r] * kr[r];
    u32x4 pq[6], pk[4]; stage_load(0, tid, Wuq_t, Wukv_t, pq, pk);
#pragma unroll 1
    for (int hd = 0; hd < 8; ++hd) {
        lds_barrier(); stage_store(tid, pq, pk, lds); lds_barrier(); if (hd < 7) stage_load(hd + 1, tid, Wuq_t, Wukv_t, pq, pk);
        f32x16 acc[4];
#pragma unroll
        for (int cb = 0; cb < 4; ++cb) { acc[cb] = f32x16{};
            const char* wrow = lds + L_WKV + (cb * 32 + r32) * KP + 16 * hi;
#pragma unroll
            for (int s = 0; s < 8; ++s) { const bf16x8 wf = *(const bf16x8*)(wrow + 32 * s); acc[cb] = __builtin_amdgcn_mfma_f32_32x32x16_bf16(wf, xt[s], acc[cb], 0, 0, 0); } }
        float ssk = sskr;
#pragma unroll
        for (int cb = 0; cb < 4; ++cb)
#pragma unroll
            for (int r = 0; r < 16; ++r) { acc[cb][r] *= rs_in; if (cb < 2) ssk += acc[cb][r] * acc[cb][r]; }
        const float rk = rsqrtf(half_swap_sum(ssk) * (1.0f / 96.0f) + EPS);
        bf16_t* krow = Ko + ((size_t)((tok >> 11) * 8 + hd) * SEQ + (tok & (SEQ - 1))) * 96 + 4 * hi; bf16_t* vrow = Vo + ((size_t)((tok >> 11) * 8 + hd) * SEQ + (tok & (SEQ - 1))) * 64 + 4 * hi;
#pragma unroll
        for (int cb = 0; cb < 3; ++cb) { float v[16];
#pragma unroll
            for (int q4 = 0; q4 < 4; ++q4) { const f32x4 g = *(const f32x4*)(gk + cb * 32 + 8 * q4 + 4 * hi);
#pragma unroll
                for (int c = 0; c < 4; ++c) { const float x = (cb < 2) ? acc[cb < 2 ? cb : 0][4 * q4 + c] : kr[4 * q4 + c]; v[4 * q4 + c] = x * rk * g[c]; } }
            if (cb == 2) { float cs[8], sn[8]; { const f32x4* cp = (const f32x4*)(lds + L_CS + tid * 64); const f32x4 c0 = cp[0], c1 = cp[1], s0 = cp[2], s1 = cp[3];
                cs[0] = c0.x; cs[1] = c0.y; cs[2] = c0.z; cs[3] = c0.w; cs[4] = c1.x; cs[5] = c1.y; cs[6] = c1.z; cs[7] = c1.w; sn[0] = s0.x; sn[1] = s0.y; sn[2] = s0.z; sn[3] = s0.w; sn[4] = s1.x; sn[5] = s1.y; sn[6] = s1.z; sn[7] = s1.w; }
                rope_regs(v, cs, sn); }
            store_blk(krow + cb * 32, v); }
#pragma unroll
        for (int cb = 2; cb < 4; ++cb) { float v[16];
#pragma unroll
            for (int r = 0; r < 16; ++r) v[r] = acc[cb][r];
            store_blk(vrow + (cb - 2) * 32, v); }
    }
}
__device__ __forceinline__ void block_item(int blk, const bf16_t* PROJ, const int* positions, const bf16_t* Wuq_t, const bf16_t* Wukv_t, const float* gq, const float* gk, bf16_t* Qo, bf16_t* Ko, bf16_t* Vo, char* lds, int wv) {
    const int tid = launder(tid_of(wv)), wave = tid >> 6, lane = tid & 63, r32 = lane & 31, hi = lane >> 5;
    const int tile = blk * 4 + (wave & 3), tok = tile * 32 + r32;
    const bf16_t* pr = PROJ + (size_t)tok * DINP;
    { float cs[8], sn[8]; const int pos = positions[tok];
#pragma unroll
      for (int r = 0; r < 8; ++r) rope_cs(pos, crow(r, hi), cs[r], sn[r]);
      f32x4* cp = (f32x4*)(lds + L_CS + tid * 64);
      cp[0] = (f32x4){cs[0], cs[1], cs[2], cs[3]}; cp[1] = (f32x4){cs[4], cs[5], cs[6], cs[7]}; cp[2] = (f32x4){sn[0], sn[1], sn[2], sn[3]}; cp[3] = (f32x4){sn[4], sn[5], sn[6], sn[7]}; }
    if (wave < 4) q_path(tid, tok, r32, hi, pr, Wuq_t, Wukv_t, gq, Qo, lds);
    else kv_path(tid, tok, r32, hi, pr, Wuq_t, Wukv_t, gk, Ko, Vo, lds);
    __syncthreads();
}
}
namespace lru {
constexpr int XA_PITCH = 144, XA_BYTES = 5120;
constexpr int LDS_XA = 0, LDS_CW = 8 * XA_BYTES, LDS_TS = LDS_CW + 5 * 64 * 4, LDS_END = LDS_TS + 2 * 8 * 2 * 64 * 4;
__device__ __forceinline__ int crow(int r, int hi) { return (r & 3) + 8 * (r >> 2) + 4 * hi; }
__device__ __forceinline__ float bcast_half(float v, int src_lane) { return lane_bcast(v, src_lane); }
__device__ __forceinline__ void unit(int un, int l, const bf16_t* PROJ, const float* conv_w, const float* conv_b, const float* lru_wa, const float* lru_ba, const float* lru_wx, const float* lru_bx,
                                     const float* lru_lam, bf16_t* DIRS, char* lds, int wv) {
    const int tid = launder(tid_of(wv)), wave = tid >> 6, lane = tid & 63, r32 = lane & 31, hi = lane >> 5;
    const int dir = un & 1, n = (un >> 1) & 3, b = un >> 3;
    char* xa = lds + LDS_XA + wave * XA_BYTES; float* CW = (float*)(lds + LDS_CW); float* TS = (float*)(lds + LDS_TS);
    __syncthreads();
    if (tid < 320) { const int k = tid >> 6, c = tid & 63; CW[k * 64 + c] = (k < 4) ? conv_w[(l * 4 + k) * 256 + n * 64 + c] : conv_b[l * 256 + n * 64 + c]; }
    bf16x8 wf[2][2][4];
    { const size_t wbase = (size_t)((l * 2 + dir) * 4 + n) * 4096;
#pragma unroll
      for (int g = 0; g < 2; ++g) { const float* W = (g == 0 ? lru_wa : lru_wx) + wbase;
#pragma unroll
        for (int ob = 0; ob < 2; ++ob)
#pragma unroll
          for (int s4 = 0; s4 < 4; ++s4) { u32x4 pk;
#pragma unroll
            for (int jj = 0; jj < 4; ++jj) { const int c0 = 16 * s4 + 8 * hi + 2 * jj; pk[jj] = pk2(W[(size_t)c0 * 64 + 32 * ob + r32], W[(size_t)(c0 + 1) * 64 + 32 * ob + r32]); }
            wf[g][ob][s4] = *reinterpret_cast<bf16x8*>(&pk); } } }
    float ba[2], bx[2], sp8[2], RC[2];
#pragma unroll
    for (int ob = 0; ob < 2; ++ob) { const int ch = (l * 2 + dir) * 256 + n * 64 + 32 * ob + r32; ba[ob] = lru_ba[ch]; bx[ob] = lru_bx[ch]; sp8[ob] = -8.0f * log1pf(__expf(-lru_lam[ch])); RC[ob] = 0.f; }
    __syncthreads();
    const size_t rowb = (size_t)b * SEQ;
    u32x4 pre[5];
#define LRU_XLOAD(rr) do { const int s0_ = (rr) * 256 + wave * 32; const int tmin_ = dir ? (SEQ - 1 - s0_ - 31) : s0_; \
        _Pragma("unroll") for (int i = 0; i < 5; ++i) { const int cidx = lane + 64 * i; const int j = cidx >> 3, ck = cidx & 7, t = tmin_ - 2 + j; \
            pre[i] = (u32x4){0u, 0u, 0u, 0u}; if (cidx < 280 && t >= 0 && t < SEQ) pre[i] = *(const u32x4*)(PROJ + (rowb + t) * DINP + C_XA + n * 64 + ck * 8); } } while (0)
    LRU_XLOAD(0);
    for (int rho = 0; rho < 8; ++rho) {
        const int s0 = rho * 256 + wave * 32;
#pragma unroll
        for (int i = 0; i < 5; ++i) { const int cidx = lane + 64 * i; if (cidx < 280) { const int j = cidx >> 3, ck = cidx & 7; *(u32x4*)(xa + j * XA_PITCH + ck * 16) = pre[i]; } }
        asm volatile("s_waitcnt lgkmcnt(0)" ::: "memory");
        if (rho + 1 < 8) LRU_XLOAD(rho + 1);
        bf16x8 xcA[4];
        { const int jb = dir ? 31 - r32 : r32;
#pragma unroll
          for (int s4 = 0; s4 < 4; ++s4) { const int c0 = 16 * s4 + 8 * hi; float acc8[8];
            { const f32x4 b0 = *(const f32x4*)(CW + 4 * 64 + c0), b1 = *(const f32x4*)(CW + 4 * 64 + c0 + 4); acc8[0] = b0.x; acc8[1] = b0.y; acc8[2] = b0.z; acc8[3] = b0.w; acc8[4] = b1.x; acc8[5] = b1.y; acc8[6] = b1.z; acc8[7] = b1.w; }
#pragma unroll
            for (int k = 0; k < 4; ++k) { const u32x4 xv = *(const u32x4*)(xa + (jb + k) * XA_PITCH + c0 * 2);
                const f32x4 w0 = *(const f32x4*)(CW + k * 64 + c0), w1 = *(const f32x4*)(CW + k * 64 + c0 + 4);
                acc8[0] += w0.x * __uint_as_float(xv.x << 16); acc8[1] += w0.y * __uint_as_float(xv.x & 0xffff0000u); acc8[2] += w0.z * __uint_as_float(xv.y << 16); acc8[3] += w0.w * __uint_as_float(xv.y & 0xffff0000u);
                acc8[4] += w1.x * __uint_as_float(xv.z << 16); acc8[5] += w1.y * __uint_as_float(xv.z & 0xffff0000u); acc8[6] += w1.z * __uint_as_float(xv.w << 16); acc8[7] += w1.w * __uint_as_float(xv.w & 0xffff0000u); }
            u32x4 pk; pk.x = pk2(acc8[0], acc8[1]); pk.y = pk2(acc8[2], acc8[3]); pk.z = pk2(acc8[4], acc8[5]); pk.w = pk2(acc8[6], acc8[7]);
            xcA[s4] = *reinterpret_cast<bf16x8*>(&pk); } }
        float P[2][16], Q[2][16];
        float Atile[2], Utile[2];
#pragma unroll
        for (int ob = 0; ob < 2; ++ob) {
            f32x16 ga = f32x16{}, gx = f32x16{};
#pragma unroll
            for (int s4 = 0; s4 < 4; ++s4) { ga = __builtin_amdgcn_mfma_f32_32x32x16_bf16(xcA[s4], wf[0][ob][s4], ga, 0, 0, 0); gx = __builtin_amdgcn_mfma_f32_32x32x16_bf16(xcA[s4], wf[1][ob][s4], gx, 0, 0, 0); }
            const int ch = 32 * ob + r32;
            const float cw0 = CW[ch], cw1 = CW[64 + ch], cw2 = CW[128 + ch], cw3 = CW[192 + ch], cbias = CW[256 + ch];
            float A4[4], U4[4];
#pragma unroll
            for (int q = 0; q < 4; ++q) {
                const int wb = dir ? 28 - (8 * q + 4 * hi) : (8 * q + 4 * hi);
                float win[7];
#pragma unroll
                for (int i = 0; i < 7; ++i) win[i] = bf2f(*(const bf16_t*)(xa + (wb + i) * XA_PITCH + ch * 2));
                float hrun = 0.f, arun = 1.f;
#pragma unroll
                for (int jj = 0; jj < 4; ++jj) { const int r = 4 * q + jj;
                    float xc;
                    if (dir) xc = cbias + cw0 * win[3 - jj] + cw1 * win[4 - jj] + cw2 * win[5 - jj] + cw3 * win[6 - jj];
                    else     xc = cbias + cw0 * win[jj] + cw1 * win[jj + 1] + cw2 * win[jj + 2] + cw3 * win[jj + 3];
                    const float rg = sigmoidf_(ga[r] + ba[ob]), ig = sigmoidf_(gx[r] + bx[ob]);
                    const float log_a = rg * sp8[ob], a = __expf(log_a), mult = __builtin_amdgcn_sqrtf(fmaxf(1.0f - a * a, 0.f));
                    const float u = mult * (ig * xc);
                    hrun = a * hrun + u; arun = arun * a;
                    P[ob][r] = arun; Q[ob][r] = hrun; }
                A4[q] = arun; U4[q] = hrun; }
            float c = 0.f, Ac = 1.f, cin[4], Acin[4];
#pragma unroll
            for (int st = 0; st < 8; ++st) { const int q = st >> 1, own = st & 1;
                if (hi == own) { cin[q] = c; Acin[q] = Ac; }
                const float cn = A4[q] * c + U4[q], An = Ac * A4[q];
                c = bcast_half(cn, r32 + 32 * own); Ac = bcast_half(An, r32 + 32 * own); }
#pragma unroll
            for (int r = 0; r < 16; ++r) { const int q = r >> 2; const float pa = P[ob][r]; Q[ob][r] = pa * cin[q] + Q[ob][r]; P[ob][r] = pa * Acin[q]; }
            Atile[ob] = Ac; Utile[ob] = c;
        }
        float* ts = TS + (rho & 1) * (8 * 2 * 64);
        if (hi == 0) {
#pragma unroll
            for (int ob = 0; ob < 2; ++ob) { ts[(wave * 2 + 0) * 64 + 32 * ob + r32] = Atile[ob]; ts[(wave * 2 + 1) * 64 + 32 * ob + r32] = Utile[ob]; } }
        __syncthreads();
        float CIN[2];
#pragma unroll
        for (int ob = 0; ob < 2; ++ob) { float c = RC[ob]; CIN[ob] = c;
#pragma unroll
            for (int w2 = 0; w2 < 8; ++w2) { if (w2 == wave) CIN[ob] = c; c = ts[(w2 * 2 + 0) * 64 + 32 * ob + r32] * c + ts[(w2 * 2 + 1) * 64 + 32 * ob + r32]; }
            RC[ob] = c; }
#pragma unroll
        for (int ob = 0; ob < 2; ++ob)
#pragma unroll
            for (int r = 0; r < 16; ++r) { const int tokidx = crow(r, hi); const int t = dir ? (SEQ - 1 - s0 - tokidx) : (s0 + tokidx);
                DIRS[(rowb + t) * D + dir * 256 + n * 64 + 32 * ob + r32] = (bf16_t)f2bf(P[ob][r] * CIN[ob] + Q[ob][r]); }
    }
#undef LRU_XLOAD
    __syncthreads();
}
}
namespace hgrn {
constexpr int QP = 136, TP = 144;
constexpr int L_QT = 0, L_KT = 64 * QP, L_KTT = 2 * 64 * QP, L_VT = L_KTT + 64 * TP, L_SC2 = L_VT + 64 * TP, L_SC2_END = L_SC2 + 1024;
__device__ __forceinline__ int crow(int r, int hi) { return (r & 3) + 8 * (r >> 2) + 4 * hi; }
__device__ __forceinline__ unsigned pkr(float lo, float hi) { unsigned r; asm volatile("v_cvt_pk_bf16_f32 %0, %1, %2" : "=v"(r) : "v"(lo), "v"(hi)); return r; }
__device__ __forceinline__ bf16x8 ld2x8(const char* p) { const u32x2 a = *(const u32x2*)p, b = *(const u32x2*)(p + 16); u32x4 w = {a.x, a.y, b.x, b.y}; return *reinterpret_cast<bf16x8*>(&w); }
__device__ __forceinline__ bf16x8 pack8(const f32x16& x, int s) { u32x4 w; w.x = pkr(x[8 * s], x[8 * s + 1]); w.y = pkr(x[8 * s + 2], x[8 * s + 3]); w.z = pkr(x[8 * s + 4], x[8 * s + 5]); w.w = pkr(x[8 * s + 6], x[8 * s + 7]); return *reinterpret_cast<bf16x8*>(&w); }
constexpr int L_BUF = L_SC2_END;
constexpr int QQP = 272, L_QQ = 2 * L_BUF, L_QQBUF = 64 * QQP;
__device__ __forceinline__ void qq_chunk(int ci, int dir, int colQ, size_t rowb, const bf16_t* PROJ, char* qqbuf, int c, int tg) {
    float q[16];
    { const int s0 = ci * 64 + tg * 16; const int t0 = dir ? SEQ - 1 - s0 : s0; unsigned o = (unsigned)(rowb + t0) * (unsigned)(DINP * 2) + (unsigned)colQ * 2u; const int tstep = dir ? -(DINP * 2) : (DINP * 2);
#pragma unroll
      for (int j = 0; j < 16; ++j) { q[j] = siluf_(bf2f(*(const bf16_t*)((const char*)PROJ + o))) * 0.125f; o += (unsigned)tstep; } }
#pragma unroll
    for (int j4 = 0; j4 < 4; ++j4) *(f32x4*)(qqbuf + c * QQP + (tg * 16 + 4 * j4) * 4) = (f32x4){q[4 * j4], q[4 * j4 + 1], q[4 * j4 + 2], q[4 * j4 + 3]};
}
__device__ __forceinline__ void qq_load(int ci, int dir, int colQ, size_t rowb, const bf16_t* PROJ, int tg, unsigned (&raw)[16]) {
    const int s0 = ci * 64 + tg * 16; const int t0 = dir ? SEQ - 1 - s0 : s0; unsigned o = (unsigned)(rowb + t0) * (unsigned)(DINP * 2) + (unsigned)colQ * 2u; const int tstep = dir ? -(DINP * 2) : (DINP * 2);
#pragma unroll
    for (int j = 0; j < 16; ++j) { raw[j] = (unsigned)*(const bf16_t*)((const char*)PROJ + o); o += (unsigned)tstep; }
}
__device__ __forceinline__ void qq_store(const unsigned (&raw)[16], char* qqbuf, int c, int tg) {
    float q[16];
#pragma unroll
    for (int j = 0; j < 16; ++j) q[j] = siluf_(__uint_as_float(raw[j] << 16)) * 0.125f;
#pragma unroll
    for (int j4 = 0; j4 < 4; ++j4) *(f32x4*)(qqbuf + c * QQP + (tg * 16 + 4 * j4) * 4) = (f32x4){q[4 * j4], q[4 * j4 + 1], q[4 * j4 + 2], q[4 * j4 + 3]};
}
__device__ __forceinline__ void unit(int un, int l, const bf16_t* PROJ, const float* lb_logits, bf16_t* DIRS, char* lds, int wv) {
    const int tid = launder(tid_of(wv)), wave = tid >> 6, lane = tid & 63, r32 = lane & 31, hi = lane >> 5;
    const int dir = un & 1, head = (un >> 1) & 3, b = un >> 3;
    const size_t rowb = (size_t)b * SEQ;
    __syncthreads();
    if (wave < 4) qq_chunk(0, dir, C_HQ + head * 64 + 16 * wave + (lane & 15), rowb, PROJ, lds + L_QQ, 16 * wave + (lane & 15), lane >> 4);
    __syncthreads();
    if (wave >= 4) {
        const int c = 16 * (wave - 4) + (lane & 15), tg = lane >> 4;
        float lb = 0.f;
        if (l == 1) { const int col = head * 64 + c; lb = 1.0f / (1.0f + __expf(lb_logits[(0 * 2 + dir) * 256 + col] - lb_logits[(1 * 2 + dir) * 256 + col])); }
        const int colF = (dir ? C_HFB : C_HFF) + head * 64 + c, colV = C_HI + head * 64 + c;
        bf16_t zr0[16], vr0[16], zr1[16], vr1[16];
        const char* pbase = (const char*)PROJ;
        const unsigned offF = (unsigned)colF * 2u, dV = (unsigned)(colV - colF) * 2u; const int tstep = dir ? -(DINP * 2) : (DINP * 2);
#define HG_LOAD(ci, zr, vr) do { const int s0 = (ci) * 64 + tg * 16; const int t0 = dir ? SEQ - 1 - s0 : s0; unsigned o = (unsigned)(rowb + t0) * (unsigned)(DINP * 2) + offF; \
        _Pragma("unroll") for (int j = 0; j < 16; ++j) { zr[j] = *(const bf16_t*)(pbase + o); vr[j] = *(const bf16_t*)(pbase + (o + dV)); o += (unsigned)tstep; } } while (0)
        HG_LOAD(0, zr0, vr0); HG_LOAD(1, zr1, vr1);
#define HG_BODY(ci, zr, vr) do { \
                char* buf = lds + ((ci) & 1) * L_BUF; \
                char* QT = buf + L_QT; char* KT = buf + L_KT; char* KTT = buf + L_KTT; char* VT = buf + L_VT; float* SC = (float*)(buf + L_SC2); \
                float bl[16], kk[16], qq[16]; unsigned vpk[8]; \
                { float run = 0.f; \
_Pragma("unroll") \
                  for (int j = 0; j < 16; ++j) { const float f = lb + (1.0f - lb) * sigmoidf_(bf2f(zr[j])); run += 0.6931471805599453f * __builtin_amdgcn_logf(f); bl[j] = run; kk[j] = 1.0f - f; } \
                  { const char* qb = lds + L_QQ + ((ci) & 1) * L_QQBUF + c * QQP + tg * 64; \
_Pragma("unroll") \
                    for (int j4 = 0; j4 < 4; ++j4) { const f32x4 v = *(const f32x4*)(qb + 16 * j4); qq[4 * j4] = v.x; qq[4 * j4 + 1] = v.y; qq[4 * j4 + 2] = v.z; qq[4 * j4 + 3] = v.w; } } \
_Pragma("unroll") \
                  for (int j = 0; j < 8; ++j) vpk[j] = (unsigned)vr[2 * j] | ((unsigned)vr[2 * j + 1] << 16); } \
                if ((ci) + 2 < 32) HG_LOAD((ci) + 2, zr, vr); \
                const float t0 = lane_bcast(bl[15], lane & 15), t1 = lane_bcast(bl[15], (lane & 15) + 16), t2 = lane_bcast(bl[15], (lane & 15) + 32), t3 = lane_bcast(bl[15], (lane & 15) + 48); \
                const float off = (tg > 0 ? t0 : 0.f) + (tg > 1 ? t1 : 0.f) + (tg > 2 ? t2 : 0.f), bref = t0 + t1, blast = (t0 + t1) + (t2 + t3); \
                unsigned kpk[8]; float ktp = 0.f; \
_Pragma("unroll") \
                for (int j = 0; j < 16; ++j) { const float bc = bl[j] + off; const float dq = fminf(fmaxf(bc - bref, -80.f), 80.f); \
                    const float e2 = __builtin_amdgcn_exp2f(1.4426950408889634f * dq); const float qt = qq[j] * e2, kt = kk[j] * __builtin_amdgcn_rcpf(e2); \
                    const int t = tg * 16 + j; const unsigned qk = pkr(qt, kt); *(bf16_t*)(QT + t * QP + c * 2) = (bf16_t)(qk & 0xffffu); *(bf16_t*)(KT + t * QP + c * 2) = (bf16_t)(qk >> 16); \
                    if (j & 1) kpk[j >> 1] = pkr(ktp, kt); else ktp = kt; } \
                *(u32x4*)(KTT + c * TP + tg * 32) = (u32x4){kpk[0], kpk[1], kpk[2], kpk[3]}; *(u32x4*)(KTT + c * TP + tg * 32 + 16) = (u32x4){kpk[4], kpk[5], kpk[6], kpk[7]}; \
                *(u32x4*)(VT + c * TP + tg * 32) = (u32x4){vpk[0], vpk[1], vpk[2], vpk[3]}; *(u32x4*)(VT + c * TP + tg * 32 + 16) = (u32x4){vpk[4], vpk[5], vpk[6], vpk[7]}; \
                if (tg == 0) { SC[c] = __expf(bref); SC[64 + c] = __expf(blast); SC[128 + c] = __expf(blast - bref); } \
        } while (0)
#pragma unroll 1
        for (int ci = 0; ci < 32; ci += 2) { HG_BODY(ci, zr0, vr0); lds_barrier(); HG_BODY(ci + 1, zr1, vr1); lds_barrier(); }
        lds_barrier();
#undef HG_BODY
#undef HG_LOAD
    } else {
        const int tb = (wave >> 1) & 1, eb = wave & 1;
        f32x16 S0 = f32x16{}, S1 = f32x16{};
        const int qcol = C_HQ + head * 64 + 16 * wave + (lane & 15), qc = 16 * wave + (lane & 15), qtg = lane >> 4;
        unsigned qE[16], qO[16];
        qq_load(1, dir, qcol, rowb, PROJ, qtg, qO); qq_load(2, dir, qcol, rowb, PROJ, qtg, qE);
#define HG_BCH(ci) do { \
                const char* buf = lds + ((ci) & 1) * L_BUF; \
                const char* QT = buf + L_QT; const char* KT = buf + L_KT; const char* KTT = buf + L_KTT; const char* VT = buf + L_VT; const float* SC = (const float*)(buf + L_SC2); \
                bf16x8 qf[4]; \
_Pragma("unroll") \
                for (int k4 = 0; k4 < 4; ++k4) qf[k4] = ld2x8(QT + (32 * tb + r32) * QP + (16 * k4 + 4 * hi) * 2); \
                f32x16 o = f32x16{}; \
_Pragma("unroll") \
                for (int sb = 0; sb < 2; ++sb) { if (sb <= tb) { \
                    f32x16 pt = f32x16{}; \
_Pragma("unroll") \
                    for (int k4 = 0; k4 < 4; ++k4) { const bf16x8 kf = ld2x8(KT + (32 * sb + r32) * QP + (16 * k4 + 4 * hi) * 2); pt = __builtin_amdgcn_mfma_f32_32x32x16_bf16(kf, qf[k4], pt, 0, 0, 0); } \
                    if (sb == tb) { \
_Pragma("unroll") \
                        for (int r = 0; r < 16; ++r) pt[r] = (crow(r, hi) <= r32) ? pt[r] : 0.f; } \
_Pragma("unroll") \
                    for (int s2 = 0; s2 < 2; ++s2) { const bf16x8 vf = ld2x8(VT + (32 * eb + r32) * TP + (32 * sb + 16 * s2 + 4 * hi) * 2); o = __builtin_amdgcn_mfma_f32_32x32x16_bf16(pack8(pt, s2), vf, o, 0, 0, 0); } } } \
_Pragma("unroll") \
                for (int cb = 0; cb < 2; ++cb) { f32x16 sp; \
_Pragma("unroll") \
                    for (int r = 0; r < 16; ++r) sp[r] = (cb == 0 ? S0[r] : S1[r]) * SC[32 * cb + crow(r, hi)]; \
_Pragma("unroll") \
                    for (int s2 = 0; s2 < 2; ++s2) o = __builtin_amdgcn_mfma_f32_32x32x16_bf16(qf[2 * cb + s2], pack8(sp, s2), o, 0, 0, 0); } \
_Pragma("unroll") \
                for (int cb = 0; cb < 2; ++cb) { f32x16 ds = f32x16{}; \
_Pragma("unroll") \
                    for (int ks = 0; ks < 4; ++ks) { const bf16x8 af = *(const bf16x8*)(KTT + (32 * cb + r32) * TP + (16 * ks + 8 * hi) * 2), bfr = *(const bf16x8*)(VT + (32 * eb + r32) * TP + (16 * ks + 8 * hi) * 2); \
                        ds = __builtin_amdgcn_mfma_f32_32x32x16_bf16(af, bfr, ds, 0, 0, 0); } \
_Pragma("unroll") \
                    for (int r = 0; r < 16; ++r) { const int c = 32 * cb + crow(r, hi); const float el = SC[64 + c], en = SC[128 + c]; \
                        if (cb == 0) S0[r] = el * S0[r] + en * ds[r]; else S1[r] = el * S1[r] + en * ds[r]; } } \
_Pragma("unroll") \
                for (int r = 0; r < 16; r += 2) { const int s = (ci) * 64 + 32 * tb + crow(r, hi); const int t = dir ? SEQ - 1 - s : s; \
                    const unsigned ob = ((unsigned)(rowb + t) * (unsigned)D + (unsigned)(512 + dir * 256 + head * 64 + 32 * eb + r32)) * 2u; const unsigned pk = pkr(o[r], o[r + 1]); \
                    *(bf16_t*)((char*)DIRS + ob) = (bf16_t)(pk & 0xffffu); *(bf16_t*)((char*)DIRS + (dir ? ob - (unsigned)(D * 2) : ob + (unsigned)(D * 2))) = (bf16_t)(pk >> 16); } \
        } while (0)
        qq_store(qO, lds + L_QQ + L_QQBUF, qc, qtg); qq_load(3, dir, qcol, rowb, PROJ, qtg, qO);
        lds_barrier();
#pragma unroll 1
        for (int ci = 0; ci < 32; ci += 2) {
            if (ci + 2 < 32) { qq_store(qE, lds + L_QQ, qc, qtg); if (ci + 4 < 32) qq_load(ci + 4, dir, qcol, rowb, PROJ, qtg, qE); }
            HG_BCH(ci);
            lds_barrier();
            if (ci + 3 < 32) { qq_store(qO, lds + L_QQ + L_QQBUF, qc, qtg); if (ci + 5 < 32) qq_load(ci + 5, dir, qcol, rowb, PROJ, qtg, qO); }
            HG_BCH(ci + 1);
            lds_barrier();
        }
#undef HG_BCH
    }
}
}
#ifndef DUP_GEMM
#define DUP_GEMM 1
#endif
#ifndef WIN_WGM
#define WIN_WGM 8
#endif
#ifndef DUP_WGM
#define DUP_WGM 4
#endif
#ifndef UP_WGM
#define UP_WGM 4
#endif
#ifndef DUP_WOUT
#define DUP_WOUT 1
#endif
#ifndef DUP_DDOWN
#define DUP_DDOWN 1
#endif
#ifndef DUP_MDOWN
#define DUP_MDOWN 1
#endif
#ifndef DUP_PM
#define DUP_PM 1
#endif
#ifndef DUP_PREP
#define DUP_PREP 1
#endif
#ifndef DUP_HG
#define DUP_HG 1
#endif
#ifndef DUP_LRU
#define DUP_LRU 1
#endif
#ifndef DUP_ATT
#define DUP_ATT 1
#endif
#ifndef DUP_SEQ
#define DUP_SEQ 1
#endif
#ifndef DUP_MLA
#define DUP_MLA 1
#endif
#ifndef DUP_NORM
#define DUP_NORM 1
#endif
#ifndef DUP_CVT
#define DUP_CVT 1
#endif
__global__ void __launch_bounds__(NWAVES * 64, 2) mk_fwd(MkArgs args) {
    extern __shared__ __attribute__((aligned(16))) unsigned char lds_raw[];
    Frame F;
    F.lds = (LAS unsigned char*)lds_raw; F.MISC = (volatile LAS unsigned*)(F.lds + MISC_OFF);
    F.wv = __builtin_amdgcn_readfirstlane((int)threadIdx.x >> 6); relaunder(F);
    F.G = gridDim.x; { const int bx = blockIdx.x; F.vcu = (F.G % 8 == 0) ? (bx % 8) * (F.G / 8) + bx / 8 : bx; }
    unsigned char* ws = args.ws; F.ctl = (unsigned*)(ws + WS_CTL);
    for (int u = F.tid; u < (LDS_BYTES - LDSCTL_OFF) / 4; u += NWAVES * 64) ((LAS unsigned*)(F.lds + LDSCTL_OFF))[u] = 0u;
    __syncthreads();
    XcdBarrier bar = xcd_barrier_post(F.ctl + CW_BAR + args.li * 4096, F.MISC + 8, F.wv);
    const int lo = args.ph_lo, hi = args.ph_hi;
#define IN(k) (lo <= (k) && (k) < hi && (relaunder(F), true))
#ifndef DUP_BAR
#define DUP_BAR 1
#endif
#define END_PHASE(k) do { if ((k) + 1 < hi) { for (int rb = 0; rb < DUP_BAR; ++rb) xcd_barrier(bar); } } while (0)
#define gw (F.vcu * NWAVES + F.wave)
    const int NGW = F.G * NWAVES;
    const float* x = (const float*)args.in[0]; float* out = args.out;
    bf16_t* HB = (bf16_t*)(ws + WS_HB); bf16_t* PROJ = (bf16_t*)(ws + WS_PROJ); bf16_t* DIRS = (bf16_t*)((unsigned char*)out + OUT_DIRS); bf16_t* YC = (bf16_t*)((unsigned char*)out + OUT_YC); bf16_t* XS = (bf16_t*)(ws + WS_XS);
    int* list = (int*)(ws + WS_LIST); float* wl = (float*)(ws + WS_LIST + 2 * MiB);

    if (IN(P_PREP)) {
        float* scr = (float*)(lds_raw + RING_OFF + F.wave * 8448);
#pragma unroll 1
        for (int rep = 0; rep < DUP_PREP; ++rep)
        for (int it = gw; it < N_SMALL_FIRST; it += NGW) { TrJob J; int local; if (small_job(it, args, J, local)) tr_item(J, local, scr, F.lane); }
        for (int l = 0; l < 2; ++l) zero_rows(F, (bf16_t*)(ws + WS_WIN) + (size_t)l * DINP * D + (size_t)DIN * D, DINP - DIN, D, D);
        zero_rows(F, (bf16_t*)(ws + WS_WGU + (size_t)(21 * 256 + 64) * D), 64, D / 2, D / 2);
        zero_rows(F, (bf16_t*)(ws + WS_WGU + (size_t)(21 * 256 + 192) * D), 64, D / 2, D / 2);
        zero_rows(F, (bf16_t*)(ws + WS_WDN + DFF), D, (DFFP - DFF) / 2, DFFP / 2);
#pragma unroll 1
        for (int rep = 0; rep < DUP_NORM; ++rep) stream_in_phase(F, x, XS, (float*)(ws + WS_SS) + 8 * T);
        END_PHASE(P_PREP);
    }
    for (int l = 0; l < 2; ++l) {
        if (IN(PH(l, PL_WIN))) {
            pg8::ProbDense pb{XS, (const bf16_t*)(ws + WS_WIN) + (size_t)l * DINP * D, D, D}; pg8::StaticOrder S;
            S.init(T / 256, DINP / 256, F.G, (int)blockIdx.x, WIN_WGM);
            pg8::EpiStoreBf16 E{PROJ, DINP, (const float*)(ws + WS_SS) + (l == 1 ? 4 * T : 8 * T)};
#pragma unroll 1
            for (int rep = 0; rep < DUP_GEMM; ++rep) pg8::gemm_phase(F.lds + RING_OFF, F.lds + ROWTAB_OFF, pb, S, E, F.wv);
            if ((int)blockIdx.x >= 128) {
                relaunder(F);
                const int fw = ((int)blockIdx.x - 128) * NWAVES + F.wave, FW = 128 * NWAVES;
                if (l == 0) { for (int it = N_SMALL_FIRST + fw; it < N_SMALL_ITEMS; it += FW) { TrJob J; int local; if (small_job(it, args, J, local)) tr_item(J, local, nullptr, F.lane); } }
                else { for (int it = fw; it < N_MOE_EARLY; it += FW) { TrJob J; int local; moe_job_early(it, args, J, local); tr_item(J, local, nullptr, F.lane); } }
            }
            END_PHASE(PH(l, PL_WIN));
        }
        if (IN(PH(l, PL_MLA))) {
            const bf16_t* Wuq_t = (const bf16_t*)(ws + WS_WUQ) + (size_t)l * 768 * 256; const bf16_t* Wukv_t = (const bf16_t*)(ws + WS_WUKV) + (size_t)l * 1024 * 128;
#pragma unroll 1
            for (int rep = 0; rep < DUP_MLA; ++rep)
            for (int blk = F.vcu; blk < T / 128; blk += F.G)
                mla::block_item(blk, PROJ, (const int*)args.in[1], Wuq_t, Wukv_t, (const float*)args.in[18] + l * 96, (const float*)args.in[19] + l * 96, (bf16_t*)(ws + WS_Q), (bf16_t*)(ws + WS_K), (bf16_t*)(ws + WS_V), (char*)lds_raw + RING_OFF, F.wv);
            END_PHASE(PH(l, PL_MLA));
        }
        if (IN(PH(l, PL_MIXERS))) {
            const bf16_t* Qg = (const bf16_t*)(ws + WS_Q); const bf16_t* Kg = (const bf16_t*)(ws + WS_K); const bf16_t* Vg = (const bf16_t*)(ws + WS_V);
            unsigned* qctr = F.ctl + CW_QUEUE + 64 * l;
            float negM;
            { const float* gq = (const float*)args.in[18] + l * 96; const float* gk = (const float*)args.in[19] + l * 96; float mq = 0.f, mk = 0.f;
              for (int j = F.lane; j < 96; j += 64) { mq = fmaxf(mq, fabsf(gq[j])); mk = fmaxf(mk, fabsf(gk[j])); }
#pragma unroll
              for (int o2 = 0; o2 < 1; ++o2) { mq = fmaxf(mq, xor_shfl<1>(mq)); mq = fmaxf(mq, xor_shfl<2>(mq)); mq = fmaxf(mq, xor_shfl<4>(mq)); mq = fmaxf(mq, xor_shfl<8>(mq)); mq = fmaxf(mq, xor_shfl<16>(mq)); mq = half_max(mq);
                  mk = fmaxf(mk, xor_shfl<1>(mk)); mk = fmaxf(mk, xor_shfl<2>(mk)); mk = fmaxf(mk, xor_shfl<4>(mk)); mk = fmaxf(mk, xor_shfl<8>(mk)); mk = fmaxf(mk, xor_shfl<16>(mk)); mk = half_max(mk); }
              negM = -9.797958971132712f * mq * mk * 1.4426950408889634f; }
#pragma unroll 1
            for (int rep = 0; rep < DUP_ATT; ++rep) {
            volatile LAS int* qslot = (volatile LAS int*)(F.MISC + 12);
            __syncthreads();
            if (F.tid == 0) qslot[0] = (int)__hip_atomic_fetch_add(qctr, 1u, RLX_AGENT);
            __syncthreads();
            int u = qslot[0];
#pragma unroll 1
            while (u < 1280 * (rep + 1)) {
                if (F.tid == 0) qslot[1] = (int)__hip_atomic_fetch_add(qctr, 1u, RLX_AGENT);
                const int uu = u - 1280 * rep;
                if (uu < 128) { for (int r2 = 0; r2 < DUP_HG; ++r2) hgrn::unit(uu, l, PROJ, (const float*)args.in[12], DIRS, (char*)lds_raw + RING_OFF, F.wv); }
                else if (uu < 256) { for (int r2 = 0; r2 < DUP_LRU; ++r2) lru::unit(uu - 128, l, PROJ, (const float*)args.in[4], (const float*)args.in[5], (const float*)args.in[6], (const float*)args.in[7], (const float*)args.in[8], (const float*)args.in[9],
                                             (const float*)args.in[10], DIRS, (char*)lds_raw + RING_OFF, F.wv); }
                else { const int unit = uu - 256; const int bh = unit >> 3, qb = unit & 7, b = bh >> 3, h = bh & 7; const size_t row0 = (size_t)b * SEQ;
                    if (negM < -40.f) att::attn_unit<true>(Qg + ((size_t)bh * SEQ + qb * 256) * 96, Kg + (size_t)bh * SEQ * 96, Vg + (size_t)bh * SEQ * 64, YC + ((size_t)bh * SEQ + qb * 256) * 64, 64, SEQ, negM, (char*)lds_raw + RING_OFF, F.wv);
                    else att::attn_unit<false>(Qg + ((size_t)bh * SEQ + qb * 256) * 96, Kg + (size_t)bh * SEQ * 96, Vg + (size_t)bh * SEQ * 64, YC + ((size_t)bh * SEQ + qb * 256) * 64, 64, SEQ, negM, (char*)lds_raw + RING_OFF, F.wv); }
                relaunder(F);
                __syncthreads();
                u = qslot[1];
                __syncthreads();
            }
            }
            END_PHASE(PH(l, PL_MIXERS));
        }
        if (IN(PH(l, PL_PREPMIX))) {
            const float* g_a = (const float*)args.in[11] + l * 256; const float* g_n = (const float*)args.in[13] + l * 64; const float* g_c = (const float*)args.in[20] + l * 512;
#pragma unroll 1
            for (int rep = 0; rep < DUP_PM; ++rep)
            for (int m = gw; m < T; m += NGW) prepmix_token(PROJ + (size_t)m * DINP, DIRS + (size_t)m * D, (const bf16_t*)YC + ((size_t)((m >> 11) * 8 + (F.lane >> 3)) * SEQ + (m & (SEQ - 1))) * 64 + (F.lane & 7) * 8, HB + (size_t)m * D, g_a, g_n, g_c, F.lane);
            END_PHASE(PH(l, PL_PREPMIX));
        }
        if (IN(PH(l, PL_WOUT))) {
            pg8::ProbDense pb{HB, (const bf16_t*)(ws + WS_WOUT) + (size_t)l * D * D, D, D}; pg8::StaticOrder S; S.init(T / 256, D / 256, F.G, (int)blockIdx.x);
            if (l == 0) { pg8::EpiResid<false> E{XS, XS, D, (float*)(ws + WS_SS), ws + WS_XS8};
                pg8::gemm_phase(F.lds + RING_OFF, F.lds + ROWTAB_OFF, pb, S, E, F.wv); }
            else { pg8::EpiResid<false> E{XS, XS, D, (float*)nullptr, (unsigned char*)nullptr};
                pg8::gemm_phase(F.lds + RING_OFF, F.lds + ROWTAB_OFF, pb, S, E, F.wv); }
            END_PHASE(PH(l, PL_WOUT));
        }
        if (l == 1 && IN(PH(l, PL_NORM2))) {
            {
                float* scr = (float*)(lds_raw + RING_OFF + 16384 + F.wave * 8448);
                norm_router_phase(F, XS, (const float*)args.in[22] + D, HB, (const float*)args.in[25], (int*)(ws + WS_ROUTE), (float*)(ws + WS_ROUTE + 256 * 1024));
#pragma unroll 1
                for (int rep = 0; rep < DUP_CVT; ++rep)
                for (int it = gw; it < N_MOE_LATE; it += NGW) { TrJob J; int local; moe_job_late(it, args, J, local); tr_item(J, local, scr, F.lane); }
            }
            END_PHASE(PH(l, PL_NORM2));
        }
        if (l == 0) {
            if (IN(PH(0, PL_UP0))) {
                pg8::ProbDense8 pb{(const bf16_t*)(ws + WS_XS8), (const bf16_t*)(ws + WS_WGU), D, D}; pg8::StaticOrder S; S.init(T / 256, NGU / 256, F.G, (int)blockIdx.x, DUP_WGM);
                pg8::EpiSwiglu8 E{ws + WS_ACT, DFFP, (const float*)(ws + WS_SS), 1.0f / (F8_WSCALE * F8_ASCALE)};
#pragma unroll 1
                for (int rep = 0; rep < DUP_GEMM; ++rep) pg8::gemm_phase(F.lds + RING_OFF, F.lds + ROWTAB_OFF, pb, S, E, F.wv);
                END_PHASE(PH(0, PL_UP0));
            }
            if (IN(PH(0, PL_DOWN0))) {
                pg8::ProbDense8 pb{(const bf16_t*)(ws + WS_ACT), (const bf16_t*)(ws + WS_WDN), DFFP, DFFP}; pg8::StaticOrder S; S.init(T / 256, D / 256, F.G, (int)blockIdx.x);
                { pg8::EpiResid<false, true> E{XS, XS, D, (float*)(ws + WS_SS) + 4 * T, (unsigned char*)nullptr};
                pg8::gemm_phase(F.lds + RING_OFF, F.lds + ROWTAB_OFF, pb, S, E, F.wv); }
                END_PHASE(PH(0, PL_DOWN0));
            }
        } else {
            if (IN(PH(1, PL_NORMN))) { route_assign_phase(F, (const int*)(ws + WS_ROUTE), (const float*)(ws + WS_ROUTE + 256 * 1024), list, wl); xcd_barrier(bar); }
#pragma unroll 1
            for (int r = 0; r < 2; ++r) {
                if (IN(PH(1, PL_UP0 + 2 * r))) {
                    int ntiles; pg8::MoeMap mm = moe_map_setup(F, r, ntiles);
                    pg8::ProbMoeUp pb{HB, (const bf16_t*)(ws + WS_W13), D, D, mm, list + (size_t)r * 8 * T, wl + (size_t)r * 8 * T}; pg8::StaticOrder S; S.init(ntiles, 2 * DEX / 256, F.G, (int)blockIdx.x, UP_WGM);
                    pg8::EpiSwigluMoe E{ws + WS_ACTM, DEX, mm};
#pragma unroll 1
                    for (int rep = 0; rep < DUP_GEMM; ++rep) pg8::gemm_phase(F.lds + RING_OFF, F.lds + ROWTAB_OFF, pb, S, E, F.wv);
                    END_PHASE(PH(1, PL_UP0 + 2 * r));
                }
                if (IN(PH(1, PL_DOWN0 + 2 * r))) {
                    int ntiles; pg8::MoeMap mm = moe_map_setup(F, r, ntiles);
                    const int nfull = ntiles < 128 ? ntiles : 128, nleft = ntiles - nfull;
                    { pg8::ProbMoeDown pb{(const bf16_t*)(ws + WS_ACTM), (const bf16_t*)(ws + WS_W2), DEX, DEX, mm}; pg8::StaticOrder S; S.init(nfull, D / 256, F.G, (int)blockIdx.x);
                      if (r == 0) { pg8::EpiScatterMoe<false> E{XS, XS, D, mm, list + (size_t)r * 8 * T, 1.0f / (F8_WSCALE * F8_ASCALE)}; pg8::gemm_phase(F.lds + RING_OFF, F.lds + ROWTAB_OFF, pb, S, E, F.wv); }
                      else { pg8::EpiScatterMoe<true> E{XS, out, D, mm, list + (size_t)r * 8 * T, 1.0f / (F8_WSCALE * F8_ASCALE)}; pg8::gemm_phase(F.lds + RING_OFF, F.lds + ROWTAB_OFF, pb, S, E, F.wv); } }
                    if (nleft > 0) {
                        bf16_t* Pscr = (bf16_t*)(ws + WS_PART);
                        { pg8::ProbMoeDownSlice pb{(const bf16_t*)(ws + WS_ACTM), (const bf16_t*)(ws + WS_W2), DEX, DEX / 7, DEX, nfull, mm}; pg8::StaticOrder S; S.init(nleft, 28, F.G, (int)blockIdx.x);
                          pg8::EpiPartialBf16 E{Pscr, 1.0f / (F8_WSCALE * F8_ASCALE)};
                          pg8::gemm_phase(F.lds + RING_OFF, F.lds + ROWTAB_OFF, pb, S, E, F.wv); }
                        xcd_barrier(bar);
                        relaunder(F);
                        for (int rw = gw; rw < nleft * 4 * 256; rw += NGW) { const int it = rw >> 8, rr = rw & 255, lt = it >> 2, n = it & 3, c4 = F.lane * 4; int e, ltl, cnt; mm.locate(nfull + lt, e, ltl, cnt);
                            const int lr = ltl * 256 + rr;
                            if (lr < cnt) { const int tok = list[(size_t)r * 8 * T + (size_t)e * T + lr]; const size_t oo = (size_t)tok * D + n * 256 + c4; const u32x2 xw = *(const u32x2*)(XS + oo); u32x2 w[7];
                                f32x4 v = (f32x4){__uint_as_float(xw.x << 16), __uint_as_float(xw.x & 0xffff0000u), __uint_as_float(xw.y << 16), __uint_as_float(xw.y & 0xffff0000u)};
#pragma unroll
                                for (int sl = 0; sl < 7; ++sl) w[sl] = *(const u32x2*)(Pscr + (size_t)(lt * 28 + sl * 4 + n) * 65536 + (size_t)rr * 256 + c4);
#pragma unroll
                                for (int sl = 0; sl < 7; ++sl) { v.x += __uint_as_float(w[sl].x << 16); v.y += __uint_as_float(w[sl].x & 0xffff0000u); v.z += __uint_as_float(w[sl].y << 16); v.w += __uint_as_float(w[sl].y & 0xffff0000u); }
                                if (r == 1) *(f32x4*)(out + oo) = v; else { u32x2 z; z.x = pk2(v.x, v.y); z.y = pk2(v.z, v.w); *(u32x2*)(XS + oo) = z; } } } }
                    if (r == 0) END_PHASE(PH(1, PL_DOWN0 + 2 * r));
                }
            }
        }
    }
#undef IN
#undef END_PHASE
#undef gw
}
static int g_grid = 0;
static void launch_mk(hipStream_t st, MkArgs a, int lo, int hi, int li) {
    a.ph_lo = lo; a.ph_hi = hi; a.li = li; a.pad = 0;
    hipLaunchKernelGGL(mk_fwd, dim3(g_grid), dim3(NWAVES * 64), LDS_BYTES, st, a);
    const hipError_t le = hipPeekAtLastError();
    if (le != hipSuccess) fprintf(stderr, "kernel_launch: mk_fwd launch [%d,%d) failed: %s\n", lo, hi, hipGetErrorName(le));
}
extern "C" void kernel_launch(void* const* d_in, const int* in_sizes, int n_in, void* d_out, int out_size, void* d_ws, size_t ws_size, hipStream_t stream) {
    if (n_in != 29 || in_sizes[0] != T * D || out_size != T * D || ws_size < WS_END) { fprintf(stderr, "kernel_launch: unexpected shapes (n_in %d, in0 %d, out %d, ws %zu)\n", n_in, n_in > 0 ? in_sizes[0] : -1, out_size, ws_size); return; }
    if (g_grid == 0) {
        int dev = 0, cus = 0;
        if (hipGetDevice(&dev) != hipSuccess || hipDeviceGetAttribute(&cus, hipDeviceAttributeMultiprocessorCount, dev) != hipSuccess) { fprintf(stderr, "kernel_launch: device query failed\n"); g_grid = -1; return; }
        if (hipFuncSetAttribute((const void*)mk_fwd, hipFuncAttributeMaxDynamicSharedMemorySize, LDS_BYTES) != hipSuccess) { fprintf(stderr, "kernel_launch: hipFuncSetAttribute failed\n"); g_grid = -1; return; }
        int per_cu = 0;
        if (hipOccupancyMaxActiveBlocksPerMultiprocessor(&per_cu, (const void*)mk_fwd, NWAVES * 64, LDS_BYTES) != hipSuccess || per_cu < 1) fprintf(stderr, "kernel_launch: occupancy query reports %d blocks per CU\n", per_cu);
        (void)hipGetLastError();
        g_grid = cus;
        if (g_grid != 256) { fprintf(stderr, "kernel_launch: built for 256 CUs, found %d\n", cus); g_grid = -1; return; }
    }
    if (g_grid < 0) return;
    unsigned char* ws = (unsigned char*)d_ws;
    (void)hipMemsetAsync(ws + WS_CTL, 0, MiB, stream);
    MkArgs a{};
    for (int i = 0; i < 29; ++i) a.in[i] = d_in[i];
    a.out = (float*)d_out; a.ws = ws;
    launch_mk(stream, a, 0, P_TOTAL, 0);
}
```
